# Optimizing an MI355X kernel written in HIP

```python
import math
import jax, jax.numpy as jnp
from jax import lax
import numpy as np

D_MODEL = 1024
BATCH = 8
SEQ = 2048
DEPTH = 1
DEC_BATCH = 128
DEC_SEQ = 1
PAST_LEN = 16384
PAGE_SIZE = 128

W_LRU = D_MODEL
LRU_BLOCKS = 8
LRU_BLK = W_LRU // LRU_BLOCKS
LRU_C = 8.0
CONV_W = 4
M_HEADS = 4
D_M = D_MODEL
M_HD = D_M // M_HEADS
CHUNK = 64
D_FF = ((8 * D_MODEL + 3 * 256 - 1) // (3 * 256)) * 256
P_DIM = 256
EPS = 1e-6
M_INIT = -1e30
SPLITS = (W_LRU, W_LRU + D_M, W_LRU + 2 * D_M, W_LRU + 2 * D_M + M_HEADS,
          W_LRU + 2 * D_M + 2 * M_HEADS, W_LRU + 2 * D_M + 2 * M_HEADS + D_MODEL)
N_IN = W_LRU + 2 * D_M + 2 * M_HEADS + 2 * D_MODEL

kernel_name = "hawk_mlstm_parallel_gated_decode_step"


def _rmsnorm(x, g):
    xf = x.astype(jnp.float32)
    y = xf * lax.rsqrt(jnp.mean(xf * xf, axis=-1, keepdims=True) + EPS)
    return (y * g.astype(jnp.float32)).astype(x.dtype)


def _causal_conv(x, buf, w, b):
    T = x.shape[1]
    xp = jnp.concatenate([buf.astype(x.dtype), x], axis=1)
    out = b + sum(xp[:, j:j + T] * w[j] for j in range(CONV_W))
    return out, xp[:, T:]


def _rg_lru(x, h0, w_a, b_a, w_x, b_x, lam):
    B, T, W = x.shape
    f32 = jnp.float32
    xb = x.reshape(B, T, LRU_BLOCKS, LRU_BLK)
    r = jax.nn.sigmoid((jnp.einsum('btnc,ncd->btnd', xb, w_a).reshape(B, T, W) + b_a).astype(f32))
    ig = jax.nn.sigmoid((jnp.einsum('btnc,ncd->btnd', xb, w_x).reshape(B, T, W) + b_x).astype(f32))
    log_a = -LRU_C * r * jax.nn.softplus(-lam.astype(f32))
    a = jnp.exp(log_a)
    u = jnp.sqrt(-jnp.expm1(2.0 * log_a)) * ig * x.astype(f32)
    u = u.at[:, 0].add(a[:, 0] * h0.astype(f32))

    def comb(e1, e2):
        a1, b1 = e1
        a2, b2 = e2
        return a1 * a2, a2 * b1 + b2

    _, h = lax.associative_scan(comb, (a, u), axis=1)
    return h.astype(x.dtype), h[:, -1]


def _mlstm_chunk(carry, xs):
    C, n, m = carry
    qc, kc, vc, ic, fc = xs
    L = qc.shape[2]
    b = jnp.cumsum(fc, axis=-1)
    causal = jnp.tril(jnp.ones((L, L), dtype=bool))
    dlog = jnp.where(causal, b[..., :, None] - b[..., None, :] + ic[..., None, :], -jnp.inf)
    m_inter = b + m[..., None]
    m_t = jnp.maximum(m_inter, jnp.max(dlog, axis=-1))
    s = jnp.einsum('bhtd,bhsd->bhts', qc, kc) * jnp.exp(dlog - m_t[..., None])
    sc = jnp.exp(m_inter - m_t)
    num = jnp.einsum('bhts,bhse->bhte', s, vc) + sc[..., None] * jnp.einsum('bhtd,bhde->bhte', qc, C)
    den = jnp.sum(s, axis=-1) + sc * jnp.einsum('bhtd,bhd->bht', qc, n)
    h = num / jnp.maximum(jnp.abs(den), jnp.exp(-m_t))[..., None]
    m_last = m_t[..., -1]
    wk = jnp.exp(b[..., -1:] - b + ic - m_last[..., None])
    dec = jnp.exp(b[..., -1] + m - m_last)
    C_new = dec[..., None, None] * C + jnp.einsum('bhs,bhsd,bhse->bhde', wk, kc, vc)
    n_new = dec[..., None] * n + jnp.einsum('bhs,bhsd->bhd', wk, kc)
    return (C_new, n_new, m_last), h


def _mlstm(xm, o_pre, i_pre, f_pre, conv_buf, C0, n0, m0, cw, cb, w_q, w_k, w_v, g):
    B, T, _ = xm.shape
    f32 = jnp.float32
    xc, new_buf = _causal_conv(xm, conv_buf, cw, cb)
    xc = jax.nn.silu(xc).reshape(B, T, M_HEADS, M_HD)
    xh = xm.reshape(B, T, M_HEADS, M_HD)
    q = jnp.einsum('bthd,hde->bhte', xc, w_q).astype(f32) * (M_HD ** -0.5)
    k = jnp.einsum('bthd,hde->bhte', xc, w_k).astype(f32)
    v = jnp.einsum('bthd,hde->bhte', xh, w_v).astype(f32)
    ig = jnp.swapaxes(i_pre.astype(f32), 1, 2)
    lf = jax.nn.log_sigmoid(jnp.swapaxes(f_pre.astype(f32), 1, 2))
    L = CHUNK if T % CHUNK == 0 else T
    nc = T // L

    def chunks(a):
        return jnp.moveaxis(a.reshape(a.shape[:2] + (nc, L) + a.shape[3:]), 2, 0)

    carry0 = (C0.astype(f32), n0.astype(f32), m0.astype(f32))
    (C, n, m), h = lax.scan(_mlstm_chunk, carry0,
                            (chunks(q), chunks(k), chunks(v), chunks(ig), chunks(lf)))
    h = jnp.moveaxis(h, 0, 2).reshape(B, M_HEADS, T, M_HD)
    h = h * lax.rsqrt(jnp.mean(h * h, axis=-1, keepdims=True) + EPS) * g[:, None, :].astype(f32)
    h = jnp.swapaxes(h, 1, 2).reshape(B, T, D_M)
    out = (jax.nn.sigmoid(o_pre.astype(f32)) * h).astype(xm.dtype)
    return out, new_buf, C.astype(xm.dtype), n.astype(xm.dtype), m.astype(xm.dtype)


def _layer(x, p, st, lw):
    conv_l, h_l, conv_m, C0, n0, m0 = st
    (g_mix, w_in, b_gates, lru_cw, lru_cb, lru_wa, lru_ba, lru_wx, lru_bx, lru_lam,
     m_cw, m_cb, w_q, w_k, w_v, m_g, w_out, g_ffn, w_gate, w_up, w_down,
     g_ple, w_ple_gate, w_ple) = lw
    xn = _rmsnorm(x, g_mix)
    z = xn @ w_in
    x_l, x_m, o_m, i_m, f_m, g_l, g_m = jnp.split(z, SPLITS, axis=-1)
    i_m = i_m + b_gates[:M_HEADS]
    f_m = f_m + b_gates[M_HEADS:]
    xl_c, new_lconv = _causal_conv(x_l, conv_l, lru_cw, lru_cb)
    y_l, new_h = _rg_lru(xl_c, h_l, lru_wa, lru_ba, lru_wx, lru_bx, lru_lam)
    y_m, new_mconv, C1, n1, m1 = _mlstm(x_m, o_m, i_m, f_m, conv_m, C0, n0, m0,
                                        m_cw, m_cb, w_q, w_k, w_v, m_g)
    merged = jax.nn.sigmoid(g_l) * y_l + jax.nn.sigmoid(g_m) * y_m
    x = x + merged @ w_out
    xn = _rmsnorm(x, g_ffn)
    x = x + (jax.nn.silu(xn @ w_gate) * (xn @ w_up)) @ w_down
    gate = jax.nn.sigmoid(_rmsnorm(x, g_ple) @ w_ple_gate)
    x = x + gate * (p @ w_ple)
    return x, (new_lconv, new_h.astype(x.dtype), new_mconv, C1, n1, m1)


def _trunk(x, p, states, weights, final_g):
    new = [[] for _ in range(len(states))]
    for l in range(DEPTH):
        st = tuple(s[l] for s in states)
        lw = tuple(w[l] for w in weights)
        x, ns = _layer(x, p[l], st, lw)
        for lst, a in zip(new, ns):
            lst.append(a)
    return _rmsnorm(x, final_g), tuple(jnp.stack(a) for a in new)


def setup_inputs(seed: int = 0) -> dict:
    key = jax.random.key(seed)
    ks = iter(jax.random.split(key, 48))
    nrm = lambda shape, s: jax.random.normal(next(ks), shape, jnp.float32) * s
    gain = lambda shape: 1.0 + nrm(shape, 0.02)
    u = jax.random.uniform(next(ks), (DEPTH, W_LRU), jnp.float32, 0.9, 0.999)
    s = u ** (1.0 / LRU_C)
    lam = jnp.log(s) - jnp.log1p(-s)
    f_bias = jnp.linspace(3.0, 6.0, M_HEADS, dtype=jnp.float32)[None, :] + nrm((DEPTH, M_HEADS), 0.1)
    b_gates = jnp.concatenate([nrm((DEPTH, M_HEADS), 0.1), f_bias], axis=-1)
    return {
        "x_prompt": nrm((BATCH, SEQ, D_MODEL), 1.0),
        "x_sample": nrm((DEC_BATCH, DEC_SEQ, D_MODEL), 1.0),
        "state_lru_conv": nrm((DEPTH, DEC_BATCH, CONV_W - 1, W_LRU), 1.0),
        "state_lru_h": nrm((DEPTH, DEC_BATCH, W_LRU), 0.5),
        "state_mlstm_conv": nrm((DEPTH, DEC_BATCH, CONV_W - 1, D_M), 1.0),
        "state_mlstm_C": nrm((DEPTH, DEC_BATCH, M_HEADS, M_HD, M_HD), 0.1),
        "state_mlstm_n": nrm((DEPTH, DEC_BATCH, M_HEADS, M_HD), 0.3),
        "state_mlstm_m": jax.random.uniform(next(ks), (DEPTH, DEC_BATCH, M_HEADS), jnp.float32, -1.0, 3.0),
        "p_prompt": nrm((DEPTH, BATCH, SEQ, P_DIM), 1.0),
        "p_sample": nrm((DEPTH, DEC_BATCH, DEC_SEQ, P_DIM), 1.0),
        "norm_mix_g": gain((DEPTH, D_MODEL)),
        "w_in": nrm((DEPTH, D_MODEL, N_IN), D_MODEL ** -0.5),
        "b_gates": b_gates,
        "lru_conv_w": nrm((DEPTH, CONV_W, W_LRU), CONV_W ** -0.5),
        "lru_conv_b": nrm((DEPTH, W_LRU), 0.02),
        "lru_w_a": nrm((DEPTH, LRU_BLOCKS, LRU_BLK, LRU_BLK), LRU_BLK ** -0.5),
        "lru_b_a": nrm((DEPTH, W_LRU), 0.02),
        "lru_w_x": nrm((DEPTH, LRU_BLOCKS, LRU_BLK, LRU_BLK), LRU_BLK ** -0.5),
        "lru_b_x": nrm((DEPTH, W_LRU), 0.02),
        "lru_lambda": lam,
        "mlstm_conv_w": nrm((DEPTH, CONV_W, D_M), CONV_W ** -0.5),
        "mlstm_conv_b": nrm((DEPTH, D_M), 0.02),
        "w_q": nrm((DEPTH, M_HEADS, M_HD, M_HD), M_HD ** -0.5),
        "w_k": nrm((DEPTH, M_HEADS, M_HD, M_HD), M_HD ** -0.5),
        "w_v": nrm((DEPTH, M_HEADS, M_HD, M_HD), M_HD ** -0.5),
        "mlstm_norm_g": gain((DEPTH, M_HEADS, M_HD)),
        "w_out": nrm((DEPTH, D_MODEL, D_MODEL), D_MODEL ** -0.5),
        "norm_ffn_g": gain((DEPTH, D_MODEL)),
        "w_ffn_gate": nrm((DEPTH, D_MODEL, D_FF), D_MODEL ** -0.5),
        "w_ffn_up": nrm((DEPTH, D_MODEL, D_FF), D_MODEL ** -0.5),
        "w_ffn_down": nrm((DEPTH, D_FF, D_MODEL), D_FF ** -0.5),
        "norm_ple_g": gain((DEPTH, D_MODEL)),
        "w_ple_gate": nrm((DEPTH, D_MODEL, D_MODEL), D_MODEL ** -0.5),
        "w_ple": nrm((DEPTH, P_DIM, D_MODEL), P_DIM ** -0.5),
        "final_norm_g": gain((D_MODEL,)),
    }


def reference(x_prompt, x_sample, state_lru_conv, state_lru_h, state_mlstm_conv,
              state_mlstm_C, state_mlstm_n, state_mlstm_m, p_prompt, p_sample,
              norm_mix_g, w_in, b_gates, lru_conv_w, lru_conv_b, lru_w_a, lru_b_a,
              lru_w_x, lru_b_x, lru_lambda, mlstm_conv_w, mlstm_conv_b, w_q, w_k, w_v,
              mlstm_norm_g, w_out, norm_ffn_g, w_ffn_gate, w_ffn_up, w_ffn_down,
              norm_ple_g, w_ple_gate, w_ple, final_norm_g):
    weights = (norm_mix_g, w_in, b_gates, lru_conv_w, lru_conv_b, lru_w_a, lru_b_a,
               lru_w_x, lru_b_x, lru_lambda, mlstm_conv_w, mlstm_conv_b, w_q, w_k, w_v,
               mlstm_norm_g, w_out, norm_ffn_g, w_ffn_gate, w_ffn_up, w_ffn_down,
               norm_ple_g, w_ple_gate, w_ple)
    B = x_prompt.shape[0]
    dt = x_prompt.dtype
    prompt_states = (
        jnp.zeros((DEPTH, B, CONV_W - 1, W_LRU), dt),
        jnp.zeros((DEPTH, B, W_LRU), dt),
        jnp.zeros((DEPTH, B, CONV_W - 1, D_M), dt),
        jnp.zeros((DEPTH, B, M_HEADS, M_HD, M_HD), jnp.float32),
        jnp.zeros((DEPTH, B, M_HEADS, M_HD), jnp.float32),
        jnp.full((DEPTH, B, M_HEADS), M_INIT, jnp.float32),
    )
    sample_states = (state_lru_conv, state_lru_h, state_mlstm_conv,
                     state_mlstm_C, state_mlstm_n, state_mlstm_m)
    y_prompt, ps = _trunk(x_prompt, p_prompt, prompt_states, weights, final_norm_g)
    y_sample, ss = _trunk(x_sample, p_sample, sample_states, weights, final_norm_g)
    p_lru_conv, p_lru_h, p_m_conv, p_C, p_n, p_m = ps
    s_lru_conv, s_lru_h, s_m_conv, s_C, s_n, s_m = ss
    return (y_prompt, y_sample, p_lru_conv, p_lru_h, p_m_conv, p_C, p_n, p_m,
            s_lru_conv, s_lru_h, s_m_conv, s_C, s_n, s_m)
```

```cpp
#include <hip/hip_runtime.h>
#include <hip/hip_cooperative_groups.h>
#include <cstdio>
#include <cstdint>
namespace cg = cooperative_groups;

#define LAS __attribute__((address_space(3)))
typedef unsigned short bf16_t;
typedef short bf16x8 __attribute__((ext_vector_type(8)));
typedef float f32x4 __attribute__((ext_vector_type(4)));
typedef float f32x2 __attribute__((ext_vector_type(2)));
typedef unsigned u32x4 __attribute__((ext_vector_type(4)));
typedef unsigned u32x2 __attribute__((ext_vector_type(2)));

constexpr int D = 1024, NB = 8, T = 2048, MP = NB * T, MS = 128, MR = MP + MS, M = 16640  ;
constexpr int NZ = 5120, DFF = 2816, NGU = 2 * DFF, PD = 256, NIN = 5128, NH = 4, HD = 256, NCH = T / 64;
constexpr float EPS = 1e-6f;
constexpr float M_INIT = -1e30f;

constexpr size_t MiB = 1u << 20;
constexpr size_t WS_W1T = 0;
constexpr size_t WS_WOT = 10 * MiB;
constexpr size_t WS_WGUT = 12 * MiB;
constexpr size_t WS_WDT = 23 * MiB;
constexpr size_t WS_WPGT = 57 * MiB / 2;
constexpr size_t WS_WPT = 61 * MiB / 2;
constexpr size_t WS_WQKT = 31 * MiB;
constexpr size_t WS_WVT = 32 * MiB;
constexpr size_t WS_WLRUT = 65 * MiB / 2;
constexpr size_t WS_SMALL = 33 * MiB;
constexpr size_t WS_XB = 40 * MiB;
constexpr size_t WS_PB = 73 * MiB;
constexpr size_t WS_Z = 82 * MiB;
constexpr size_t WS_XC = 245 * MiB;
constexpr size_t WS_Q = 278 * MiB;
constexpr size_t WS_K = 311 * MiB;
constexpr size_t WS_KT = 344 * MiB;
constexpr size_t WS_VT = 377 * MiB;
constexpr size_t WS_HLOC = 410 * MiB;
constexpr size_t WS_CUMA = 443 * MiB;
constexpr size_t WS_END = 476 * MiB;
constexpr size_t WS_X1 = WS_Q;
constexpr size_t WS_X1B = WS_KT;
constexpr size_t WS_X2B = WS_VT;
constexpr size_t WS_PE = WS_HLOC;
constexpr int SM_RSTD0 = 0;
constexpr int SM_SS1 = SM_RSTD0 + M;
constexpr int SM_SS2 = SM_SS1 + M;
constexpr int SM_SS3 = SM_SS2 + M;
constexpr int SM_GI = SM_SS3 + M;
constexpr int SM_GF = SM_GI + 4 * M;
constexpr int SM_BM = SM_GF + 4 * M;
constexpr int SM_GIB = SM_BM + 32 * T;
constexpr int SM_SC = SM_GIB + 32 * T;
constexpr int SM_WK = SM_SC + 32 * T;
constexpr int SM_MM = SM_WK + 32 * T;
constexpr int SM_DEC = SM_MM + 32 * T;
constexpr int SM_NST = SM_DEC + 1024;
constexpr int SM_LRA = SM_NST + 32 * 32 * 256;
constexpr int SM_LRH = SM_LRA + 8 * 32 * 1024;
constexpr int SM_XLS = SM_LRH + 8 * 32 * 1024;
constexpr int SM_END = SM_XLS + 128 * 1024;
static_assert((size_t)SM_END * 4 <= 7 * MiB, "small arrays");
static_assert(WS_END <= 512 * MiB, "workspace");

constexpr size_t O_YP = 0, O_YS = O_YP + (size_t)MP * D, O_PLC = O_YS + (size_t)MS * D, O_PLH = O_PLC + 8 * 3 * 1024, O_PMC = O_PLH + 8 * 1024,
                 O_PC = O_PMC + 8 * 3 * 1024, O_PN = O_PC + (size_t)8 * 4 * 65536, O_PM = O_PN + 8 * 4 * 256, O_SLC = O_PM + 32, O_SLH = O_SLC + (size_t)128 * 3 * 1024,
                 O_SMC = O_SLH + 128 * 1024, O_SC = O_SMC + (size_t)128 * 3 * 1024, O_SN = O_SC + (size_t)128 * 4 * 65536, O_SM = O_SN + 128 * 4 * 256, O_END = O_SM + 512;

constexpr int LDS_BYTES = 147456;
constexpr int NT = 512;

struct Args {
    const float* in[35];
    float* out;
    unsigned char* ws;
    int ph_lo, ph_hi;
};

__device__ __forceinline__ const float* inp_(const Args& a, int k) { asm volatile("" : "+s"(k)); return a.in[k]; }
#define INP(k) inp_(a, (k))
__device__ __forceinline__ unsigned f2bf(float f) { unsigned u = __builtin_bit_cast(unsigned, f); return (u + 0x7fffu + ((u >> 16) & 1u)) >> 16; }
__device__ __forceinline__ unsigned pk2(float lo, float hi) { return f2bf(lo) | (f2bf(hi) << 16); }
__device__ __forceinline__ float bf2f(unsigned short h) { return __builtin_bit_cast(float, (unsigned)h << 16); }
__device__ __forceinline__ float bflo(unsigned w) { return __builtin_bit_cast(float, w << 16); }
__device__ __forceinline__ float bfhi(unsigned w) { return __builtin_bit_cast(float, w & 0xffff0000u); }
__device__ __forceinline__ float sigmoidf_(float x) { return 1.f / (1.f + __expf(-x)); }
__device__ __forceinline__ float wave_sum(float v) {
#pragma unroll
    for (int o = 1; o < 64; o <<= 1) v += __shfl_xor(v, o);
    return v;
}
__device__ __forceinline__ const float* xrow_ptr(const Args& a, int row) {
    return row < MP ? INP(0) + (size_t)row * D : INP(1) + (size_t)(row - MP) * D;
}

namespace pg8 {
constexpr int BM = 256, BK = 64, HALF = 128, HTB = HALF * BK * 2, STAGE_BYTES = 8 * HTB, NXCD = 8, WGM = 8;
__device__ __forceinline__ int lds_byte(int r, int c) { const int st = (r >> 4) * 2 + (c >> 5), rr = r & 15, cc = c & 31, ob = rr * 64 + cc * 2; return st * 1024 + (ob ^ (((ob >> 9) & 1) << 5)); }
__device__ __forceinline__ void stage_rc(int b, int& R, int& C) { const int st = b / 1024, sb = b % 1024, swz = sb ^ (((sb >> 9) & 1) << 5); R = (st >> 1) * 16 + swz / 64; C = (st & 1) * 32 + (swz % 64) / 2; }
__device__ __forceinline__ int perm32(int rho) { const int n = rho >> 4, i = rho & 15; return 8 * (i >> 2) + 4 * n + (i & 3); }

struct Unit { int pm, pn, z; };
struct Gemm { const bf16_t* A; const bf16_t* Bt; int lda, ldb, K; size_t zA, zB; };

struct Order {
    int nM, nN, nwg, total, G, c;
    __device__ void init(int nM_, int nN_, int nZ_, int G_, int c_) { nM = nM_; nN = nN_; nwg = nM * nN; total = nwg * nZ_; G = G_; c = c_; }
    __device__ bool next(int i, Unit& u) const {
        const long L = (long)i * G + c; if (L >= total) return false;
        u.z = (int)(L / nwg); int wgid = (int)(L % nwg);
        { const int q = nwg / NXCD, r = nwg % NXCD, xcd = wgid % NXCD, off = wgid / NXCD; wgid = (xcd < r ? xcd * (q + 1) : r * (q + 1) + (xcd - r) * q) + off; }
        const int nig = WGM * nN, gid = wgid / nig, fm = gid * WGM, gsz = (nM - fm) < WGM ? (nM - fm) : WGM;
        u.pm = fm + ((wgid % nig) % gsz); u.pn = (wgid % nig) / gsz; return true;
    }
};

__device__ __forceinline__ unsigned cvt_pk_bf16(float lo, float hi) { unsigned r; asm volatile("v_cvt_pk_bf16_f32 %0, %1, %2" : "=v"(r) : "v"(lo), "v"(hi)); return r; }

template <class Epi>
__device__ __forceinline__ void gemm_phase(LAS unsigned char* lds, const Gemm g, const Order& S, const Epi& E) {
    int tid = threadIdx.x; asm volatile("" : "+v"(tid));
    const int wid = __builtin_amdgcn_readfirstlane(tid >> 6), lane = tid & 63, wr = wid >> 2, wc = wid & 3, fr = lane & 15, fq = lane >> 4;
    const int K = g.K, nt = K / BK;
    unsigned voffA[2], voffB[2];
#pragma unroll
    for (int i = 0; i < 2; ++i) { int R, C; stage_rc(tid * 16 + i * 8192, R, C); const int Rb = (R & ~31) + perm32(R & 31);
        voffA[i] = (unsigned)(R * g.lda + C) * 2u; voffB[i] = (unsigned)(Rb * g.ldb + C) * 2u; }
    const size_t kstep = (size_t)(BK * 2);
    const size_t hstepA = (size_t)HALF * g.lda * 2, hstepB = (size_t)HALF * g.ldb * 2;
    const size_t tstepA = 2 * hstepA, tstepB = 2 * hstepB;
    const unsigned ldsw = (unsigned)wid * 1024u;
    const int aoff = lds_byte(wr * 64 + fr, fq * 8), boff = lds_byte(wc * 32 + fr, fq * 8);
#define PG8_SA(b, h) (((b) * 2 + (h)) * HTB)
#define PG8_SB(b, h) ((4 + (b) * 2 + (h)) * HTB)
#define PG8_STAGE(bufoff, gbase, voff) do { _Pragma("unroll") for (int _i = 0; _i < 2; ++_i) \
        __builtin_amdgcn_global_load_lds((const unsigned*)((const char*)(gbase) + (voff)[_i]), (LAS unsigned*)(lds + (bufoff) + ldsw + _i * 8192), 16, 0, 0); } while (0)
#define PG8_LDA(dst, b, h) do { _Pragma("unroll") for (int m = 0; m < 4; ++m) _Pragma("unroll") for (int k = 0; k < 2; ++k) dst[m][k] = *(const LAS bf16x8*)(lds + PG8_SA(b, h) + aoff + m * 2048 + k * 1024); } while (0)
#define PG8_LDB(dst, b, h) do { _Pragma("unroll") for (int n = 0; n < 2; ++n) _Pragma("unroll") for (int k = 0; k < 2; ++k) dst[n][k] = *(const LAS bf16x8*)(lds + PG8_SB(b, h) + boff + n * 2048 + k * 1024); } while (0)
#define PG8_MMA(ai, bj, At, Bt) do { __builtin_amdgcn_s_setprio(1); _Pragma("unroll") for (int m = 0; m < 4; ++m) _Pragma("unroll") for (int n = 0; n < 2; ++n) _Pragma("unroll") for (int k = 0; k < 2; ++k) \
        acc[ai][bj][m][n] = __builtin_amdgcn_mfma_f32_16x16x32_bf16(Bt[n][k], At[m][k], acc[ai][bj][m][n], 0, 0, 0); __builtin_amdgcn_s_setprio(0); } while (0)
#define PG8_WAIT_V(n) asm volatile("s_waitcnt vmcnt(" #n ")" ::: "memory")
#define PG8_WAIT_L(n) asm volatile("s_waitcnt lgkmcnt(" #n ")" ::: "memory")
#define PG8_BAR __builtin_amdgcn_s_barrier()
#define PG8_SCHED __builtin_amdgcn_sched_barrier(0)
    Unit cur, nxt; int ui = 0;
    if (!S.next(0, cur)) return;
    f32x4 acc[2][2][4][2];
#pragma unroll
    for (int a = 0; a < 2; ++a)
#pragma unroll
        for (int b = 0; b < 2; ++b)
#pragma unroll
            for (int m = 0; m < 4; ++m)
#pragma unroll
                for (int n = 0; n < 2; ++n) acc[a][b][m][n] = (f32x4){0.f, 0.f, 0.f, 0.f};
    bf16x8 At[4][2], B0[2][2], B1[2][2];
    const char* cA = (const char*)g.A + (size_t)cur.pm * tstepA + (size_t)cur.z * g.zA; const char* cB = (const char*)g.Bt + (size_t)cur.pn * tstepB + (size_t)cur.z * g.zB;
    PG8_STAGE(PG8_SB(0, 0), cB, voffB); PG8_STAGE(PG8_SB(0, 1), cB + hstepB, voffB); PG8_STAGE(PG8_SA(0, 0), cA, voffA); PG8_STAGE(PG8_SA(0, 1), cA + hstepA, voffA);
    if (wr == 1) PG8_BAR;
    PG8_WAIT_V(2); PG8_BAR;
    PG8_STAGE(PG8_SB(1, 0), cB + kstep, voffB); PG8_STAGE(PG8_SA(1, 0), cA + kstep, voffA); PG8_STAGE(PG8_SB(1, 1), cB + hstepB + kstep, voffB);
    PG8_WAIT_V(6); PG8_BAR;
    for (;;) {
        const bool has_next = S.next(ui + 1, nxt);
        const char* nA = has_next ? (const char*)g.A + (size_t)nxt.pm * tstepA + (size_t)nxt.z * g.zA : cA;
        const char* nB = has_next ? (const char*)g.Bt + (size_t)nxt.pn * tstepB + (size_t)nxt.z * g.zB : cB;
        for (int t = 0; t < nt; t += 2) {
            const bool last = (t == nt - 2);
            const char* a1 = cA + (size_t)(t + 1) * kstep;
            const char* a2 = last ? nA : cA + (size_t)(t + 2) * kstep; const char* b2 = last ? nB : cB + (size_t)(t + 2) * kstep;
            const char* a3 = a2 + kstep; const char* b3 = b2 + kstep;
            PG8_LDB(B0, 0, 0); PG8_LDB(B1, 0, 1); PG8_SCHED; PG8_LDA(At, 0, 0); PG8_STAGE(PG8_SA(1, 1), a1 + hstepA, voffA);
            PG8_WAIT_V(8); PG8_WAIT_L(0); PG8_BAR; PG8_MMA(0, 0, At, B0); PG8_MMA(0, 1, At, B1); PG8_BAR; PG8_SCHED;
            PG8_LDA(At, 0, 1); PG8_STAGE(PG8_SB(0, 0), b2, voffB); PG8_STAGE(PG8_SB(0, 1), b2 + hstepB, voffB); PG8_STAGE(PG8_SA(0, 0), a2, voffA);
            PG8_WAIT_V(8); PG8_WAIT_L(0); PG8_BAR; PG8_MMA(1, 0, At, B0); PG8_MMA(1, 1, At, B1); PG8_BAR; PG8_SCHED;
            PG8_LDB(B0, 1, 0); PG8_LDB(B1, 1, 1); PG8_SCHED; PG8_LDA(At, 1, 0); PG8_STAGE(PG8_SA(0, 1), a2 + hstepA, voffA);
            PG8_WAIT_V(8); PG8_WAIT_L(0); PG8_BAR; PG8_MMA(0, 0, At, B0); PG8_MMA(0, 1, At, B1); PG8_BAR; PG8_SCHED;
            PG8_LDA(At, 1, 1); PG8_STAGE(PG8_SB(1, 0), b3, voffB); PG8_STAGE(PG8_SB(1, 1), b3 + hstepB, voffB); PG8_STAGE(PG8_SA(1, 0), a3, voffA);
            PG8_WAIT_V(8); PG8_WAIT_L(0); PG8_BAR; PG8_MMA(1, 0, At, B0); PG8_MMA(1, 1, At, B1); PG8_BAR; PG8_SCHED;
        }
        if (wr == 0) PG8_BAR;
        E(acc, cur, wr, wc, fr, fq);
        if (!has_next) break;
#pragma unroll
        for (int a = 0; a < 2; ++a)
#pragma unroll
            for (int b = 0; b < 2; ++b)
#pragma unroll
                for (int m = 0; m < 4; ++m)
#pragma unroll
                    for (int n = 0; n < 2; ++n) acc[a][b][m][n] = (f32x4){0.f, 0.f, 0.f, 0.f};
        cur = nxt; cA = nA; cB = nB; ++ui;
        if (wr == 1) PG8_BAR;
    }
    PG8_WAIT_V(0);
    PG8_BAR;
#undef PG8_SA
#undef PG8_SB
#undef PG8_STAGE
#undef PG8_LDA
#undef PG8_LDB
#undef PG8_MMA
#undef PG8_WAIT_V
#undef PG8_WAIT_L
#undef PG8_BAR
#undef PG8_SCHED
}

#define EPI_ROW0(u) ((u).pm * BM + wr * 64 + fr)
#define EPI_COL0(u) ((u).pn * BM + wc * 32 + 8 * fq)

struct EpiZ {
    bf16_t* Zp; const float* rstd;
    __device__ __forceinline__ void operator()(const f32x4 (&acc)[2][2][4][2], const Unit& u, int wr, int wc, int fr, int fq) const {
        const int row0 = EPI_ROW0(u), col0 = EPI_COL0(u);
#pragma unroll
        for (int ai = 0; ai < 2; ++ai)
#pragma unroll
            for (int m = 0; m < 4; ++m) { const int row = row0 + ai * HALF + m * 16; const float s = rstd[row]; bf16_t* rp = Zp + (size_t)row * NZ + col0;
#pragma unroll
                for (int bj = 0; bj < 2; ++bj) { const f32x4 v0 = acc[ai][bj][m][0] * s, v1 = acc[ai][bj][m][1] * s; u32x4 w;
                    w.x = cvt_pk_bf16(v0[0], v0[1]); w.y = cvt_pk_bf16(v0[2], v0[3]); w.z = cvt_pk_bf16(v1[0], v1[1]); w.w = cvt_pk_bf16(v1[2], v1[3]);
                    *(u32x4*)(rp + bj * HALF) = w; } }
    }
};
struct EpiQK {
    bf16_t* Qp; bf16_t* Kp;
    __device__ __forceinline__ void operator()(const f32x4 (&acc)[2][2][4][2], const Unit& u, int wr, int wc, int fr, int fq) const {
        const int row0 = EPI_ROW0(u), col0 = u.z * 256 + wc * 32 + 8 * fq; bf16_t* base = u.pn ? Kp : Qp;
#pragma unroll
        for (int ai = 0; ai < 2; ++ai)
#pragma unroll
            for (int m = 0; m < 4; ++m) { const int row = row0 + ai * HALF + m * 16; bf16_t* rp = base + (size_t)row * D + col0;
#pragma unroll
                for (int bj = 0; bj < 2; ++bj) { const f32x4 v0 = acc[ai][bj][m][0], v1 = acc[ai][bj][m][1]; u32x4 w;
                    w.x = cvt_pk_bf16(v0[0], v0[1]); w.y = cvt_pk_bf16(v0[2], v0[3]); w.z = cvt_pk_bf16(v1[0], v1[1]); w.w = cvt_pk_bf16(v1[2], v1[3]);
                    *(u32x4*)(rp + bj * HALF) = w; } }
    }
};
struct EpiT {
    bf16_t* Op;
    __device__ __forceinline__ void operator()(const f32x4 (&acc)[2][2][4][2], const Unit& u, int wr, int wc, int fr, int fq) const {
        const int row0 = wr * 64 + fr, col0 = EPI_COL0(u);
#pragma unroll
        for (int ai = 0; ai < 2; ++ai)
#pragma unroll
            for (int m = 0; m < 4; ++m) { const int row = row0 + ai * HALF + m * 16; bf16_t* rp = Op + ((size_t)u.z * 256 + row) * M + col0;
#pragma unroll
                for (int bj = 0; bj < 2; ++bj) { const f32x4 v0 = acc[ai][bj][m][0], v1 = acc[ai][bj][m][1]; u32x4 w;
                    w.x = cvt_pk_bf16(v0[0], v0[1]); w.y = cvt_pk_bf16(v0[2], v0[3]); w.z = cvt_pk_bf16(v1[0], v1[1]); w.w = cvt_pk_bf16(v1[2], v1[3]);
                    *(u32x4*)(rp + bj * HALF) = w; } }
    }
};
struct EpiPlain {
    bf16_t* Op; int ldc;
    __device__ __forceinline__ void operator()(const f32x4 (&acc)[2][2][4][2], const Unit& u, int wr, int wc, int fr, int fq) const {
        const int row0 = EPI_ROW0(u), col0 = EPI_COL0(u);
#pragma unroll
        for (int ai = 0; ai < 2; ++ai)
#pragma unroll
            for (int m = 0; m < 4; ++m) { const int row = row0 + ai * HALF + m * 16; bf16_t* rp = Op + (size_t)row * ldc + col0;
#pragma unroll
                for (int bj = 0; bj < 2; ++bj) { const f32x4 v0 = acc[ai][bj][m][0], v1 = acc[ai][bj][m][1]; u32x4 w;
                    w.x = cvt_pk_bf16(v0[0], v0[1]); w.y = cvt_pk_bf16(v0[2], v0[3]); w.z = cvt_pk_bf16(v1[0], v1[1]); w.w = cvt_pk_bf16(v1[2], v1[3]);
                    *(u32x4*)(rp + bj * HALF) = w; } }
    }
};
template <int MODE> struct EpiRes {
    const float* xp; const float* xs; float* X; bf16_t* XBp; float* ss;
    __device__ __forceinline__ void operator()(const f32x4 (&acc)[2][2][4][2], const Unit& u, int wr, int wc, int fr, int fq) const {
        const int row0 = EPI_ROW0(u), col0 = EPI_COL0(u);
#pragma unroll
        for (int ai = 0; ai < 2; ++ai)
#pragma unroll
            for (int m = 0; m < 4; ++m) { const int row = row0 + ai * HALF + m * 16;
                float q = 0.f;
                if (row < MR) {
                    const float* bp = MODE == 0 ? (row < MP ? xp + (size_t)row * D : xs + (size_t)(row - MP) * D) : X + (size_t)row * D;
#pragma unroll
                    for (int bj = 0; bj < 2; ++bj) { const int c = col0 + bj * HALF;
                        const f32x4 b0 = *(const f32x4*)(bp + c), b1 = *(const f32x4*)(bp + c + 4);
                        const f32x4 v0 = acc[ai][bj][m][0] + b0, v1 = acc[ai][bj][m][1] + b1;
                        *(f32x4*)(X + (size_t)row * D + c) = v0; *(f32x4*)(X + (size_t)row * D + c + 4) = v1;
                        u32x4 w; w.x = cvt_pk_bf16(v0[0], v0[1]); w.y = cvt_pk_bf16(v0[2], v0[3]); w.z = cvt_pk_bf16(v1[0], v1[1]); w.w = cvt_pk_bf16(v1[2], v1[3]);
                        *(u32x4*)(XBp + (size_t)row * D + c) = w;
                        q += (v0[0] * v0[0] + v0[1] * v0[1]) + (v0[2] * v0[2] + v0[3] * v0[3]) + (v1[0] * v1[0] + v1[1] * v1[1]) + (v1[2] * v1[2] + v1[3] * v1[3]); }
                }
                q += __shfl_xor(q, 16); q += __shfl_xor(q, 32);
                if (fq == 0 && row < MR) atomicAdd(ss + row, q);
            }
    }
};
struct EpiGU {
    bf16_t* Hp; const float* ss;
    __device__ __forceinline__ void operator()(const f32x4 (&acc)[2][2][4][2], const Unit& u, int wr, int wc, int fr, int fq) const {
        const int row0 = EPI_ROW0(u), col0 = u.pn * HALF + wc * 32 + 8 * fq;
#pragma unroll
        for (int ai = 0; ai < 2; ++ai)
#pragma unroll
            for (int m = 0; m < 4; ++m) { const int row = row0 + ai * HALF + m * 16; const float s = __builtin_amdgcn_rsqf(ss[row] * (1.f / D) + EPS);
                float o[8];
#pragma unroll
                for (int n = 0; n < 2; ++n)
#pragma unroll
                    for (int i = 0; i < 4; ++i) { const float gv = acc[ai][0][m][n][i] * s, uv = acc[ai][1][m][n][i] * s; o[n * 4 + i] = gv * sigmoidf_(gv) * uv; }
                u32x4 w; w.x = cvt_pk_bf16(o[0], o[1]); w.y = cvt_pk_bf16(o[2], o[3]); w.z = cvt_pk_bf16(o[4], o[5]); w.w = cvt_pk_bf16(o[6], o[7]);
                *(u32x4*)(Hp + (size_t)row * DFF + col0) = w; }
    }
};
struct EpiPle {
    float* X; const bf16_t* PEp; const float* ss2; float* ss3;
    __device__ __forceinline__ void operator()(const f32x4 (&acc)[2][2][4][2], const Unit& u, int wr, int wc, int fr, int fq) const {
        const int row0 = EPI_ROW0(u), col0 = EPI_COL0(u);
#pragma unroll
        for (int ai = 0; ai < 2; ++ai)
#pragma unroll
            for (int m = 0; m < 4; ++m) { const int row = row0 + ai * HALF + m * 16;
                float q = 0.f;
                if (row < MR) {
                    const float s = __builtin_amdgcn_rsqf(ss2[row] * (1.f / D) + EPS);
#pragma unroll
                    for (int bj = 0; bj < 2; ++bj) { const int c = col0 + bj * HALF;
                        const f32x4 b0 = *(const f32x4*)(X + (size_t)row * D + c), b1 = *(const f32x4*)(X + (size_t)row * D + c + 4);
                        const u32x4 pw = *(const u32x4*)(PEp + (size_t)row * D + c);
                        const float pe[8] = {bflo(pw.x), bfhi(pw.x), bflo(pw.y), bfhi(pw.y), bflo(pw.z), bfhi(pw.z), bflo(pw.w), bfhi(pw.w)};
                        f32x4 v0, v1;
#pragma unroll
                        for (int i = 0; i < 4; ++i) { v0[i] = b0[i] + sigmoidf_(acc[ai][bj][m][0][i] * s) * pe[i]; v1[i] = b1[i] + sigmoidf_(acc[ai][bj][m][1][i] * s) * pe[4 + i]; }
                        *(f32x4*)(X + (size_t)row * D + c) = v0; *(f32x4*)(X + (size_t)row * D + c + 4) = v1;
                        q += (v0[0] * v0[0] + v0[1] * v0[1]) + (v0[2] * v0[2] + v0[3] * v0[3]) + (v1[0] * v1[0] + v1[1] * v1[1]) + (v1[2] * v1[2] + v1[3] * v1[3]); }
                }
                q += __shfl_xor(q, 16); q += __shfl_xor(q, 32);
                if (fq == 0 && row < MR) atomicAdd(ss3 + row, q);
            }
    }
};
}

#define MFMA16(a, b, c) __builtin_amdgcn_mfma_f32_16x16x32_bf16((a), (b), (c), 0, 0, 0)
__device__ __forceinline__ float log_sigmoid_(float f) { return fminf(f, 0.f) - log1pf(__expf(-fabsf(f))); }
__device__ __forceinline__ void unpack8(const u32x4 w, float (&o)[8]) { o[0] = bflo(w.x); o[1] = bfhi(w.x); o[2] = bflo(w.y); o[3] = bfhi(w.y); o[4] = bflo(w.z); o[5] = bfhi(w.z); o[6] = bflo(w.w); o[7] = bfhi(w.w); }
__device__ __forceinline__ u32x4 pack8(const float (&o)[8]) { u32x4 w; w.x = pk2(o[0], o[1]); w.y = pk2(o[2], o[3]); w.z = pk2(o[4], o[5]); w.w = pk2(o[6], o[7]); return w; }

__device__ __forceinline__ void transpose_item(const float* W, int ldw, int col0, bf16_t* WT, int drow0, int ldt, const float* gk, float scal, LAS float* scr, int k0, int lane) {
#pragma unroll 8
    for (int i = 0; i < 32; ++i) { const int kk = 2 * i + (lane >> 5); const float gg = gk ? gk[k0 + kk] * scal : scal;
        scr[kk * 33 + (lane & 31)] = W[(size_t)(k0 + kk) * ldw + col0 + (lane & 31)] * gg; }
    asm volatile("s_waitcnt lgkmcnt(0)" ::: "memory");
    const int c = lane & 7;
#pragma unroll
    for (int j = 0; j < 4; ++j) { const int n = (lane >> 3) + 8 * j; const LAS float* s = scr + (8 * c) * 33 + n;
        u32x4 o; o.x = pk2(s[0 * 33], s[1 * 33]); o.y = pk2(s[2 * 33], s[3 * 33]); o.z = pk2(s[4 * 33], s[5 * 33]); o.w = pk2(s[6 * 33], s[7 * 33]);
        *(u32x4*)(WT + (size_t)(drow0 + n) * ldt + k0 + 8 * c) = o; }
    asm volatile("s_waitcnt lgkmcnt(0)" ::: "memory");
}

__device__ __forceinline__ void p0_prologue(const Args& a, LAS unsigned char* lds, int G) {
    int tid = threadIdx.x; asm volatile("" : "+v"(tid)); const int lane = tid & 63, wave = tid >> 6;
    unsigned char* ws = a.ws; asm volatile("" : "+s"(ws));
    float* sm = (float*)(ws + WS_SMALL);
    const int gw = blockIdx.x * 8 + wave, NGW = G * 8;
    LAS float* scr = (LAS float*)(lds + wave * 16384);
    constexpr int I0 = 16 * 96, I1 = 16 * 64, I2 = 16 * 32, I3 = 16 * 88, I4 = I3, I5 = 44 * 32, I6 = 16 * 32, I7 = 4 * 32, I8 = 4 * 32, I9 = I8, I10 = I8, I11 = 8 * 8, I12 = I11;
    constexpr int NIT = I0 + I1 + I2 + I3 + I4 + I5 + I6 + I7 + I8 + I9 + I10 + I11 + I12;
    for (int it = gw; it < NIT; it += NGW) {
        int r = it;
        if (r < I0) { const int kb = r / 96, nb = r % 96; transpose_item(INP(11), NIN, nb * 32, (bf16_t*)(ws + WS_W1T), nb * 32, D, INP(10), 1.f, scr, kb * 64, lane); continue; } r -= I0;
        if (r < I1) { const int kb = r / 64, nb = r % 64; transpose_item(INP(11), NIN, 3080 + nb * 32, (bf16_t*)(ws + WS_W1T), 3072 + nb * 32, D, INP(10), 1.f, scr, kb * 64, lane); continue; } r -= I1;
        if (r < I2) { const int kb = r / 32, nb = r % 32; transpose_item(INP(26), D, nb * 32, (bf16_t*)(ws + WS_WOT), nb * 32, D, nullptr, 1.f, scr, kb * 64, lane); continue; } r -= I2;
        if (r < I3) { const int kb = r / 88, nb = r % 88, n0 = nb * 32; transpose_item(INP(28), DFF, n0, (bf16_t*)(ws + WS_WGUT), (n0 / 128) * 256 + (n0 % 128), D, INP(27), 1.f, scr, kb * 64, lane); continue; } r -= I3;
        if (r < I4) { const int kb = r / 88, nb = r % 88, n0 = nb * 32; transpose_item(INP(29), DFF, n0, (bf16_t*)(ws + WS_WGUT), (n0 / 128) * 256 + 128 + (n0 % 128), D, INP(27), 1.f, scr, kb * 64, lane); continue; } r -= I4;
        if (r < I5) { const int kb = r / 32, nb = r % 32; transpose_item(INP(30), D, nb * 32, (bf16_t*)(ws + WS_WDT), nb * 32, DFF, nullptr, 1.f, scr, kb * 64, lane); continue; } r -= I5;
        if (r < I6) { const int kb = r / 32, nb = r % 32; transpose_item(INP(32), D, nb * 32, (bf16_t*)(ws + WS_WPGT), nb * 32, D, INP(31), 1.f, scr, kb * 64, lane); continue; } r -= I6;
        if (r < I7) { const int kb = r / 32, nb = r % 32; transpose_item(INP(33), D, nb * 32, (bf16_t*)(ws + WS_WPT), nb * 32, PD, nullptr, 1.f, scr, kb * 64, lane); continue; } r -= I7;
        if (r < I8) { const int h = r / 32, q = r % 32, kb = q / 8, nb = q % 8; transpose_item(INP(22) + (size_t)h * 65536, HD, nb * 32, (bf16_t*)(ws + WS_WQKT) + (size_t)h * 512 * 256, nb * 32, HD, nullptr, 0.0625f, scr, kb * 64, lane); continue; } r -= I8;
        if (r < I9) { const int h = r / 32, q = r % 32, kb = q / 8, nb = q % 8; transpose_item(INP(23) + (size_t)h * 65536, HD, nb * 32, (bf16_t*)(ws + WS_WQKT) + (size_t)h * 512 * 256, 256 + nb * 32, HD, nullptr, 1.f, scr, kb * 64, lane); continue; } r -= I9;
        if (r < I10) { const int h = r / 32, q = r % 32, kb = q / 8, nb = q % 8; transpose_item(INP(24) + (size_t)h * 65536, HD, nb * 32, (bf16_t*)(ws + WS_WVT) + (size_t)h * 65536, nb * 32, HD, nullptr, 1.f, scr, kb * 64, lane); continue; } r -= I10;
        if (r < I11) { const int bl = r / 8, q = r % 8, kb = q / 4, nb = q % 4; transpose_item(INP(15) + (size_t)bl * 16384, 128, nb * 32, (bf16_t*)(ws + WS_WLRUT) + (size_t)bl * 256 * 128, nb * 32, 128, nullptr, 1.f, scr, kb * 64, lane); continue; } r -= I11;
        { const int bl = r / 8, q = r % 8, kb = q / 4, nb = q % 4; transpose_item(INP(17) + (size_t)bl * 16384, 128, nb * 32, (bf16_t*)(ws + WS_WLRUT) + (size_t)bl * 256 * 128, 128 + nb * 32, 128, nullptr, 1.f, scr, kb * 64, lane); }
    }
    __syncthreads();
    LAS float* gwL = (LAS float*)lds;
    for (int i = tid; i < 8192; i += NT) { const int j = i >> 10, k = i & 1023; gwL[i] = INP(10)[k] * INP(11)[(size_t)k * NIN + 3072 + j]; }
    __syncthreads();
    bf16_t* XB = (bf16_t*)(ws + WS_XB);
    for (int row = gw; row < M; row += NGW) {
        unsigned long long* o8 = (unsigned long long*)(XB + (size_t)row * D) + lane;
        if (row >= MR) {
#pragma unroll
            for (int j = 0; j < 4; ++j) o8[64 * j] = 0ull;
            if (lane == 0) sm[SM_RSTD0 + row] = 0.f;
            continue;
        }
        const f32x4* xr = (const f32x4*)xrow_ptr(a, row) + lane;
        f32x4 v[4]; float s = 0.f;
#pragma unroll
        for (int j = 0; j < 4; ++j) { v[j] = xr[64 * j]; s += (v[j].x * v[j].x + v[j].y * v[j].y) + (v[j].z * v[j].z + v[j].w * v[j].w); }
        float dt[8];
#pragma unroll
        for (int jj = 0; jj < 8; ++jj) { float d = 0.f;
#pragma unroll
            for (int j = 0; j < 4; ++j) { const f32x4 w = *(const LAS f32x4*)(gwL + jj * 1024 + j * 256 + lane * 4); d += (v[j].x * w.x + v[j].y * w.y) + (v[j].z * w.z + v[j].w * w.w); }
            dt[jj] = wave_sum(d); }
        s = wave_sum(s);
        const float rstd = 1.0f / sqrtf(s * (1.f / D) + EPS);
#pragma unroll
        for (int j = 0; j < 4; ++j) o8[64 * j] = (unsigned long long)pk2(v[j].x, v[j].y) | ((unsigned long long)pk2(v[j].z, v[j].w) << 32);
        if (lane == 0) { sm[SM_RSTD0 + row] = rstd;
#pragma unroll
            for (int jj = 0; jj < 4; ++jj) { sm[SM_GI + row * 4 + jj] = dt[jj] * rstd + INP(12)[jj]; sm[SM_GF + row * 4 + jj] = dt[4 + jj] * rstd + INP(12)[4 + jj]; } }
    }
    const int gt = blockIdx.x * NT + tid, NGT = G * NT;
    bf16_t* PB = (bf16_t*)(ws + WS_PB);
    for (int i = gt; i < M * (PD / 4); i += NGT) { const int row = i >> 6, c4 = (i & 63) * 4;
        f32x4 v = (f32x4){0.f, 0.f, 0.f, 0.f};
        if (row < MP) v = *(const f32x4*)(INP(8) + (size_t)row * PD + c4); else if (row < MR) v = *(const f32x4*)(INP(9) + (size_t)(row - MP) * PD + c4);
        *(unsigned long long*)(PB + (size_t)row * PD + c4) = (unsigned long long)pk2(v.x, v.y) | ((unsigned long long)pk2(v.z, v.w) << 32); }
    for (int i = gt; i < 3 * M; i += NGT) sm[SM_SS1 + i] = 0.f;
}

__device__ __forceinline__ void p2a_item(const Args& a, LAS unsigned char* lds, int idx) {
    int tid = threadIdx.x; asm volatile("" : "+v"(tid)); const int lane = tid & 63, wave = tid >> 6;
    unsigned char* ws = a.ws; asm volatile("" : "+s"(ws)); float* sm = (float*)(ws + WS_SMALL);
    const bf16_t* Z = (const bf16_t*)(ws + WS_Z); bf16_t* XC = (bf16_t*)(ws + WS_XC);
    if (idx >= 2048) {
        const int sb = idx - 2048, row = MP + sb;
#pragma unroll
        for (int cc = 0; cc < 2; ++cc) { const int ch = tid * 2 + cc;
            { const float s0 = INP(2)[((size_t)sb * 3 + 0) * D + ch], s1 = INP(2)[((size_t)sb * 3 + 1) * D + ch], s2 = INP(2)[((size_t)sb * 3 + 2) * D + ch], xv = bf2f(Z[(size_t)row * NZ + ch]);
              const float o = INP(14)[ch] + INP(13)[ch] * s0 + INP(13)[D + ch] * s1 + INP(13)[2 * D + ch] * s2 + INP(13)[3 * D + ch] * xv;
              sm[SM_XLS + sb * D + ch] = o;
              a.out[O_SLC + ((size_t)sb * 3 + 0) * D + ch] = s1; a.out[O_SLC + ((size_t)sb * 3 + 1) * D + ch] = s2; a.out[O_SLC + ((size_t)sb * 3 + 2) * D + ch] = xv; }
            { const float s0 = INP(4)[((size_t)sb * 3 + 0) * D + ch], s1 = INP(4)[((size_t)sb * 3 + 1) * D + ch], s2 = INP(4)[((size_t)sb * 3 + 2) * D + ch], xv = bf2f(Z[(size_t)row * NZ + 1024 + ch]);
              const float o = INP(21)[ch] + INP(20)[ch] * s0 + INP(20)[D + ch] * s1 + INP(20)[2 * D + ch] * s2 + INP(20)[3 * D + ch] * xv;
              XC[(size_t)row * D + ch] = (bf16_t)f2bf(o * sigmoidf_(o));
              a.out[O_SMC + ((size_t)sb * 3 + 0) * D + ch] = s1; a.out[O_SMC + ((size_t)sb * 3 + 1) * D + ch] = s2; a.out[O_SMC + ((size_t)sb * 3 + 2) * D + ch] = xv; }
        }
        return;
    }
    const int cb = idx & 7, tt = (idx >> 3) & 31, b = idx >> 8;
    LAS bf16_t* AL = (LAS bf16_t*)lds;
    LAS float* U = (LAS float*)(lds + 17408);
    LAS float* AA = (LAS float*)(lds + 17408 + 32768);
    const int t0 = tt * 64, tokb = b * T;
    {
        const int c8 = tid & 15, rs = tid >> 4, chl = cb * 128 + c8 * 8;
        float wl[4][8], wm[4][8], bl[8], bm[8];
#pragma unroll
        for (int j = 0; j < 4; ++j)
#pragma unroll
            for (int i = 0; i < 8; ++i) { wl[j][i] = INP(13)[j * D + chl + i]; wm[j][i] = INP(20)[j * D + chl + i]; }
#pragma unroll
        for (int i = 0; i < 8; ++i) { bl[i] = INP(14)[chl + i]; bm[i] = INP(21)[chl + i]; }
#pragma unroll
        for (int rr = 0; rr < 2; ++rr) { const int tl = rs + 32 * rr, tg = t0 + tl;
            float ol[8], om[8], xl3[8], xm3[8];
#pragma unroll
            for (int i = 0; i < 8; ++i) { ol[i] = bl[i]; om[i] = bm[i]; xl3[i] = 0.f; xm3[i] = 0.f; }
#pragma unroll
            for (int j = 0; j < 4; ++j) { const int ts = tg - 3 + j;
                if (ts >= 0) { float xl[8], xm[8];
                    unpack8(*(const u32x4*)(Z + (size_t)(tokb + ts) * NZ + chl), xl); unpack8(*(const u32x4*)(Z + (size_t)(tokb + ts) * NZ + 1024 + chl), xm);
#pragma unroll
                    for (int i = 0; i < 8; ++i) { ol[i] += wl[j][i] * xl[i]; om[i] += wm[j][i] * xm[i]; if (j == 3) { xl3[i] = xl[i]; xm3[i] = xm[i]; } } } }
            *(LAS u32x4*)(AL + tl * 136 + c8 * 8) = pack8(ol);
            *(LAS f32x4*)(U + tl * 128 + c8 * 8) = (f32x4){ol[0], ol[1], ol[2], ol[3]}; *(LAS f32x4*)(U + tl * 128 + c8 * 8 + 4) = (f32x4){ol[4], ol[5], ol[6], ol[7]};
            float xs[8];
#pragma unroll
            for (int i = 0; i < 8; ++i) xs[i] = om[i] * sigmoidf_(om[i]);
            *(u32x4*)(XC + (size_t)(tokb + tg) * D + chl) = pack8(xs);
            if (tg >= T - 3) { const int j3 = tg - (T - 3);
#pragma unroll
                for (int i = 0; i < 8; ++i) { a.out[O_PLC + ((size_t)b * 3 + j3) * D + chl + i] = xl3[i]; a.out[O_PMC + ((size_t)b * 3 + j3) * D + chl + i] = xm3[i]; } }
        }
    }
    __syncthreads();
    {
        const int fr = lane & 15, fq = lane >> 4;
        const bf16_t* Wl = (const bf16_t*)(ws + WS_WLRUT) + (size_t)cb * 256 * 128;
        f32x4 ar[4], ai[4];
#pragma unroll
        for (int m = 0; m < 4; ++m) { ar[m] = (f32x4){0.f, 0.f, 0.f, 0.f}; ai[m] = (f32x4){0.f, 0.f, 0.f, 0.f}; }
#pragma unroll
        for (int ks = 0; ks < 4; ++ks) {
            const bf16x8 br = *(const bf16x8*)(Wl + (size_t)(16 * wave + fr) * 128 + ks * 32 + fq * 8);
            const bf16x8 bi = *(const bf16x8*)(Wl + (size_t)(128 + 16 * wave + fr) * 128 + ks * 32 + fq * 8);
#pragma unroll
            for (int m = 0; m < 4; ++m) { const bf16x8 af = *(const LAS bf16x8*)(AL + (m * 16 + fr) * 136 + ks * 32 + fq * 8);
                ar[m] = MFMA16(af, br, ar[m]); ai[m] = MFMA16(af, bi, ai[m]); }
        }
        const int c = 16 * wave + fr, ch = cb * 128 + c;
        const float ba = INP(16)[ch], bx = INP(18)[ch], lam = INP(19)[ch];
        const float sp = fmaxf(-lam, 0.f) + log1pf(__expf(-fabsf(lam)));
#pragma unroll
        for (int m = 0; m < 4; ++m)
#pragma unroll
            for (int j = 0; j < 4; ++j) { const int t = m * 16 + fq * 4 + j;
                const float r = sigmoidf_(ar[m][j] + ba), ig = sigmoidf_(ai[m][j] + bx);
                const float la = -8.0f * r * sp, av = __expf(la);
                const float uv = sqrtf(-expm1f(2.f * la)) * ig * U[t * 128 + c];
                AA[t * 128 + c] = av; U[t * 128 + c] = uv; }
    }
    __syncthreads();
    {
        const int c = tid & 127, seg = tid >> 7;
        float h = 0.f, P = 1.f;
#pragma unroll
        for (int i = 0; i < 16; ++i) { const int t = seg * 16 + i; const float av = AA[t * 128 + c], uv = U[t * 128 + c]; h = av * h + uv; P *= av; U[t * 128 + c] = h; AA[t * 128 + c] = P; }
        __syncthreads();
        float hc = 0.f, pc = 1.f;
        for (int s = 0; s < seg; ++s) { const int te = s * 16 + 15; const float pe = AA[te * 128 + c]; hc = pe * hc + U[te * 128 + c]; pc *= pe; }
        __syncthreads();
        if (seg > 0) {
#pragma unroll
            for (int i = 0; i < 16; ++i) { const int t = seg * 16 + i; const float pv = AA[t * 128 + c]; U[t * 128 + c] += pv * hc; AA[t * 128 + c] = pv * pc; }
        }
    }
    __syncthreads();
    {
        const int c8 = tid & 15, rs = tid >> 4, chl = cb * 128 + c8 * 8;
        bf16_t* HL = (bf16_t*)(ws + WS_HLOC); bf16_t* CA = (bf16_t*)(ws + WS_CUMA);
#pragma unroll
        for (int rr = 0; rr < 2; ++rr) { const int tl = rs + 32 * rr; float hv[8], cv[8];
#pragma unroll
            for (int i = 0; i < 8; ++i) { hv[i] = U[tl * 128 + c8 * 8 + i]; cv[i] = AA[tl * 128 + c8 * 8 + i]; }
            *(u32x4*)(HL + (size_t)(tokb + t0 + tl) * D + chl) = pack8(hv); *(u32x4*)(CA + (size_t)(tokb + t0 + tl) * D + chl) = pack8(cv); }
        if (tid < 128) { sm[SM_LRA + (b * 32 + tt) * D + cb * 128 + tid] = AA[63 * 128 + tid]; sm[SM_LRH + (b * 32 + tt) * D + cb * 128 + tid] = U[63 * 128 + tid]; }
    }
    __syncthreads();
}

__device__ __forceinline__ float block_excl_sum(float v, LAS float* red, int tid) {
    const int lane = tid & 63, wave = tid >> 6; float inc = v;
#pragma unroll
    for (int o = 1; o < 64; o <<= 1) { const float t = __shfl_up(inc, o); if (lane >= o) inc += t; }
    __syncthreads();
    if (lane == 63) red[wave] = inc;
    __syncthreads();
    float base = 0.f;
    for (int w = 0; w < wave; ++w) base += red[w];
    return base + inc - v;
}
__device__ __forceinline__ float block_excl_max(float v, LAS float* red, int tid) {
    const int lane = tid & 63, wave = tid >> 6; float inc = v;
#pragma unroll
    for (int o = 1; o < 64; o <<= 1) { const float t = __shfl_up(inc, o); if (lane >= o) inc = fmaxf(inc, t); }
    __syncthreads();
    if (lane == 63) red[wave] = inc;
    __syncthreads();
    float base = -INFINITY;
    for (int w = 0; w < wave; ++w) base = fmaxf(base, red[w]);
    const float prev = __shfl_up(inc, 1);
    return fmaxf(base, lane > 0 ? prev : -INFINITY);
}
__device__ __forceinline__ void gate_scan(const Args& a, LAS unsigned char* lds, int bh) {
    int tid = threadIdx.x; asm volatile("" : "+v"(tid)); float* sm = (float*)(a.ws + WS_SMALL);
    LAS float* BCl = (LAS float*)lds; LAS float* MMl = BCl + T; LAS float* red = MMl + T;
    const int b = bh >> 2, h = bh & 3;
    float lf[4], ig[4], bc[4], gv[4], pmx[4];
#pragma unroll
    for (int i = 0; i < 4; ++i) { const int row = b * T + tid * 4 + i; lf[i] = log_sigmoid_(sm[SM_GF + row * 4 + h]); ig[i] = sm[SM_GI + row * 4 + h]; }
    const float tot = (lf[0] + lf[1]) + (lf[2] + lf[3]);
    const float ex = block_excl_sum(tot, red, tid);
    float run = ex;
#pragma unroll
    for (int i = 0; i < 4; ++i) { run += lf[i]; bc[i] = run; gv[i] = ig[i] - run; }
    const float lm = fmaxf(fmaxf(gv[0], gv[1]), fmaxf(gv[2], gv[3]));
    const float exm = block_excl_max(lm, red, tid);
    float rm = exm;
#pragma unroll
    for (int i = 0; i < 4; ++i) { rm = fmaxf(rm, gv[i]); pmx[i] = rm; BCl[tid * 4 + i] = bc[i]; MMl[tid * 4 + i] = bc[i] + rm; }
    __syncthreads();
#pragma unroll
    for (int i = 0; i < 4; ++i) { const int t = tid * 4 + i, c = t >> 6;
        const float Bprev = c ? BCl[64 * c - 1] : 0.f, mprev = c ? MMl[64 * c - 1] : M_INIT, Blast = BCl[64 * c + 63], mlast = MMl[64 * c + 63];
        const float mm = bc[i] + pmx[i];
        sm[SM_BM + bh * T + t] = -pmx[i]; sm[SM_GIB + bh * T + t] = gv[i]; sm[SM_MM + bh * T + t] = mm;
        sm[SM_SC + bh * T + t] = __expf(bc[i] - Bprev + mprev - mm);
        sm[SM_WK + bh * T + t] = __expf(Blast - bc[i] + ig[i] - mlast);
        if ((t & 63) == 0) sm[SM_DEC + bh * 32 + c] = __expf(Blast - Bprev + mprev - mlast);
        if (t == T - 1) a.out[O_PM + bh] = mm; }
    __syncthreads();
}

__device__ __forceinline__ void p3_item(const Args& a, LAS unsigned char* lds, int idx) {
    int tid = threadIdx.x; asm volatile("" : "+v"(tid)); const int lane = tid & 63, wave = tid >> 6, fr = lane & 15, fq = lane >> 4;
    unsigned char* ws = a.ws; asm volatile("" : "+s"(ws)); float* sm = (float*)(ws + WS_SMALL);
    const int es = idx & 7, bh = idx >> 3, b = bh >> 2, h = bh & 3;
    const bf16_t* Q = (const bf16_t*)(ws + WS_Q); const bf16_t* KT = (const bf16_t*)(ws + WS_KT); const bf16_t* VT = (const bf16_t*)(ws + WS_VT);
    bf16_t* NUMI = (bf16_t*)(ws + WS_XC);
    LAS bf16_t* CT = (LAS bf16_t*)lds;
    f32x4 acc[2][2];
#pragma unroll
    for (int e = 0; e < 2; ++e)
#pragma unroll
        for (int d = 0; d < 2; ++d) acc[e][d] = (f32x4){0.f, 0.f, 0.f, 0.f};
    for (int i = tid; i < 32 * 264 / 2; i += NT) ((LAS unsigned*)CT)[i] = 0u;
    float nval = 0.f;
    const int nd = 32 * wave + (lane & 31), nhalf = lane >> 5;
    __syncthreads();
    for (int c = 0; c < NCH; ++c) {
        const int tok0 = b * T + c * 64, gb = bh * T + c * 64;
        if (c > 0) {
            const int mt = wave >> 1, et = wave & 1;
            f32x4 ai = (f32x4){0.f, 0.f, 0.f, 0.f};
#pragma unroll
            for (int ks = 0; ks < 8; ++ks) { const bf16x8 cf = *(const LAS bf16x8*)(CT + (et * 16 + fr) * 264 + ks * 32 + fq * 8);
                const bf16x8 qf = *(const bf16x8*)(Q + (size_t)(tok0 + mt * 16 + fr) * D + h * 256 + ks * 32 + fq * 8);
                ai = MFMA16(cf, qf, ai); }
            const float sc = sm[SM_SC + gb + mt * 16 + fr];
            u32x2 w; w.x = pk2(ai[0] * sc, ai[1] * sc); w.y = pk2(ai[2] * sc, ai[3] * sc);
            *(u32x2*)(NUMI + (size_t)(tok0 + mt * 16 + fr) * D + h * 256 + es * 32 + et * 16 + fq * 4) = w;
        }
        if (es == 0 && nhalf == 0) sm[SM_NST + (bh * 32 + c) * 256 + nd] = nval;
        __syncthreads();
        const float dec = sm[SM_DEC + bh * 32 + c];
#pragma unroll
        for (int e = 0; e < 2; ++e)
#pragma unroll
            for (int d = 0; d < 2; ++d) acc[e][d] = acc[e][d] * dec;
#pragma unroll
        for (int ks = 0; ks < 2; ++ks) {
            const f32x4 w0 = *(const f32x4*)(sm + SM_WK + gb + ks * 32 + fq * 8), w1 = *(const f32x4*)(sm + SM_WK + gb + ks * 32 + fq * 8 + 4);
            bf16x8 vf[2], kf[2];
#pragma unroll
            for (int e = 0; e < 2; ++e) { float vv[8]; unpack8(*(const u32x4*)(VT + (size_t)(h * 256 + es * 32 + e * 16 + fr) * M + tok0 + ks * 32 + fq * 8), vv);
                vv[0] *= w0[0]; vv[1] *= w0[1]; vv[2] *= w0[2]; vv[3] *= w0[3]; vv[4] *= w1[0]; vv[5] *= w1[1]; vv[6] *= w1[2]; vv[7] *= w1[3];
                const u32x4 pw = pack8(vv); vf[e] = __builtin_bit_cast(bf16x8, pw); }
#pragma unroll
            for (int d = 0; d < 2; ++d) kf[d] = *(const bf16x8*)(KT + (size_t)(h * 256 + 32 * wave + d * 16 + fr) * M + tok0 + ks * 32 + fq * 8);
#pragma unroll
            for (int e = 0; e < 2; ++e)
#pragma unroll
                for (int d = 0; d < 2; ++d) acc[e][d] = MFMA16(vf[e], kf[d], acc[e][d]);
        }
        if (es == 0) {
            float part = 0.f;
#pragma unroll
            for (int q4 = 0; q4 < 4; ++q4) { float kk[8]; unpack8(*(const u32x4*)(KT + (size_t)(h * 256 + nd) * M + tok0 + nhalf * 32 + q4 * 8), kk);
                const f32x4 w0 = *(const f32x4*)(sm + SM_WK + gb + nhalf * 32 + q4 * 8), w1 = *(const f32x4*)(sm + SM_WK + gb + nhalf * 32 + q4 * 8 + 4);
                part += (kk[0] * w0[0] + kk[1] * w0[1]) + (kk[2] * w0[2] + kk[3] * w0[3]) + (kk[4] * w1[0] + kk[5] * w1[1]) + (kk[6] * w1[2] + kk[7] * w1[3]); }
            part += __shfl_xor(part, 32);
            nval = dec * nval + part;
        }
#pragma unroll
        for (int e = 0; e < 2; ++e)
#pragma unroll
            for (int d = 0; d < 2; ++d)
#pragma unroll
                for (int j = 0; j < 4; ++j) CT[(e * 16 + fq * 4 + j) * 264 + 32 * wave + d * 16 + fr] = (bf16_t)f2bf(acc[e][d][j]);
        __syncthreads();
    }
#pragma unroll
    for (int e = 0; e < 2; ++e)
#pragma unroll
        for (int d = 0; d < 2; ++d) *(f32x4*)(a.out + O_PC + ((size_t)bh * 256 + 32 * wave + d * 16 + fr) * 256 + es * 32 + e * 16 + fq * 4) = acc[e][d];
    if (es == 0 && nhalf == 0) a.out[O_PN + bh * 256 + nd] = nval;
    __syncthreads();
}

__device__ __forceinline__ void sample_item(const Args& a, LAS unsigned char* lds, int idx) {
    int tid = threadIdx.x; asm volatile("" : "+v"(tid)); const int lane = tid & 63, wave = tid >> 6;
    unsigned char* ws = a.ws; asm volatile("" : "+s"(ws)); float* sm = (float*)(ws + WS_SMALL);
    const int sb = idx >> 2, h = idx & 3, row = MP + sb, sh = sb * 4 + h;
    const bf16_t* Q = (const bf16_t*)(ws + WS_Q); const bf16_t* Kb = (const bf16_t*)(ws + WS_K); const bf16_t* VT = (const bf16_t*)(ws + WS_VT); const bf16_t* Z = (const bf16_t*)(ws + WS_Z);
    LAS float* qs = (LAS float*)lds; LAS float* ks = qs + 256; LAS float* vs = ks + 256; LAS float* red = vs + 256  ; LAS float* r2 = red + 2048  ;
    if (tid < 256) { qs[tid] = bf2f(Q[(size_t)row * D + h * 256 + tid]); ks[tid] = bf2f(Kb[(size_t)row * D + h * 256 + tid]); vs[tid] = bf2f(VT[(size_t)(h * 256 + tid) * M + row]); }
    const float fpre = sm[SM_GF + row * 4 + h], ipre = sm[SM_GI + row * 4 + h], lf = log_sigmoid_(fpre), m0 = INP(7)[sh];
    const float mn = fmaxf(lf + m0, ipre), dec = __expf(lf + m0 - mn), wkk = __expf(ipre - mn);
    __syncthreads();
    {
        const int e4 = (tid & 63) * 4, dr = tid >> 6;
        const f32x4 v4 = *(const LAS f32x4*)(vs + e4);
        f32x4 ac = (f32x4){0.f, 0.f, 0.f, 0.f};
        const float* C0 = INP(5) + (size_t)sh * 65536; float* C1 = a.out + O_SC + (size_t)sh * 65536;
#pragma unroll 4
        for (int d = dr; d < 256; d += 8) { const f32x4 c0 = *(const f32x4*)(C0 + (size_t)d * 256 + e4); const float kd = ks[d] * wkk;
            const f32x4 cn = c0 * dec + v4 * kd; *(f32x4*)(C1 + (size_t)d * 256 + e4) = cn; ac += cn * qs[d]; }
        *(LAS f32x4*)(red + dr * 256 + e4) = ac;
    }
    float dn = 0.f;
    if (tid < 256) { const float nn = dec * INP(6)[sh * 256 + tid] + wkk * ks[tid]; a.out[O_SN + sh * 256 + tid] = nn; dn = qs[tid] * nn; }
    dn = wave_sum(dn);
    if (lane == 0) r2[wave] = dn;
    __syncthreads();
    const float den = (r2[0] + r2[1]) + (r2[2] + r2[3]);
    float hv = 0.f;
    if (tid < 256) { float num = 0.f;
#pragma unroll
        for (int r = 0; r < 8; ++r) num += red[r * 256 + tid];
        hv = num / fmaxf(fabsf(den), __expf(-mn)); }
    const float hq = wave_sum(hv * hv);
    if (lane == 0) r2[8 + wave] = hq;
    __syncthreads();
    if (tid < 256) {
        const float rs = 1.0f / sqrtf(((r2[8] + r2[9]) + (r2[10] + r2[11])) * (1.f / 256.f) + EPS);
        const int ch = h * 256 + tid, blk = ch >> 7, dd = ch & 127;
        const float ym = hv * rs * INP(25)[ch] * sigmoidf_(bf2f(Z[(size_t)row * NZ + 2048 + ch]));
        const float* xl = sm + SM_XLS + sb * D + blk * 128; const float* wa = INP(15) + (size_t)blk * 16384 + dd; const float* wx = INP(17) + (size_t)blk * 16384 + dd;
        float rp = INP(16)[ch], ip = INP(18)[ch];
#pragma unroll 8
        for (int c = 0; c < 128; ++c) { const float xv = xl[c]; rp += xv * wa[c * 128]; ip += xv * wx[c * 128]; }
        const float lam = INP(19)[ch], sp = fmaxf(-lam, 0.f) + log1pf(__expf(-fabsf(lam)));
        const float r = sigmoidf_(rp), ig = sigmoidf_(ip), la = -8.0f * r * sp, av = __expf(la);
        const float uv = sqrtf(-expm1f(2.f * la)) * ig * sm[SM_XLS + sb * D + ch];
        const float hn = av * INP(3)[sb * D + ch] + uv;
        a.out[O_SLH + sb * D + ch] = hn;
        const float mg = sigmoidf_(bf2f(Z[(size_t)row * NZ + 3072 + ch])) * hn + sigmoidf_(bf2f(Z[(size_t)row * NZ + 4096 + ch])) * ym;
        ((bf16_t*)(ws + WS_XB))[(size_t)row * D + ch] = (bf16_t)f2bf(mg);
        if (tid == 0) a.out[O_SM + sh] = mn;
    }
    __syncthreads();
}

__device__ __forceinline__ void p4_item(const Args& a, LAS unsigned char* lds, int idx) {
    int tid = threadIdx.x; asm volatile("" : "+v"(tid)); const int lane = tid & 63, wave = tid >> 6, fr = lane & 15, fq = lane >> 4;
    unsigned char* ws = a.ws; asm volatile("" : "+s"(ws)); float* sm = (float*)(ws + WS_SMALL);
    const int h = idx & 3, c = (idx >> 2) & 31, b = idx >> 7, bh = b * 4 + h, tok0 = b * T + c * 64, gb = bh * T + c * 64;
    const bf16_t* Q = (const bf16_t*)(ws + WS_Q); const bf16_t* Kb = (const bf16_t*)(ws + WS_K); const bf16_t* VT = (const bf16_t*)(ws + WS_VT); const bf16_t* Z = (const bf16_t*)(ws + WS_Z);
    const bf16_t* NUMI = (const bf16_t*)(ws + WS_XC); const bf16_t* HL = (const bf16_t*)(ws + WS_HLOC); const bf16_t* CA = (const bf16_t*)(ws + WS_CUMA);
    bf16_t* MG = (bf16_t*)(ws + WS_XB);
    LAS bf16_t* Sl = (LAS bf16_t*)lds;
    LAS float* DENP = (LAS float*)(lds + 9216);
    LAS float* HSQ = (LAS float*)(lds + 10240);
    LAS float* CARRY = (LAS float*)(lds + 12288);
    LAS float* NC = (LAS float*)(lds + 13312);
    LAS float* DI = (LAS float*)(lds + 14336);
    if (tid < 256) { const int ch = h * 256 + tid; float cr = 0.f;
        for (int j = 0; j < c; ++j) cr = sm[SM_LRA + (b * 32 + j) * D + ch] * cr + sm[SM_LRH + (b * 32 + j) * D + ch];
        CARRY[tid] = cr;
        if (c == NCH - 1) a.out[O_PLH + b * D + ch] = sm[SM_LRA + (b * 32 + c) * D + ch] * cr + sm[SM_LRH + (b * 32 + c) * D + ch];
        NC[tid] = sm[SM_NST + (bh * 32 + c) * 256 + tid]; }
    __syncthreads();
    {
        const int t = tid >> 3, part = tid & 7; float d = 0.f;
#pragma unroll
        for (int q4 = 0; q4 < 4; ++q4) { float qq[8]; unpack8(*(const u32x4*)(Q + (size_t)(tok0 + t) * D + h * 256 + part * 32 + q4 * 8), qq);
#pragma unroll
            for (int i = 0; i < 8; ++i) d += qq[i] * NC[part * 32 + q4 * 8 + i]; }
        d += __shfl_xor(d, 1); d += __shfl_xor(d, 2); d += __shfl_xor(d, 4);
        if (part == 0) DI[t] = d * sm[SM_SC + gb + t];
    }
    {
        const int st = wave >> 1;
        bf16x8 kf[8];
#pragma unroll
        for (int ks = 0; ks < 8; ++ks) kf[ks] = *(const bf16x8*)(Kb + (size_t)(tok0 + st * 16 + fr) * D + h * 256 + ks * 32 + fq * 8);
        const f32x4 gib = *(const f32x4*)(sm + SM_GIB + gb + st * 16 + fq * 4);
#pragma unroll
        for (int q2 = 0; q2 < 2; ++q2) { const int tt = (wave & 1) * 2 + q2;
            f32x4 sa = (f32x4){0.f, 0.f, 0.f, 0.f};
#pragma unroll
            for (int ks = 0; ks < 8; ++ks) { const bf16x8 qf = *(const bf16x8*)(Q + (size_t)(tok0 + tt * 16 + fr) * D + h * 256 + ks * 32 + fq * 8); sa = MFMA16(kf[ks], qf, sa); }
            const int t = tt * 16 + fr; const float bm = sm[SM_BM + gb + t];
            float vv[4], ds = 0.f;
#pragma unroll
            for (int j = 0; j < 4; ++j) { const int s = st * 16 + fq * 4 + j; vv[j] = (s <= t) ? sa[j] * __expf(bm + gib[j]) : 0.f; ds += vv[j]; }
            ds += __shfl_xor(ds, 16); ds += __shfl_xor(ds, 32);
            if (fq == 0) DENP[st * 64 + t] = ds;
            u32x2 w; w.x = pk2(vv[0], vv[1]); w.y = pk2(vv[2], vv[3]);
            *(LAS u32x2*)(Sl + t * 72 + st * 16 + fq * 4) = w; }
    }
    __syncthreads();
    f32x4 acc[2][4];
#pragma unroll
    for (int e = 0; e < 2; ++e)
#pragma unroll
        for (int t4 = 0; t4 < 4; ++t4) acc[e][t4] = (f32x4){0.f, 0.f, 0.f, 0.f};
#pragma unroll
    for (int ks = 0; ks < 2; ++ks) { bf16x8 vf[2];
#pragma unroll
        for (int e = 0; e < 2; ++e) vf[e] = *(const bf16x8*)(VT + (size_t)(h * 256 + 32 * wave + e * 16 + fr) * M + tok0 + ks * 32 + fq * 8);
#pragma unroll
        for (int t4 = 0; t4 < 4; ++t4) { const bf16x8 sf = *(const LAS bf16x8*)(Sl + (t4 * 16 + fr) * 72 + ks * 32 + fq * 8);
#pragma unroll
            for (int e = 0; e < 2; ++e) acc[e][t4] = MFMA16(vf[e], sf, acc[e][t4]); } }
#pragma unroll
    for (int t4 = 0; t4 < 4; ++t4) { const int t = t4 * 16 + fr; const size_t tok = (size_t)(tok0 + t);
        const float den = ((DENP[t] + DENP[64 + t]) + (DENP[128 + t] + DENP[192 + t])) + DI[t];
        const float inv = 1.0f / fmaxf(fabsf(den), __expf(-sm[SM_MM + gb + t]));
        float hq = 0.f;
#pragma unroll
        for (int e = 0; e < 2; ++e) { const int e0 = 32 * wave + e * 16 + fq * 4; float ni[4] = {0.f, 0.f, 0.f, 0.f};
            if (c > 0) { const u32x2 w = *(const u32x2*)(NUMI + tok * D + h * 256 + e0); ni[0] = bflo(w.x); ni[1] = bfhi(w.x); ni[2] = bflo(w.y); ni[3] = bfhi(w.y); }
#pragma unroll
            for (int j = 0; j < 4; ++j) { const float hv = (acc[e][t4][j] + ni[j]) * inv; acc[e][t4][j] = hv; hq += hv * hv; } }
        hq += __shfl_xor(hq, 16); hq += __shfl_xor(hq, 32);
        if (fq == 0) HSQ[wave * 64 + t] = hq; }
    __syncthreads();
#pragma unroll
    for (int t4 = 0; t4 < 4; ++t4) { const int t = t4 * 16 + fr; const size_t tok = (size_t)(tok0 + t);
        float tot = 0.f;
#pragma unroll
        for (int w = 0; w < 8; ++w) tot += HSQ[w * 64 + t];
        const float rs = 1.0f / sqrtf(tot * (1.f / 256.f) + EPS);
#pragma unroll
        for (int e = 0; e < 2; ++e) { const int el = 32 * wave + e * 16 + fq * 4, ch = h * 256 + el;
            const f32x4 mg = *(const f32x4*)(INP(25) + ch); const f32x4 cr = *(const LAS f32x4*)(CARRY + el);
            const u32x2 ow = *(const u32x2*)(Z + tok * NZ + 2048 + ch), glw = *(const u32x2*)(Z + tok * NZ + 3072 + ch), gmw = *(const u32x2*)(Z + tok * NZ + 4096 + ch);
            const u32x2 hlw = *(const u32x2*)(HL + tok * D + ch), caw = *(const u32x2*)(CA + tok * D + ch);
            const float ov[4] = {bflo(ow.x), bfhi(ow.x), bflo(ow.y), bfhi(ow.y)}, gl[4] = {bflo(glw.x), bfhi(glw.x), bflo(glw.y), bfhi(glw.y)}, gm[4] = {bflo(gmw.x), bfhi(gmw.x), bflo(gmw.y), bfhi(gmw.y)};
            const float hl[4] = {bflo(hlw.x), bfhi(hlw.x), bflo(hlw.y), bfhi(hlw.y)}, ca[4] = {bflo(caw.x), bfhi(caw.x), bflo(caw.y), bfhi(caw.y)};
            float o[4];
#pragma unroll
            for (int j = 0; j < 4; ++j) { const float ym = acc[e][t4][j] * rs * mg[j] * sigmoidf_(ov[j]); const float yl = hl[j] + ca[j] * cr[j];
                o[j] = sigmoidf_(gl[j]) * yl + sigmoidf_(gm[j]) * ym; }
            u32x2 w; w.x = pk2(o[0], o[1]); w.y = pk2(o[2], o[3]);
            *(u32x2*)(MG + tok * D + ch) = w; } }
    __syncthreads();
}

__device__ __forceinline__ void p9_final(const Args& a, int G) {
    int tid = threadIdx.x; asm volatile("" : "+v"(tid)); const int lane = tid & 63, wave = tid >> 6;
    const float* sm = (const float*)(a.ws + WS_SMALL); const float* X = (const float*)(a.ws + WS_X1);
    const int gw = blockIdx.x * 8 + wave, NGW = G * 8;
    f32x4 g4[4];
#pragma unroll
    for (int j = 0; j < 4; ++j) g4[j] = *((const f32x4*)INP(34) + lane + 64 * j);
    for (int row = gw; row < MR; row += NGW) {
        const float rs = 1.0f / sqrtf(sm[SM_SS3 + row] * (1.f / D) + EPS);
        const f32x4* xr = (const f32x4*)(X + (size_t)row * D) + lane;
        f32x4* o = (f32x4*)(a.out + (row < MP ? O_YP + (size_t)row * D : O_YS + (size_t)(row - MP) * D)) + lane;
#pragma unroll
        for (int j = 0; j < 4; ++j) o[64 * j] = xr[64 * j] * rs * g4[j];
    }
}

namespace pg8 {
struct EpiAny {
    int kind; unsigned char* ws; const float* xp; const float* xs;
    __device__ __forceinline__ void operator()(const f32x4 (&acc)[2][2][4][2], const Unit& u, int wr, int wc, int fr, int fq) const {
        float* sm = (float*)(ws + WS_SMALL);
        switch (kind) {
        case 0: { EpiZ E{(bf16_t*)(ws + WS_Z), sm + SM_RSTD0}; E(acc, u, wr, wc, fr, fq); } break;
        case 1: { EpiQK E{(bf16_t*)(ws + WS_Q), (bf16_t*)(ws + WS_K)}; E(acc, u, wr, wc, fr, fq); } break;
        case 2: { EpiT E{(bf16_t*)(ws + WS_KT)}; E(acc, u, wr, wc, fr, fq); } break;
        case 3: { EpiT E{(bf16_t*)(ws + WS_VT)}; E(acc, u, wr, wc, fr, fq); } break;
        case 4: { EpiRes<0> E{xp, xs, (float*)(ws + WS_X1), (bf16_t*)(ws + WS_X1B), sm + SM_SS1}; E(acc, u, wr, wc, fr, fq); } break;
        case 5: { EpiGU E{(bf16_t*)(ws + WS_Z), sm + SM_SS1}; E(acc, u, wr, wc, fr, fq); } break;
        case 6: { EpiRes<1> E{nullptr, nullptr, (float*)(ws + WS_X1), (bf16_t*)(ws + WS_X2B), sm + SM_SS2}; E(acc, u, wr, wc, fr, fq); } break;
        case 7: { EpiPlain E{(bf16_t*)(ws + WS_PE), D}; E(acc, u, wr, wc, fr, fq); } break;
        default: { EpiPle E{(float*)(ws + WS_X1), (const bf16_t*)(ws + WS_PE), sm + SM_SS2, sm + SM_SS3}; E(acc, u, wr, wc, fr, fq); } break;
        }
    }
};
}

__device__ __forceinline__ bool gemm_job(unsigned char* ws, int ph, int j, pg8::Gemm& g, int& nM, int& nN, int& nZ, int& kind) {
    using namespace pg8;
    const bf16_t* w = (const bf16_t*)ws;
#define WSB(off) ((const bf16_t*)(ws + (off)))
    if (ph == 1 && j == 0) { g = Gemm{WSB(WS_XB), WSB(WS_W1T), D, D, D, 0, 0}; nM = M / 256; nN = NZ / 256; nZ = 1; kind = 0; return true; }
    if (ph == 3 && j == 0) { g = Gemm{WSB(WS_XC), WSB(WS_WQKT), D, HD, HD, 512, (size_t)512 * 256 * 2}; nM = M / 256; nN = 2; nZ = NH; kind = 1; return true; }
    if (ph == 3 && j == 1) { g = Gemm{WSB(WS_WQKT) + 65536, WSB(WS_XC), HD, D, HD, (size_t)512 * 256 * 2, 512}; nM = 1; nN = M / 256; nZ = NH; kind = 2; return true; }
    if (ph == 3 && j == 2) { g = Gemm{WSB(WS_WVT), WSB(WS_Z) + 1024, HD, NZ, HD, (size_t)65536 * 2, 512}; nM = 1; nN = M / 256; nZ = NH; kind = 3; return true; }
    if (ph == 6 && j == 0) { g = Gemm{WSB(WS_XB), WSB(WS_WOT), D, D, D, 0, 0}; nM = M / 256; nN = D / 256; nZ = 1; kind = 4; return true; }
    if (ph == 7 && j == 0) { g = Gemm{WSB(WS_X1B), WSB(WS_WGUT), D, D, D, 0, 0}; nM = M / 256; nN = NGU / 256; nZ = 1; kind = 5; return true; }
    if (ph == 8 && j == 0) { g = Gemm{WSB(WS_Z), WSB(WS_WDT), DFF, DFF, DFF, 0, 0}; nM = M / 256; nN = D / 256; nZ = 1; kind = 6; return true; }
    if (ph == 9 && j == 0) { g = Gemm{WSB(WS_PB), WSB(WS_WPT), PD, PD, PD, 0, 0}; nM = M / 256; nN = D / 256; nZ = 1; kind = 7; return true; }
    if (ph == 9 && j == 1) { g = Gemm{WSB(WS_X2B), WSB(WS_WPGT), D, D, D, 0, 0}; nM = M / 256; nN = D / 256; nZ = 1; kind = 8; return true; }
#undef WSB
    (void)w; return false;
}

#ifndef PHMASK
#define PHMASK 0x7ff
#endif
constexpr int NPHASE = 11;
__global__ void __launch_bounds__(NT, 2) hawk_fwd(Args a) {
    extern __shared__ __attribute__((aligned(16))) unsigned char lds_raw[];
    LAS unsigned char* lds = (LAS unsigned char*)lds_raw;
    cg::grid_group grid = cg::this_grid();
    const int G = gridDim.x, bx = blockIdx.x;
    for (int ph = a.ph_lo; ph < a.ph_hi; ++ph) {
        if ((PHMASK >> ph) & 1) {
            switch (ph) {
            case 0: p0_prologue(a, lds, G); break;
            case 2: for (int it = bx; it < 2048 + MS; it += G) p2a_item(a, lds, it); break;
            case 3: for (int bh = bx; bh < 32; bh += G) gate_scan(a, lds, bh); break;
            case 4: for (int it = bx; it < 256; it += G) p3_item(a, lds, it);
                    for (int it = bx; it < MS * NH; it += G) sample_item(a, lds, it); break;
            case 5: for (int it = bx; it < 1024; it += G) p4_item(a, lds, it); break;
            case 10: p9_final(a, G); break;
            default: break;
            }
            __syncthreads();
            for (int j = 0; j < 3; ++j) {
                pg8::Gemm g; int nM, nN, nZ, kind;
                if (!gemm_job(a.ws, ph, j, g, nM, nN, nZ, kind)) break;
                pg8::Order S; S.init(nM, nN, nZ, G, bx);
                pg8::EpiAny E{kind, a.ws, a.in[0], a.in[1]};
                pg8::gemm_phase(lds, g, S, E);
            }
        }
        if (ph + 1 < a.ph_hi) grid.sync();
    }
}

#ifndef N_LAUNCH_SPLIT
#define N_LAUNCH_SPLIT 0
#endif
extern "C" void kernel_launch(void* const* d_in, const int* in_sizes, int n_in, void* d_out, int out_size, void* d_ws, size_t ws_size, hipStream_t stream) {
    static int grid = 0;
    if (grid == 0) {
        int dev = 0, cus = 0, per_cu = 0;
        hipGetDevice(&dev);
        hipDeviceGetAttribute(&cus, hipDeviceAttributeMultiprocessorCount, dev);
        hipFuncSetAttribute((const void*)hawk_fwd, hipFuncAttributeMaxDynamicSharedMemorySize, LDS_BYTES);
        hipOccupancyMaxActiveBlocksPerMultiprocessor(&per_cu, (const void*)hawk_fwd, NT, LDS_BYTES);
        if (per_cu < 1) { fprintf(stderr, "kernel_launch: occupancy query says %d blocks per CU\n", per_cu); per_cu = 1; }
        grid = cus * per_cu;
        if (n_in != 35 || ws_size < WS_END || (size_t)out_size != O_END) fprintf(stderr, "kernel_launch: unexpected sizes n_in %d ws %zu out %d\n", n_in, ws_size, out_size);
    }
    Args a{};
    for (int i = 0; i < 35; ++i) a.in[i] = (const float*)d_in[i];
    a.out = (float*)d_out; a.ws = (unsigned char*)d_ws;
#if N_LAUNCH_SPLIT
    for (int p = 0; p < NPHASE; ++p) { a.ph_lo = p; a.ph_hi = p + 1; hipLaunchKernelGGL(hawk_fwd, dim3(grid), dim3(NT), LDS_BYTES, stream, a); }
#else
    a.ph_lo = 0; a.ph_hi = NPHASE;
    void* args[] = {&a};
    hipError_t e = hipLaunchCooperativeKernel((const void*)hawk_fwd, dim3(grid), dim3(NT), args, LDS_BYTES, stream);
    if (e != hipSuccess) fprintf(stderr, "cooperative launch failed: %s (grid %d)\n", hipGetErrorString(e), grid);
#endif
}
```

```cpp
#include <hip/hip_runtime.h>
#include <hip/hip_cooperative_groups.h>
#include <cstdio>
#include <cstdint>
namespace cg = cooperative_groups;

#define LAS __attribute__((address_space(3)))
typedef unsigned short bf16_t;
typedef short bf16x8 __attribute__((ext_vector_type(8)));
typedef float f32x4 __attribute__((ext_vector_type(4)));
typedef float f32x2 __attribute__((ext_vector_type(2)));
typedef unsigned u32x4 __attribute__((ext_vector_type(4)));
typedef unsigned u32x2 __attribute__((ext_vector_type(2)));

constexpr int D = 1024, NB = 8, T = 2048, MP = NB * T, MS = 128, MR = MP + MS, M = 16640  ;
constexpr int NZ = 5120, DFF = 2816, NGU = 2 * DFF, PD = 256, NIN = 5128, NH = 4, HD = 256, NCH = T / 64;
constexpr float EPS = 1e-6f;
constexpr float M_INIT = -1e30f;

constexpr size_t MiB = 1u << 20;
constexpr size_t WS_W1T = 0;
constexpr size_t WS_WOT = 10 * MiB;
constexpr size_t WS_WGUT = 12 * MiB;
constexpr size_t WS_WDT = 23 * MiB;
constexpr size_t WS_WPGT = 57 * MiB / 2;
constexpr size_t WS_WPT = 61 * MiB / 2;
constexpr size_t WS_WQKT = 31 * MiB;
constexpr size_t WS_WVT = 32 * MiB;
constexpr size_t WS_WLRUT = 65 * MiB / 2;
constexpr size_t WS_SMALL = 33 * MiB;
constexpr size_t WS_XB = 40 * MiB;
constexpr size_t WS_PB = 73 * MiB;
constexpr size_t WS_Z = 82 * MiB;
constexpr size_t WS_XC = 245 * MiB;
constexpr size_t WS_Q = 278 * MiB;
constexpr size_t WS_K = 311 * MiB;
constexpr size_t WS_KT = 344 * MiB;
constexpr size_t WS_VT = 377 * MiB;
constexpr size_t WS_HLOC = 410 * MiB;
constexpr size_t WS_CUMA = 443 * MiB;
constexpr size_t WS_END = 476 * MiB;
constexpr size_t WS_X1 = WS_Q;
constexpr size_t WS_X1B = WS_KT;
constexpr size_t WS_X2B = WS_VT;
constexpr size_t WS_PE = WS_HLOC;
constexpr int SM_RSTD0 = 0;
constexpr int SM_SS1 = SM_RSTD0 + M;
constexpr int SM_SS2 = SM_SS1 + M;
constexpr int SM_SS3 = SM_SS2 + M;
constexpr int SM_GI = SM_SS3 + M;
constexpr int SM_GF = SM_GI + 4 * M;
constexpr int SM_BM = SM_GF + 4 * M;
constexpr int SM_GIB = SM_BM + 32 * T;
constexpr int SM_SC = SM_GIB + 32 * T;
constexpr int SM_WK = SM_SC + 32 * T;
constexpr int SM_MM = SM_WK + 32 * T;
constexpr int SM_DEC = SM_MM + 32 * T;
constexpr int SM_NST = SM_DEC + 1024;
constexpr int SM_LRA = SM_NST + 32 * 32 * 256;
constexpr int SM_LRH = SM_LRA + 8 * 32 * 1024;
constexpr int SM_XLS = SM_LRH + 8 * 32 * 1024;
constexpr int SM_CARRY = SM_XLS + 128 * 1024;
constexpr int SM_END = SM_CARRY + 8 * 32 * 1024;
static_assert((size_t)SM_END * 4 <= 7 * MiB, "small arrays");
static_assert(WS_END <= 512 * MiB, "workspace");

constexpr size_t O_YP = 0, O_YS = O_YP + (size_t)MP * D, O_PLC = O_YS + (size_t)MS * D, O_PLH = O_PLC + 8 * 3 * 1024, O_PMC = O_PLH + 8 * 1024,
                 O_PC = O_PMC + 8 * 3 * 1024, O_PN = O_PC + (size_t)8 * 4 * 65536, O_PM = O_PN + 8 * 4 * 256, O_SLC = O_PM + 32, O_SLH = O_SLC + (size_t)128 * 3 * 1024,
                 O_SMC = O_SLH + 128 * 1024, O_SC = O_SMC + (size_t)128 * 3 * 1024, O_SN = O_SC + (size_t)128 * 4 * 65536, O_SM = O_SN + 128 * 4 * 256, O_END = O_SM + 512;

constexpr int LDS_BYTES = 147456;
constexpr int NT = 512;

struct Args {
    const float* in[35];
    float* out;
    unsigned char* ws;
    int ph_lo, ph_hi;
};

__device__ __forceinline__ size_t opq0() { size_t z = 0; asm volatile("" : "+s"(z)); return z; }
#define INP(k) (a.in[k] + opq0())
__device__ __forceinline__ unsigned f2bf(float f) { unsigned u = __builtin_bit_cast(unsigned, f); return (u + 0x7fffu + ((u >> 16) & 1u)) >> 16; }
__device__ __forceinline__ unsigned pk2(float lo, float hi) { return f2bf(lo) | (f2bf(hi) << 16); }
__device__ __forceinline__ float bf2f(unsigned short h) { return __builtin_bit_cast(float, (unsigned)h << 16); }
__device__ __forceinline__ float bflo(unsigned w) { return __builtin_bit_cast(float, w << 16); }
__device__ __forceinline__ float bfhi(unsigned w) { return __builtin_bit_cast(float, w & 0xffff0000u); }
__device__ __forceinline__ float sigmoidf_(float x) { return __builtin_amdgcn_rcpf(1.f + __builtin_amdgcn_exp2f(-1.4426950408889634f * x)); }
__device__ __forceinline__ float fexp_(float x) { return __builtin_amdgcn_exp2f(1.4426950408889634f * x); }
__device__ __forceinline__ void unpack8x(const u32x4 w, float (&o)[8]) { o[0] = bflo(w.x); o[1] = bfhi(w.x); o[2] = bflo(w.y); o[3] = bfhi(w.y); o[4] = bflo(w.z); o[5] = bfhi(w.z); o[6] = bflo(w.w); o[7] = bfhi(w.w); }
__device__ __forceinline__ float wave_sum(float v) {
#pragma unroll
    for (int o = 1; o < 64; o <<= 1) v += __shfl_xor(v, o);
    return v;
}
__device__ __forceinline__ const float* xrow_ptr(const Args& a, int row) {
    return row < MP ? INP(0) + (size_t)row * D : INP(1) + (size_t)(row - MP) * D;
}

namespace pg8 {
constexpr int BM = 256, BK = 64, HALF = 128, HTB = HALF * BK * 2, STAGE_BYTES = 8 * HTB, NXCD = 8, WGM = 8;
__device__ __forceinline__ int lds_byte(int r, int c) { const int st = (r >> 4) * 2 + (c >> 5), rr = r & 15, cc = c & 31, ob = rr * 64 + cc * 2; return st * 1024 + (ob ^ (((ob >> 9) & 1) << 5)); }
__device__ __forceinline__ void stage_rc(int b, int& R, int& C) { const int st = b / 1024, sb = b % 1024, swz = sb ^ (((sb >> 9) & 1) << 5); R = (st >> 1) * 16 + swz / 64; C = (st & 1) * 32 + (swz % 64) / 2; }
__device__ __forceinline__ int perm32(int rho) { const int n = rho >> 4, i = rho & 15; return 8 * (i >> 2) + 4 * n + (i & 3); }

struct Unit { int pm, pn, z; };
struct Gemm { const bf16_t* A; const bf16_t* Bt; int lda, ldb, K; size_t zA, zB; };

struct Order {
    int nM, nN, nwg, total, G, c;
    __device__ void init(int nM_, int nN_, int nZ_, int G_, int c_) { nM = nM_; nN = nN_; nwg = nM * nN; total = nwg * nZ_; G = G_; c = c_; }
    __device__ bool next(int i, Unit& u) const {
        const long L = (long)i * G + c; if (L >= total) return false;
        u.z = (int)(L / nwg); int wgid = (int)(L % nwg);
        { const int q = nwg / NXCD, r = nwg % NXCD, xcd = wgid % NXCD, off = wgid / NXCD; wgid = (xcd < r ? xcd * (q + 1) : r * (q + 1) + (xcd - r) * q) + off; }
        const int nig = WGM * nN, gid = wgid / nig, fm = gid * WGM, gsz = (nM - fm) < WGM ? (nM - fm) : WGM;
        u.pm = fm + ((wgid % nig) % gsz); u.pn = (wgid % nig) / gsz; return true;
    }
};

__device__ __forceinline__ unsigned cvt_pk_bf16(float lo, float hi) { unsigned r; asm volatile("v_cvt_pk_bf16_f32 %0, %1, %2" : "=v"(r) : "v"(lo), "v"(hi)); return r; }

template <class Epi>
__device__ __forceinline__ void gemm_phase(LAS unsigned char* lds, const Gemm g, const Order& S, const Epi& E) {
    int tid = threadIdx.x; asm volatile("" : "+v"(tid));
    const int wid = __builtin_amdgcn_readfirstlane(tid >> 6), lane = tid & 63, wr = wid >> 2, wc = wid & 3, fr = lane & 15, fq = lane >> 4;
    const int K = g.K, nt = K / BK;
    unsigned voffA[2], voffB[2];
#pragma unroll
    for (int i = 0; i < 2; ++i) { int R, C; stage_rc(tid * 16 + i * 8192, R, C); const int Rb = (R & ~31) + perm32(R & 31);
        voffA[i] = (unsigned)(R * g.lda + C) * 2u; voffB[i] = (unsigned)(Rb * g.ldb + C) * 2u; }
    const size_t kstep = (size_t)(BK * 2);
    const size_t hstepA = (size_t)HALF * g.lda * 2, hstepB = (size_t)HALF * g.ldb * 2;
    const size_t tstepA = 2 * hstepA, tstepB = 2 * hstepB;
    const unsigned ldsw = (unsigned)wid * 1024u;
    const int aoff = lds_byte(wr * 64 + fr, fq * 8), boff = lds_byte(wc * 32 + fr, fq * 8);
#define PG8_SA(b, h) (((b) * 2 + (h)) * HTB)
#define PG8_SB(b, h) ((4 + (b) * 2 + (h)) * HTB)
#define PG8_STAGE(bufoff, gbase, voff) do { _Pragma("unroll") for (int _i = 0; _i < 2; ++_i) \
        __builtin_amdgcn_global_load_lds((const unsigned*)((const char*)(gbase) + (voff)[_i]), (LAS unsigned*)(lds + (bufoff) + ldsw + _i * 8192), 16, 0, 0); } while (0)
#define PG8_LDA(dst, b, h) do { _Pragma("unroll") for (int m = 0; m < 4; ++m) _Pragma("unroll") for (int k = 0; k < 2; ++k) dst[m][k] = *(const LAS bf16x8*)(lds + PG8_SA(b, h) + aoff + m * 2048 + k * 1024); } while (0)
#define PG8_LDB(dst, b, h) do { _Pragma("unroll") for (int n = 0; n < 2; ++n) _Pragma("unroll") for (int k = 0; k < 2; ++k) dst[n][k] = *(const LAS bf16x8*)(lds + PG8_SB(b, h) + boff + n * 2048 + k * 1024); } while (0)
#define PG8_MMA(ai, bj, At, Bt) do { __builtin_amdgcn_s_setprio(1); _Pragma("unroll") for (int m = 0; m < 4; ++m) _Pragma("unroll") for (int n = 0; n < 2; ++n) _Pragma("unroll") for (int k = 0; k < 2; ++k) \
        acc[ai][bj][m][n] = __builtin_amdgcn_mfma_f32_16x16x32_bf16(Bt[n][k], At[m][k], acc[ai][bj][m][n], 0, 0, 0); __builtin_amdgcn_s_setprio(0); } while (0)
#define PG8_WAIT_V(n) asm volatile("s_waitcnt vmcnt(" #n ")" ::: "memory")
#define PG8_WAIT_L(n) asm volatile("s_waitcnt lgkmcnt(" #n ")" ::: "memory")
#define PG8_BAR __builtin_amdgcn_s_barrier()
#define PG8_SCHED __builtin_amdgcn_sched_barrier(0)
    Unit cur, nxt; int ui = 0;
    if (!S.next(0, cur)) return;
    f32x4 acc[2][2][4][2];
#pragma unroll
    for (int a = 0; a < 2; ++a)
#pragma unroll
        for (int b = 0; b < 2; ++b)
#pragma unroll
            for (int m = 0; m < 4; ++m)
#pragma unroll
                for (int n = 0; n < 2; ++n) acc[a][b][m][n] = (f32x4){0.f, 0.f, 0.f, 0.f};
    bf16x8 At[4][2], B0[2][2], B1[2][2];
    const char* cA = (const char*)g.A + (size_t)cur.pm * tstepA + (size_t)cur.z * g.zA; const char* cB = (const char*)g.Bt + (size_t)cur.pn * tstepB + (size_t)cur.z * g.zB;
    PG8_STAGE(PG8_SB(0, 0), cB, voffB); PG8_STAGE(PG8_SB(0, 1), cB + hstepB, voffB); PG8_STAGE(PG8_SA(0, 0), cA, voffA); PG8_STAGE(PG8_SA(0, 1), cA + hstepA, voffA);
    if (wr == 1) PG8_BAR;
    PG8_WAIT_V(2); PG8_BAR;
    PG8_STAGE(PG8_SB(1, 0), cB + kstep, voffB); PG8_STAGE(PG8_SA(1, 0), cA + kstep, voffA); PG8_STAGE(PG8_SB(1, 1), cB + hstepB + kstep, voffB);
    PG8_WAIT_V(6); PG8_BAR;
    for (;;) {
        const bool has_next = S.next(ui + 1, nxt);
        const char* nA = has_next ? (const char*)g.A + (size_t)nxt.pm * tstepA + (size_t)nxt.z * g.zA : cA;
        const char* nB = has_next ? (const char*)g.Bt + (size_t)nxt.pn * tstepB + (size_t)nxt.z * g.zB : cB;
        for (int t = 0; t < nt; t += 2) {
            const bool last = (t == nt - 2);
            const char* a1 = cA + (size_t)(t + 1) * kstep;
            const char* a2 = last ? nA : cA + (size_t)(t + 2) * kstep; const char* b2 = last ? nB : cB + (size_t)(t + 2) * kstep;
            const char* a3 = a2 + kstep; const char* b3 = b2 + kstep;
            PG8_LDB(B0, 0, 0); PG8_LDB(B1, 0, 1); PG8_SCHED; PG8_LDA(At, 0, 0); PG8_STAGE(PG8_SA(1, 1), a1 + hstepA, voffA);
            PG8_WAIT_V(8); PG8_WAIT_L(0); PG8_BAR; PG8_MMA(0, 0, At, B0); PG8_MMA(0, 1, At, B1); PG8_BAR; PG8_SCHED;
            PG8_LDA(At, 0, 1); PG8_STAGE(PG8_SB(0, 0), b2, voffB); PG8_STAGE(PG8_SB(0, 1), b2 + hstepB, voffB); PG8_STAGE(PG8_SA(0, 0), a2, voffA);
            PG8_WAIT_V(8); PG8_WAIT_L(0); PG8_BAR; PG8_MMA(1, 0, At, B0); PG8_MMA(1, 1, At, B1); PG8_BAR; PG8_SCHED;
            PG8_LDB(B0, 1, 0); PG8_LDB(B1, 1, 1); PG8_SCHED; PG8_LDA(At, 1, 0); PG8_STAGE(PG8_SA(0, 1), a2 + hstepA, voffA);
            PG8_WAIT_V(8); PG8_WAIT_L(0); PG8_BAR; PG8_MMA(0, 0, At, B0); PG8_MMA(0, 1, At, B1); PG8_BAR; PG8_SCHED;
            PG8_LDA(At, 1, 1); PG8_STAGE(PG8_SB(1, 0), b3, voffB); PG8_STAGE(PG8_SB(1, 1), b3 + hstepB, voffB); PG8_STAGE(PG8_SA(1, 0), a3, voffA);
            PG8_WAIT_V(8); PG8_WAIT_L(0); PG8_BAR; PG8_MMA(1, 0, At, B0); PG8_MMA(1, 1, At, B1); PG8_BAR; PG8_SCHED;
        }
        if (wr == 0) PG8_BAR;
        E(acc, cur, wr, wc, fr, fq);
        if (!has_next) break;
#pragma unroll
        for (int a = 0; a < 2; ++a)
#pragma unroll
            for (int b = 0; b < 2; ++b)
#pragma unroll
                for (int m = 0; m < 4; ++m)
#pragma unroll
                    for (int n = 0; n < 2; ++n) acc[a][b][m][n] = (f32x4){0.f, 0.f, 0.f, 0.f};
        cur = nxt; cA = nA; cB = nB; ++ui;
        if (wr == 1) PG8_BAR;
    }
    PG8_WAIT_V(0);
    PG8_BAR;
#undef PG8_SA
#undef PG8_SB
#undef PG8_STAGE
#undef PG8_LDA
#undef PG8_LDB
#undef PG8_MMA
#undef PG8_WAIT_V
#undef PG8_WAIT_L
#undef PG8_BAR
#undef PG8_SCHED
}

#define EPI_ROW0(u) ((u).pm * BM + wr * 64 + fr)
#define EPI_COL0(u) ((u).pn * BM + wc * 32 + 8 * fq)

struct EpiZ {
    bf16_t* Zp; const float* rstd;
    __device__ __forceinline__ void operator()(const f32x4 (&acc)[2][2][4][2], const Unit& u, int wr, int wc, int fr, int fq) const {
        const int row0 = EPI_ROW0(u), col0 = EPI_COL0(u);
#pragma unroll
        for (int ai = 0; ai < 2; ++ai)
#pragma unroll
            for (int m = 0; m < 4; ++m) { const int row = row0 + ai * HALF + m * 16; const float s = rstd[row]; bf16_t* rp = Zp + (size_t)row * NZ + col0;
#pragma unroll
                for (int bj = 0; bj < 2; ++bj) { const f32x4 v0 = acc[ai][bj][m][0] * s, v1 = acc[ai][bj][m][1] * s; u32x4 w;
                    w.x = cvt_pk_bf16(v0[0], v0[1]); w.y = cvt_pk_bf16(v0[2], v0[3]); w.z = cvt_pk_bf16(v1[0], v1[1]); w.w = cvt_pk_bf16(v1[2], v1[3]);
                    *(u32x4*)(rp + bj * HALF) = w; } }
    }
};
struct EpiQK {
    bf16_t* Qp; bf16_t* Kp;
    __device__ __forceinline__ void operator()(const f32x4 (&acc)[2][2][4][2], const Unit& u, int wr, int wc, int fr, int fq) const {
        const int row0 = EPI_ROW0(u), col0 = u.z * 256 + wc * 32 + 8 * fq; bf16_t* base = u.pn ? Kp : Qp;
#pragma unroll
        for (int ai = 0; ai < 2; ++ai)
#pragma unroll
            for (int m = 0; m < 4; ++m) { const int row = row0 + ai * HALF + m * 16; bf16_t* rp = base + (size_t)row * D + col0;
#pragma unroll
                for (int bj = 0; bj < 2; ++bj) { const f32x4 v0 = acc[ai][bj][m][0], v1 = acc[ai][bj][m][1]; u32x4 w;
                    w.x = cvt_pk_bf16(v0[0], v0[1]); w.y = cvt_pk_bf16(v0[2], v0[3]); w.z = cvt_pk_bf16(v1[0], v1[1]); w.w = cvt_pk_bf16(v1[2], v1[3]);
                    *(u32x4*)(rp + bj * HALF) = w; } }
    }
};
struct EpiT {
    bf16_t* Op;
    __device__ __forceinline__ void operator()(const f32x4 (&acc)[2][2][4][2], const Unit& u, int wr, int wc, int fr, int fq) const {
        const int row0 = wr * 64 + fr, col0 = EPI_COL0(u);
#pragma unroll
        for (int ai = 0; ai < 2; ++ai)
#pragma unroll
            for (int m = 0; m < 4; ++m) { const int row = row0 + ai * HALF + m * 16; bf16_t* rp = Op + ((size_t)u.z * 256 + row) * M + col0;
#pragma unroll
                for (int bj = 0; bj < 2; ++bj) { const f32x4 v0 = acc[ai][bj][m][0], v1 = acc[ai][bj][m][1]; u32x4 w;
                    w.x = cvt_pk_bf16(v0[0], v0[1]); w.y = cvt_pk_bf16(v0[2], v0[3]); w.z = cvt_pk_bf16(v1[0], v1[1]); w.w = cvt_pk_bf16(v1[2], v1[3]);
                    *(u32x4*)(rp + bj * HALF) = w; } }
    }
};
struct EpiPlain {
    bf16_t* Op; int ldc;
    __device__ __forceinline__ void operator()(const f32x4 (&acc)[2][2][4][2], const Unit& u, int wr, int wc, int fr, int fq) const {
        const int row0 = EPI_ROW0(u), col0 = EPI_COL0(u);
#pragma unroll
        for (int ai = 0; ai < 2; ++ai)
#pragma unroll
            for (int m = 0; m < 4; ++m) { const int row = row0 + ai * HALF + m * 16; bf16_t* rp = Op + (size_t)row * ldc + col0;
#pragma unroll
                for (int bj = 0; bj < 2; ++bj) { const f32x4 v0 = acc[ai][bj][m][0], v1 = acc[ai][bj][m][1]; u32x4 w;
                    w.x = cvt_pk_bf16(v0[0], v0[1]); w.y = cvt_pk_bf16(v0[2], v0[3]); w.z = cvt_pk_bf16(v1[0], v1[1]); w.w = cvt_pk_bf16(v1[2], v1[3]);
                    *(u32x4*)(rp + bj * HALF) = w; } }
    }
};
template <int MODE> struct EpiRes {
    const float* xp; const float* xs; const bf16_t* XI; bf16_t* XO; float* ss;
    __device__ __forceinline__ void operator()(const f32x4 (&acc)[2][2][4][2], const Unit& u, int wr, int wc, int fr, int fq) const {
        const int row0 = EPI_ROW0(u), col0 = EPI_COL0(u);
#pragma unroll
        for (int ai = 0; ai < 2; ++ai)
#pragma unroll
            for (int m = 0; m < 4; ++m) { const int row = row0 + ai * HALF + m * 16;
                float q = 0.f;
                if (row < MR) {
#pragma unroll
                    for (int bj = 0; bj < 2; ++bj) { const int c = col0 + bj * HALF;
                        f32x4 b0, b1;
                        if (MODE == 0) { const float* bp = row < MP ? xp + (size_t)row * D : xs + (size_t)(row - MP) * D; b0 = *(const f32x4*)(bp + c); b1 = *(const f32x4*)(bp + c + 4); }
                        else { const u32x4 w = *(const u32x4*)(XI + (size_t)row * D + c); b0 = (f32x4){bflo(w.x), bfhi(w.x), bflo(w.y), bfhi(w.y)}; b1 = (f32x4){bflo(w.z), bfhi(w.z), bflo(w.w), bfhi(w.w)}; }
                        const f32x4 v0 = acc[ai][bj][m][0] + b0, v1 = acc[ai][bj][m][1] + b1;
                        u32x4 w; w.x = cvt_pk_bf16(v0[0], v0[1]); w.y = cvt_pk_bf16(v0[2], v0[3]); w.z = cvt_pk_bf16(v1[0], v1[1]); w.w = cvt_pk_bf16(v1[2], v1[3]);
                        *(u32x4*)(XO + (size_t)row * D + c) = w;
                        q += (v0[0] * v0[0] + v0[1] * v0[1]) + (v0[2] * v0[2] + v0[3] * v0[3]) + (v1[0] * v1[0] + v1[1] * v1[1]) + (v1[2] * v1[2] + v1[3] * v1[3]); }
                }
                q += __shfl_xor(q, 16); q += __shfl_xor(q, 32);
                if (fq == 0 && row < MR) atomicAdd(ss + row, q);
            }
    }
};
struct EpiGU {
    bf16_t* Hp; const float* ss;
    __device__ __forceinline__ void operator()(const f32x4 (&acc)[2][2][4][2], const Unit& u, int wr, int wc, int fr, int fq) const {
        const int row0 = EPI_ROW0(u), col0 = u.pn * HALF + wc * 32 + 8 * fq;
#pragma unroll
        for (int ai = 0; ai < 2; ++ai)
#pragma unroll
            for (int m = 0; m < 4; ++m) { const int row = row0 + ai * HALF + m * 16; const float s = __builtin_amdgcn_rsqf(ss[row] * (1.f / D) + EPS);
                float o[8];
#pragma unroll
                for (int n = 0; n < 2; ++n)
#pragma unroll
                    for (int i = 0; i < 4; ++i) { const float gv = acc[ai][0][m][n][i] * s, uv = acc[ai][1][m][n][i] * s; o[n * 4 + i] = gv * sigmoidf_(gv) * uv; }
                u32x4 w; w.x = cvt_pk_bf16(o[0], o[1]); w.y = cvt_pk_bf16(o[2], o[3]); w.z = cvt_pk_bf16(o[4], o[5]); w.w = cvt_pk_bf16(o[6], o[7]);
                *(u32x4*)(Hp + (size_t)row * DFF + col0) = w; }
    }
};
struct EpiPle {
    const bf16_t* XI; bf16_t* XO; const bf16_t* PEp; const float* ss2; float* ss3;
    __device__ __forceinline__ void operator()(const f32x4 (&acc)[2][2][4][2], const Unit& u, int wr, int wc, int fr, int fq) const {
        const int row0 = EPI_ROW0(u), col0 = EPI_COL0(u);
#pragma unroll
        for (int ai = 0; ai < 2; ++ai)
#pragma unroll
            for (int m = 0; m < 4; ++m) { const int row = row0 + ai * HALF + m * 16;
                float q = 0.f;
                if (row < MR) {
                    const float s = __builtin_amdgcn_rsqf(ss2[row] * (1.f / D) + EPS);
#pragma unroll
                    for (int bj = 0; bj < 2; ++bj) { const int c = col0 + bj * HALF;
                        float xb[8], pe[8];
                        unpack8x(*(const u32x4*)(XI + (size_t)row * D + c), xb); unpack8x(*(const u32x4*)(PEp + (size_t)row * D + c), pe);
                        float v[8];
#pragma unroll
                        for (int i = 0; i < 4; ++i) { v[i] = xb[i] + sigmoidf_(acc[ai][bj][m][0][i] * s) * pe[i]; v[4 + i] = xb[4 + i] + sigmoidf_(acc[ai][bj][m][1][i] * s) * pe[4 + i]; }
                        u32x4 w; w.x = cvt_pk_bf16(v[0], v[1]); w.y = cvt_pk_bf16(v[2], v[3]); w.z = cvt_pk_bf16(v[4], v[5]); w.w = cvt_pk_bf16(v[6], v[7]);
                        *(u32x4*)(XO + (size_t)row * D + c) = w;
#pragma unroll
                        for (int i = 0; i < 8; ++i) q += v[i] * v[i]; }
                }
                q += __shfl_xor(q, 16); q += __shfl_xor(q, 32);
                if (fq == 0 && row < MR) atomicAdd(ss3 + row, q);
            }
    }
};
}

#define MFMA16(a, b, c) __builtin_amdgcn_mfma_f32_16x16x32_bf16((a), (b), (c), 0, 0, 0)
__device__ __forceinline__ float log_sigmoid_(float f) { return fminf(f, 0.f) - log1pf(__expf(-fabsf(f))); }
__device__ __forceinline__ void unpack8(const u32x4 w, float (&o)[8]) { o[0] = bflo(w.x); o[1] = bfhi(w.x); o[2] = bflo(w.y); o[3] = bfhi(w.y); o[4] = bflo(w.z); o[5] = bfhi(w.z); o[6] = bflo(w.w); o[7] = bfhi(w.w); }
__device__ __forceinline__ u32x4 pack8(const float (&o)[8]) { u32x4 w; w.x = pk2(o[0], o[1]); w.y = pk2(o[2], o[3]); w.z = pk2(o[4], o[5]); w.w = pk2(o[6], o[7]); return w; }

__device__ __forceinline__ void transpose_item(const float* W, int ldw, int col0, bf16_t* WT, int drow0, int ldt, const float* gk, float scal, LAS float* scr, int k0, int lane) {
#pragma unroll 8
    for (int i = 0; i < 32; ++i) { const int kk = 2 * i + (lane >> 5); const float gg = gk ? gk[k0 + kk] * scal : scal;
        scr[kk * 33 + (lane & 31)] = W[(size_t)(k0 + kk) * ldw + col0 + (lane & 31)] * gg; }
    asm volatile("s_waitcnt lgkmcnt(0)" ::: "memory");
    const int c = lane & 7;
#pragma unroll
    for (int j = 0; j < 4; ++j) { const int n = (lane >> 3) + 8 * j; const LAS float* s = scr + (8 * c) * 33 + n;
        u32x4 o; o.x = pk2(s[0 * 33], s[1 * 33]); o.y = pk2(s[2 * 33], s[3 * 33]); o.z = pk2(s[4 * 33], s[5 * 33]); o.w = pk2(s[6 * 33], s[7 * 33]);
        *(u32x4*)(WT + (size_t)(drow0 + n) * ldt + k0 + 8 * c) = o; }
    asm volatile("s_waitcnt lgkmcnt(0)" ::: "memory");
}

__device__ __forceinline__ void p0_prologue(const Args& a, LAS unsigned char* lds, int G) {
    int tid = threadIdx.x; asm volatile("" : "+v"(tid)); const int lane = tid & 63, wave = tid >> 6;
    unsigned char* ws = a.ws + opq0();
    float* sm = (float*)(ws + WS_SMALL);
    const int gw = blockIdx.x * 8 + wave, NGW = G * 8;
    LAS float* scr = (LAS float*)(lds + wave * 16384);
    constexpr int I0 = 16 * 96, I1 = 16 * 64, I2 = 16 * 32, I3 = 16 * 88, I4 = I3, I5 = 44 * 32, I6 = 16 * 32, I7 = 4 * 32, I8 = 4 * 32, I9 = I8, I10 = I8, I11 = 8 * 8, I12 = I11;
    constexpr int NIT = I0 + I1 + I2 + I3 + I4 + I5 + I6 + I7 + I8 + I9 + I10 + I11 + I12;
    for (int it = gw; it < NIT; it += NGW) {
        int r = it;
        if (r < I0) { const int kb = r / 96, nb = r % 96; transpose_item(INP(11), NIN, nb * 32, (bf16_t*)(ws + WS_W1T), nb * 32, D, INP(10), 1.f, scr, kb * 64, lane); continue; } r -= I0;
        if (r < I1) { const int kb = r / 64, nb = r % 64; transpose_item(INP(11), NIN, 3080 + nb * 32, (bf16_t*)(ws + WS_W1T), 3072 + nb * 32, D, INP(10), 1.f, scr, kb * 64, lane); continue; } r -= I1;
        if (r < I2) { const int kb = r / 32, nb = r % 32; transpose_item(INP(26), D, nb * 32, (bf16_t*)(ws + WS_WOT), nb * 32, D, nullptr, 1.f, scr, kb * 64, lane); continue; } r -= I2;
        if (r < I3) { const int kb = r / 88, nb = r % 88, n0 = nb * 32; transpose_item(INP(28), DFF, n0, (bf16_t*)(ws + WS_WGUT), (n0 / 128) * 256 + (n0 % 128), D, INP(27), 1.f, scr, kb * 64, lane); continue; } r -= I3;
        if (r < I4) { const int kb = r / 88, nb = r % 88, n0 = nb * 32; transpose_item(INP(29), DFF, n0, (bf16_t*)(ws + WS_WGUT), (n0 / 128) * 256 + 128 + (n0 % 128), D, INP(27), 1.f, scr, kb * 64, lane); continue; } r -= I4;
        if (r < I5) { const int kb = r / 32, nb = r % 32; transpose_item(INP(30), D, nb * 32, (bf16_t*)(ws + WS_WDT), nb * 32, DFF, nullptr, 1.f, scr, kb * 64, lane); continue; } r -= I5;
        if (r < I6) { const int kb = r / 32, nb = r % 32; transpose_item(INP(32), D, nb * 32, (bf16_t*)(ws + WS_WPGT), nb * 32, D, INP(31), 1.f, scr, kb * 64, lane); continue; } r -= I6;
        if (r < I7) { const int kb = r / 32, nb = r % 32; transpose_item(INP(33), D, nb * 32, (bf16_t*)(ws + WS_WPT), nb * 32, PD, nullptr, 1.f, scr, kb * 64, lane); continue; } r -= I7;
        if (r < I8) { const int h = r / 32, q = r % 32, kb = q / 8, nb = q % 8; transpose_item(INP(22) + (size_t)h * 65536, HD, nb * 32, (bf16_t*)(ws + WS_WQKT) + (size_t)h * 512 * 256, nb * 32, HD, nullptr, 0.0625f, scr, kb * 64, lane); continue; } r -= I8;
        if (r < I9) { const int h = r / 32, q = r % 32, kb = q / 8, nb = q % 8; transpose_item(INP(23) + (size_t)h * 65536, HD, nb * 32, (bf16_t*)(ws + WS_WQKT) + (size_t)h * 512 * 256, 256 + nb * 32, HD, nullptr, 1.f, scr, kb * 64, lane); continue; } r -= I9;
        if (r < I10) { const int h = r / 32, q = r % 32, kb = q / 8, nb = q % 8; transpose_item(INP(24) + (size_t)h * 65536, HD, nb * 32, (bf16_t*)(ws + WS_WVT) + (size_t)h * 65536, nb * 32, HD, nullptr, 1.f, scr, kb * 64, lane); continue; } r -= I10;
        if (r < I11) { const int bl = r / 8, q = r % 8, kb = q / 4, nb = q % 4; transpose_item(INP(15) + (size_t)bl * 16384, 128, nb * 32, (bf16_t*)(ws + WS_WLRUT) + (size_t)bl * 256 * 128, nb * 32, 128, nullptr, 1.f, scr, kb * 64, lane); continue; } r -= I11;
        { const int bl = r / 8, q = r % 8, kb = q / 4, nb = q % 4; transpose_item(INP(17) + (size_t)bl * 16384, 128, nb * 32, (bf16_t*)(ws + WS_WLRUT) + (size_t)bl * 256 * 128, 128 + nb * 32, 128, nullptr, 1.f, scr, kb * 64, lane); }
    }
    __syncthreads();
    LAS float* gwL = (LAS float*)lds;
    for (int i = tid; i < 8192; i += NT) { const int j = i >> 10, k = i & 1023; gwL[i] = INP(10)[k] * INP(11)[(size_t)k * NIN + 3072 + j]; }
    __syncthreads();
    bf16_t* XB = (bf16_t*)(ws + WS_XB);
    for (int row = gw; row < M; row += NGW) {
        unsigned long long* o8 = (unsigned long long*)(XB + (size_t)row * D) + lane;
        if (row >= MR) {
#pragma unroll
            for (int j = 0; j < 4; ++j) o8[64 * j] = 0ull;
            if (lane == 0) sm[SM_RSTD0 + row] = 0.f;
            continue;
        }
        const f32x4* xr = (const f32x4*)xrow_ptr(a, row) + lane;
        f32x4 v[4]; float s = 0.f;
#pragma unroll
        for (int j = 0; j < 4; ++j) { v[j] = xr[64 * j]; s += (v[j].x * v[j].x + v[j].y * v[j].y) + (v[j].z * v[j].z + v[j].w * v[j].w); }
        float dt[8];
#pragma unroll
        for (int jj = 0; jj < 8; ++jj) { float d = 0.f;
#pragma unroll
            for (int j = 0; j < 4; ++j) { const f32x4 w = *(const LAS f32x4*)(gwL + jj * 1024 + j * 256 + lane * 4); d += (v[j].x * w.x + v[j].y * w.y) + (v[j].z * w.z + v[j].w * w.w); }
            dt[jj] = wave_sum(d); }
        s = wave_sum(s);
        const float rstd = 1.0f / sqrtf(s * (1.f / D) + EPS);
#pragma unroll
        for (int j = 0; j < 4; ++j) o8[64 * j] = (unsigned long long)pk2(v[j].x, v[j].y) | ((unsigned long long)pk2(v[j].z, v[j].w) << 32);
        if (lane == 0) { sm[SM_RSTD0 + row] = rstd;
#pragma unroll
            for (int jj = 0; jj < 4; ++jj) { sm[SM_GI + row * 4 + jj] = dt[jj] * rstd + INP(12)[jj]; sm[SM_GF + row * 4 + jj] = dt[4 + jj] * rstd + INP(12)[4 + jj]; } }
    }
    const int gt = blockIdx.x * NT + tid, NGT = G * NT;
    bf16_t* PB = (bf16_t*)(ws + WS_PB);
    for (int i = gt; i < M * (PD / 4); i += NGT) { asm volatile("" : "+v"(i)); const int row = i >> 6, c4 = (i & 63) * 4;
        f32x4 v = (f32x4){0.f, 0.f, 0.f, 0.f};
        if (row < MP) v = *(const f32x4*)(INP(8) + (size_t)row * PD + c4); else if (row < MR) v = *(const f32x4*)(INP(9) + (size_t)(row - MP) * PD + c4);
        *(unsigned long long*)(PB + (size_t)row * PD + c4) = (unsigned long long)pk2(v.x, v.y) | ((unsigned long long)pk2(v.z, v.w) << 32); }
    for (int i = gt; i < 3 * M; i += NGT) { sm[SM_SS1 + i] = 0.f; asm volatile("" : "+v"(i)); }
}

__device__ __forceinline__ void p2a_item(const Args& a, LAS unsigned char* lds, int idx) {
    int tid = threadIdx.x; asm volatile("" : "+v"(tid)); const int lane = tid & 63, wave = tid >> 6;
    unsigned char* ws = a.ws + opq0(); float* sm = (float*)(ws + WS_SMALL);
    const bf16_t* Z = (const bf16_t*)(ws + WS_Z); bf16_t* XC = (bf16_t*)(ws + WS_XC);
    if (idx >= 2048) {
        const int sb = idx - 2048, row = MP + sb;
#pragma unroll
        for (int cc = 0; cc < 2; ++cc) { const int ch = tid * 2 + cc;
            { const float s0 = INP(2)[((size_t)sb * 3 + 0) * D + ch], s1 = INP(2)[((size_t)sb * 3 + 1) * D + ch], s2 = INP(2)[((size_t)sb * 3 + 2) * D + ch], xv = bf2f(Z[(size_t)row * NZ + ch]);
              const float o = INP(14)[ch] + INP(13)[ch] * s0 + INP(13)[D + ch] * s1 + INP(13)[2 * D + ch] * s2 + INP(13)[3 * D + ch] * xv;
              sm[SM_XLS + sb * D + ch] = o;
              a.out[O_SLC + ((size_t)sb * 3 + 0) * D + ch] = s1; a.out[O_SLC + ((size_t)sb * 3 + 1) * D + ch] = s2; a.out[O_SLC + ((size_t)sb * 3 + 2) * D + ch] = xv; }
            { const float s0 = INP(4)[((size_t)sb * 3 + 0) * D + ch], s1 = INP(4)[((size_t)sb * 3 + 1) * D + ch], s2 = INP(4)[((size_t)sb * 3 + 2) * D + ch], xv = bf2f(Z[(size_t)row * NZ + 1024 + ch]);
              const float o = INP(21)[ch] + INP(20)[ch] * s0 + INP(20)[D + ch] * s1 + INP(20)[2 * D + ch] * s2 + INP(20)[3 * D + ch] * xv;
              XC[(size_t)row * D + ch] = (bf16_t)f2bf(o * sigmoidf_(o));
              a.out[O_SMC + ((size_t)sb * 3 + 0) * D + ch] = s1; a.out[O_SMC + ((size_t)sb * 3 + 1) * D + ch] = s2; a.out[O_SMC + ((size_t)sb * 3 + 2) * D + ch] = xv; }
        }
        return;
    }
    const int cb = idx & 7, tt = (idx >> 3) & 31, b = idx >> 8;
    LAS bf16_t* AL = (LAS bf16_t*)lds;
    LAS float* U = (LAS float*)(lds + 17408);
    LAS float* AA = (LAS float*)(lds + 17408 + 32768);
    const int t0 = tt * 64, tokb = b * T;
    {
        const int c8 = tid & 15, rs = tid >> 4, chl = cb * 128 + c8 * 8;
        float wl[4][8], wm[4][8], bl[8], bm[8];
#pragma unroll
        for (int j = 0; j < 4; ++j)
#pragma unroll
            for (int i = 0; i < 8; ++i) { wl[j][i] = INP(13)[j * D + chl + i]; wm[j][i] = INP(20)[j * D + chl + i]; }
#pragma unroll
        for (int i = 0; i < 8; ++i) { bl[i] = INP(14)[chl + i]; bm[i] = INP(21)[chl + i]; }
#pragma unroll
        for (int rr = 0; rr < 2; ++rr) { const int tl = rs + 32 * rr, tg = t0 + tl;
            float ol[8], om[8], xl3[8], xm3[8];
#pragma unroll
            for (int i = 0; i < 8; ++i) { ol[i] = bl[i]; om[i] = bm[i]; xl3[i] = 0.f; xm3[i] = 0.f; }
#pragma unroll
            for (int j = 0; j < 4; ++j) { const int ts = tg - 3 + j;
                if (ts >= 0) { float xl[8], xm[8];
                    unpack8(*(const u32x4*)(Z + (size_t)(tokb + ts) * NZ + chl), xl); unpack8(*(const u32x4*)(Z + (size_t)(tokb + ts) * NZ + 1024 + chl), xm);
#pragma unroll
                    for (int i = 0; i < 8; ++i) { ol[i] += wl[j][i] * xl[i]; om[i] += wm[j][i] * xm[i]; if (j == 3) { xl3[i] = xl[i]; xm3[i] = xm[i]; } } } }
            *(LAS u32x4*)(AL + tl * 136 + c8 * 8) = pack8(ol);
            *(LAS f32x4*)(U + tl * 128 + c8 * 8) = (f32x4){ol[0], ol[1], ol[2], ol[3]}; *(LAS f32x4*)(U + tl * 128 + c8 * 8 + 4) = (f32x4){ol[4], ol[5], ol[6], ol[7]};
            float xs[8];
#pragma unroll
            for (int i = 0; i < 8; ++i) xs[i] = om[i] * sigmoidf_(om[i]);
            *(u32x4*)(XC + (size_t)(tokb + tg) * D + chl) = pack8(xs);
            if (tg >= T - 3) { const int j3 = tg - (T - 3);
#pragma unroll
                for (int i = 0; i < 8; ++i) { a.out[O_PLC + ((size_t)b * 3 + j3) * D + chl + i] = xl3[i]; a.out[O_PMC + ((size_t)b * 3 + j3) * D + chl + i] = xm3[i]; } }
        }
    }
    __syncthreads();
    {
        const int fr = lane & 15, fq = lane >> 4;
        const bf16_t* Wl = (const bf16_t*)(ws + WS_WLRUT) + (size_t)cb * 256 * 128;
        f32x4 ar[4], ai[4];
#pragma unroll
        for (int m = 0; m < 4; ++m) { ar[m] = (f32x4){0.f, 0.f, 0.f, 0.f}; ai[m] = (f32x4){0.f, 0.f, 0.f, 0.f}; }
#pragma unroll
        for (int ks = 0; ks < 4; ++ks) {
            const bf16x8 br = *(const bf16x8*)(Wl + (size_t)(16 * wave + fr) * 128 + ks * 32 + fq * 8);
            const bf16x8 bi = *(const bf16x8*)(Wl + (size_t)(128 + 16 * wave + fr) * 128 + ks * 32 + fq * 8);
#pragma unroll
            for (int m = 0; m < 4; ++m) { const bf16x8 af = *(const LAS bf16x8*)(AL + (m * 16 + fr) * 136 + ks * 32 + fq * 8);
                ar[m] = MFMA16(af, br, ar[m]); ai[m] = MFMA16(af, bi, ai[m]); }
        }
        const int c = 16 * wave + fr, ch = cb * 128 + c;
        const float ba = INP(16)[ch], bx = INP(18)[ch], lam = INP(19)[ch];
        const float sp = fmaxf(-lam, 0.f) + log1pf(__expf(-fabsf(lam)));
#pragma unroll
        for (int m = 0; m < 4; ++m)
#pragma unroll
            for (int j = 0; j < 4; ++j) { const int t = m * 16 + fq * 4 + j;
                const float r = sigmoidf_(ar[m][j] + ba), ig = sigmoidf_(ai[m][j] + bx);
                const float la = -8.0f * r * sp, av = fexp_(la);
                const float uv = __builtin_amdgcn_sqrtf(fmaxf(1.f - av * av, 0.f)) * ig * U[t * 128 + c];
                AA[t * 128 + c] = av; U[t * 128 + c] = uv; }
    }
    __syncthreads();
    {
        const int c = tid & 127, seg = tid >> 7;
        float h = 0.f, P = 1.f;
#pragma unroll
        for (int i = 0; i < 16; ++i) { const int t = seg * 16 + i; const float av = AA[t * 128 + c], uv = U[t * 128 + c]; h = av * h + uv; P *= av; U[t * 128 + c] = h; AA[t * 128 + c] = P; }
        __syncthreads();
        float hc = 0.f, pc = 1.f;
        for (int s = 0; s < seg; ++s) { const int te = s * 16 + 15; const float pe = AA[te * 128 + c]; hc = pe * hc + U[te * 128 + c]; pc *= pe; }
        __syncthreads();
        if (seg > 0) {
#pragma unroll
            for (int i = 0; i < 16; ++i) { const int t = seg * 16 + i; const float pv = AA[t * 128 + c]; U[t * 128 + c] += pv * hc; AA[t * 128 + c] = pv * pc; }
        }
    }
    __syncthreads();
    {
        const int c8 = tid & 15, rs = tid >> 4, chl = cb * 128 + c8 * 8;
        bf16_t* HL = (bf16_t*)(ws + WS_HLOC); bf16_t* CA = (bf16_t*)(ws + WS_CUMA);
#pragma unroll
        for (int rr = 0; rr < 2; ++rr) { const int tl = rs + 32 * rr; float hv[8], cv[8];
#pragma unroll
            for (int i = 0; i < 8; ++i) { hv[i] = U[tl * 128 + c8 * 8 + i]; cv[i] = AA[tl * 128 + c8 * 8 + i]; }
            *(u32x4*)(HL + (size_t)(tokb + t0 + tl) * D + chl) = pack8(hv); *(u32x4*)(CA + (size_t)(tokb + t0 + tl) * D + chl) = pack8(cv); }
        if (tid < 128) { sm[SM_LRA + (b * 32 + tt) * D + cb * 128 + tid] = AA[63 * 128 + tid]; sm[SM_LRH + (b * 32 + tt) * D + cb * 128 + tid] = U[63 * 128 + tid]; }
    }
    __syncthreads();
}

__device__ __forceinline__ float block_excl_sum(float v, LAS float* red, int tid) {
    const int lane = tid & 63, wave = tid >> 6; float inc = v;
#pragma unroll
    for (int o = 1; o < 64; o <<= 1) { const float t = __shfl_up(inc, o); if (lane >= o) inc += t; }
    __syncthreads();
    if (lane == 63) red[wave] = inc;
    __syncthreads();
    float base = 0.f;
    for (int w = 0; w < wave; ++w) base += red[w];
    return base + inc - v;
}
__device__ __forceinline__ float block_excl_max(float v, LAS float* red, int tid) {
    const int lane = tid & 63, wave = tid >> 6; float inc = v;
#pragma unroll
    for (int o = 1; o < 64; o <<= 1) { const float t = __shfl_up(inc, o); if (lane >= o) inc = fmaxf(inc, t); }
    __syncthreads();
    if (lane == 63) red[wave] = inc;
    __syncthreads();
    float base = -INFINITY;
    for (int w = 0; w < wave; ++w) base = fmaxf(base, red[w]);
    const float prev = __shfl_up(inc, 1);
    return fmaxf(base, lane > 0 ? prev : -INFINITY);
}
__device__ __forceinline__ void gate_scan(const Args& a, LAS unsigned char* lds, int bh) {
    int tid = threadIdx.x; asm volatile("" : "+v"(tid)); float* sm = (float*)(a.ws + WS_SMALL);
    LAS float* BCl = (LAS float*)lds; LAS float* MMl = BCl + T; LAS float* red = MMl + T;
    const int b = bh >> 2, h = bh & 3;
    float lf[4], ig[4], bc[4], gv[4], pmx[4];
#pragma unroll
    for (int i = 0; i < 4; ++i) { const int row = b * T + tid * 4 + i; lf[i] = log_sigmoid_(sm[SM_GF + row * 4 + h]); ig[i] = sm[SM_GI + row * 4 + h]; }
    const float tot = (lf[0] + lf[1]) + (lf[2] + lf[3]);
    const float ex = block_excl_sum(tot, red, tid);
    float run = ex;
#pragma unroll
    for (int i = 0; i < 4; ++i) { run += lf[i]; bc[i] = run; gv[i] = ig[i] - run; }
    const float lm = fmaxf(fmaxf(gv[0], gv[1]), fmaxf(gv[2], gv[3]));
    const float exm = block_excl_max(lm, red, tid);
    float rm = exm;
#pragma unroll
    for (int i = 0; i < 4; ++i) { rm = fmaxf(rm, gv[i]); pmx[i] = rm; BCl[tid * 4 + i] = bc[i]; MMl[tid * 4 + i] = bc[i] + rm; }
    __syncthreads();
#pragma unroll
    for (int i = 0; i < 4; ++i) { const int t = tid * 4 + i, c = t >> 6;
        const float Bprev = c ? BCl[64 * c - 1] : 0.f, mprev = c ? MMl[64 * c - 1] : M_INIT, Blast = BCl[64 * c + 63], mlast = MMl[64 * c + 63];
        const float mm = bc[i] + pmx[i];
        sm[SM_BM + bh * T + t] = -pmx[i]; sm[SM_GIB + bh * T + t] = gv[i]; sm[SM_MM + bh * T + t] = mm;
        sm[SM_SC + bh * T + t] = __expf(bc[i] - Bprev + mprev - mm);
        sm[SM_WK + bh * T + t] = __expf(Blast - bc[i] + ig[i] - mlast);
        if ((t & 63) == 0) sm[SM_DEC + bh * 32 + c] = __expf(Blast - Bprev + mprev - mlast);
        if (t == T - 1) a.out[O_PM + bh] = mm; }
    __syncthreads();
}

#define LBAR() do { asm volatile("s_waitcnt lgkmcnt(0)" ::: "memory"); __builtin_amdgcn_s_barrier(); asm volatile("" ::: "memory"); } while (0)
struct P3Ops { u32x4 vraw[2][2]; bf16x8 kf[2][2]; f32x4 wk[2][2]; float sc, dec; };
__device__ __forceinline__ void p3_load(P3Ops& o, const bf16_t* Q, const bf16_t* KT, const bf16_t* VT, const float* sm, int b, int h, int bh, int es, int c, int wave, int fr, int fq) {
    const int tok0 = b * T + c * 64, gb = bh * T + c * 64, mt = wave >> 1;
#pragma unroll
    for (int ks = 0; ks < 2; ++ks) {
        o.wk[ks][0] = *(const f32x4*)(sm + SM_WK + gb + ks * 32 + fq * 8); o.wk[ks][1] = *(const f32x4*)(sm + SM_WK + gb + ks * 32 + fq * 8 + 4);
#pragma unroll
        for (int e = 0; e < 2; ++e) o.vraw[ks][e] = *(const u32x4*)(VT + (size_t)(h * 256 + es * 32 + e * 16 + fr) * M + tok0 + ks * 32 + fq * 8);
#pragma unroll
        for (int d = 0; d < 2; ++d) o.kf[ks][d] = *(const bf16x8*)(KT + (size_t)(h * 256 + 32 * wave + d * 16 + fr) * M + tok0 + ks * 32 + fq * 8);
    }
    o.sc = sm[SM_SC + gb + mt * 16 + fr]; o.dec = sm[SM_DEC + bh * 32 + c];
}
__device__ __forceinline__ void p3_item(const Args& a, LAS unsigned char* lds, int idx) {
    int tid = threadIdx.x; asm volatile("" : "+v"(tid)); const int lane = tid & 63, wave = tid >> 6, fr = lane & 15, fq = lane >> 4;
    unsigned char* ws = a.ws + opq0(); float* sm = (float*)(ws + WS_SMALL);
    const int es = idx & 7, bh = idx >> 3, b = bh >> 2, h = bh & 3;
    const bf16_t* Q = (const bf16_t*)(ws + WS_Q); const bf16_t* KT = (const bf16_t*)(ws + WS_KT); const bf16_t* VT = (const bf16_t*)(ws + WS_VT);
    bf16_t* NUMI = (bf16_t*)(ws + WS_XC);
    const int ii = tid >> 8, q_ = tid & 255, sit = idx * 2 + ii, ssb = sit >> 2, shh = sit & 3, srow = MP + ssb, ssh = ssb * 4 + shh;
    LAS float* SQ = (LAS float*)(lds + 34816) + ii * 256; LAS float* SK = (LAS float*)(lds + 36864) + ii * 256; LAS float* SV = (LAS float*)(lds + 38912) + ii * 256;
    LAS float* SRED = (LAS float*)(lds + 40960) + ii * 1024; LAS float* SR2 = (LAS float*)(lds + 49152) + ii * 16;
    SQ[q_] = bf2f(Q[(size_t)srow * D + shh * 256 + q_]); SK[q_] = bf2f(((const bf16_t*)(ws + WS_K))[(size_t)srow * D + shh * 256 + q_]); SV[q_] = bf2f(VT[(size_t)(shh * 256 + q_) * M + srow]);
    const float s_lf = log_sigmoid_(sm[SM_GF + srow * 4 + shh]), s_ip = sm[SM_GI + srow * 4 + shh], s_m0 = INP(7)[ssh];
    const float s_mn = fmaxf(s_lf + s_m0, s_ip), s_dec = fexp_(s_lf + s_m0 - s_mn), s_wkk = fexp_(s_ip - s_mn);
    const int s_r = q_ >> 6, s_e4 = (q_ & 63) * 4;
    const float* sC0 = INP(5) + (size_t)ssh * 65536 + s_e4; float* sC1 = a.out + O_SC + (size_t)ssh * 65536 + s_e4;
    f32x4 sacc = (f32x4){0.f, 0.f, 0.f, 0.f};
    f32x4 acc[2][2], accn[2];
#pragma unroll
    for (int e = 0; e < 2; ++e)
#pragma unroll
        for (int d = 0; d < 2; ++d) acc[e][d] = (f32x4){0.f, 0.f, 0.f, 0.f};
    accn[0] = (f32x4){0.f, 0.f, 0.f, 0.f}; accn[1] = (f32x4){0.f, 0.f, 0.f, 0.f};
    P3Ops cur, nxt;
    p3_load(cur, Q, KT, VT, sm, b, h, bh, es, 0, wave, fr, fq);
    bf16x8 qf[8];
#pragma unroll
    for (int ks = 0; ks < 8; ++ks) qf[ks] = *(const bf16x8*)(Q + (size_t)(b * T + 64 + (wave >> 1) * 16 + fr) * D + h * 256 + ks * 32 + fq * 8);
    __syncthreads();
    const f32x4 s_v4 = *(const LAS f32x4*)(SV + s_e4);
    for (int c = 0; c < NCH; ++c) {
        const int tok0 = b * T + c * 64;
        LAS bf16_t* CTr = (LAS bf16_t*)(lds + (c & 1) * 16896);
        LAS bf16_t* CTw = (LAS bf16_t*)(lds + ((c + 1) & 1) * 16896);
        p3_load(nxt, Q, KT, VT, sm, b, h, bh, es, c + 1 < NCH ? c + 1 : c, wave, fr, fq);
        const int sd0 = c * 8 + s_r, sd1 = sd0 + 4;
        const f32x4 sc0 = *(const f32x4*)(sC0 + (size_t)sd0 * 256), sc1 = *(const f32x4*)(sC0 + (size_t)sd1 * 256);
        if (c > 0) {
            const int mt = wave >> 1, et = wave & 1;
            f32x4 ai = (f32x4){0.f, 0.f, 0.f, 0.f};
#pragma unroll
            for (int ks = 0; ks < 8; ++ks) { const bf16x8 cf = *(const LAS bf16x8*)(CTr + (et * 16 + fr) * 264 + ks * 32 + fq * 8); ai = MFMA16(cf, qf[ks], ai); }
            u32x2 w; w.x = pk2(ai[0] * cur.sc, ai[1] * cur.sc); w.y = pk2(ai[2] * cur.sc, ai[3] * cur.sc);
            *(u32x2*)(NUMI + (size_t)(tok0 + mt * 16 + fr) * D + h * 256 + es * 32 + et * 16 + fq * 4) = w;
            const int cq = c + 1 < NCH ? c + 1 : c;
#pragma unroll
            for (int ks = 0; ks < 8; ++ks) qf[ks] = *(const bf16x8*)(Q + (size_t)(b * T + cq * 64 + mt * 16 + fr) * D + h * 256 + ks * 32 + fq * 8);
        }
        if (es == 0 && fq == 0) { sm[SM_NST + (bh * 32 + c) * 256 + 32 * wave + fr] = accn[0][0]; sm[SM_NST + (bh * 32 + c) * 256 + 32 * wave + 16 + fr] = accn[1][0]; }
        const float dec = cur.dec;
#pragma unroll
        for (int e = 0; e < 2; ++e)
#pragma unroll
            for (int d = 0; d < 2; ++d) acc[e][d] = acc[e][d] * dec;
        accn[0] = accn[0] * dec; accn[1] = accn[1] * dec;
#pragma unroll
        for (int ks = 0; ks < 2; ++ks) {
            const f32x4 w0 = cur.wk[ks][0], w1 = cur.wk[ks][1];
            bf16x8 vf[2];
#pragma unroll
            for (int e = 0; e < 2; ++e) { float vv[8]; unpack8(cur.vraw[ks][e], vv);
                vv[0] *= w0[0]; vv[1] *= w0[1]; vv[2] *= w0[2]; vv[3] *= w0[3]; vv[4] *= w1[0]; vv[5] *= w1[1]; vv[6] *= w1[2]; vv[7] *= w1[3];
                const u32x4 pw = pack8(vv); vf[e] = __builtin_bit_cast(bf16x8, pw); }
#pragma unroll
            for (int e = 0; e < 2; ++e)
#pragma unroll
                for (int d = 0; d < 2; ++d) acc[e][d] = MFMA16(vf[e], cur.kf[ks][d], acc[e][d]);
            if (es == 0) {
                float ww[8] = {w0[0], w0[1], w0[2], w0[3], w1[0], w1[1], w1[2], w1[3]};
                u32x4 pw = pack8(ww); if (fr != 0) pw = (u32x4){0u, 0u, 0u, 0u};
                const bf16x8 nf = __builtin_bit_cast(bf16x8, pw);
                accn[0] = MFMA16(nf, cur.kf[ks][0], accn[0]); accn[1] = MFMA16(nf, cur.kf[ks][1], accn[1]);
            }
        }
#pragma unroll
        for (int e = 0; e < 2; ++e)
#pragma unroll
            for (int d = 0; d < 2; ++d)
#pragma unroll
                for (int j = 0; j < 4; ++j) CTw[(e * 16 + fq * 4 + j) * 264 + 32 * wave + d * 16 + fr] = (bf16_t)f2bf(acc[e][d][j]);
        {
            const float k0 = SK[sd0] * s_wkk, k1 = SK[sd1] * s_wkk, q0 = SQ[sd0], q1 = SQ[sd1];
            const f32x4 cn0 = sc0 * s_dec + s_v4 * k0, cn1 = sc1 * s_dec + s_v4 * k1;
            *(f32x4*)(sC1 + (size_t)sd0 * 256) = cn0; *(f32x4*)(sC1 + (size_t)sd1 * 256) = cn1;
            sacc += cn0 * q0 + cn1 * q1;
        }
        LBAR();
        cur = nxt;
    }
#pragma unroll
    for (int e = 0; e < 2; ++e)
#pragma unroll
        for (int d = 0; d < 2; ++d) *(f32x4*)(a.out + O_PC + ((size_t)bh * 256 + 32 * wave + d * 16 + fr) * 256 + es * 32 + e * 16 + fq * 4) = acc[e][d];
    if (es == 0 && fq == 0) { a.out[O_PN + bh * 256 + 32 * wave + fr] = accn[0][0]; a.out[O_PN + bh * 256 + 32 * wave + 16 + fr] = accn[1][0]; }
    *(LAS f32x4*)(SRED + s_r * 256 + s_e4) = sacc;
    const float nn = s_dec * INP(6)[ssh * 256 + q_] + s_wkk * SK[q_];
    a.out[O_SN + ssh * 256 + q_] = nn;
    const float dn = wave_sum(SQ[q_] * nn);
    if (lane == 0) SR2[wave & 3] = dn;
    __syncthreads();
    const float den = (SR2[0] + SR2[1]) + (SR2[2] + SR2[3]);
    const float num = (SRED[q_] + SRED[256 + q_]) + (SRED[512 + q_] + SRED[768 + q_]);
    const float hv = num / fmaxf(fabsf(den), fexp_(-s_mn));
    const float hq = wave_sum(hv * hv);
    if (lane == 0) SR2[4 + (wave & 3)] = hq;
    __syncthreads();
    {
        const float rs = 1.0f / sqrtf(((SR2[4] + SR2[5]) + (SR2[6] + SR2[7])) * (1.f / 256.f) + EPS);
        const bf16_t* Z = (const bf16_t*)(ws + WS_Z);
        const int ch = shh * 256 + q_, blk = ch >> 7, dd = ch & 127;
        const float ym = hv * rs * INP(25)[ch] * sigmoidf_(bf2f(Z[(size_t)srow * NZ + 2048 + ch]));
        const float* xl = sm + SM_XLS + ssb * D + blk * 128; const float* wa = INP(15) + (size_t)blk * 16384 + dd; const float* wx = INP(17) + (size_t)blk * 16384 + dd;
        float rp = INP(16)[ch], ip = INP(18)[ch];
#pragma unroll 16
        for (int c = 0; c < 128; ++c) { const float xv = xl[c]; rp += xv * wa[c * 128]; ip += xv * wx[c * 128]; }
        const float lam = INP(19)[ch], sp = fmaxf(-lam, 0.f) + log1pf(__expf(-fabsf(lam)));
        const float r = sigmoidf_(rp), ig = sigmoidf_(ip), la = -8.0f * r * sp, av = fexp_(la);
        const float uv = __builtin_amdgcn_sqrtf(fmaxf(1.f - av * av, 0.f)) * ig * sm[SM_XLS + ssb * D + ch];
        const float hn = av * INP(3)[ssb * D + ch] + uv;
        a.out[O_SLH + ssb * D + ch] = hn;
        const float mg = sigmoidf_(bf2f(Z[(size_t)srow * NZ + 3072 + ch])) * hn + sigmoidf_(bf2f(Z[(size_t)srow * NZ + 4096 + ch])) * ym;
        ((bf16_t*)(ws + WS_XB))[(size_t)srow * D + ch] = (bf16_t)f2bf(mg);
        if (q_ == 0) a.out[O_SM + ssh] = s_mn;
    }
    __syncthreads();
}
__device__ __forceinline__ void carry_scan(const Args& a, int G) {
    int tid = threadIdx.x; asm volatile("" : "+v"(tid));
    float* sm = (float*)(a.ws + WS_SMALL);
    for (int i = blockIdx.x * NT + tid; i < NB * D; i += G * NT) { const int b = i >> 10, ch = i & 1023; float cr = 0.f;
#pragma unroll
        for (int j = 0; j < NCH; ++j) { sm[SM_CARRY + (b * 32 + j) * D + ch] = cr; cr = sm[SM_LRA + (b * 32 + j) * D + ch] * cr + sm[SM_LRH + (b * 32 + j) * D + ch]; }
        a.out[O_PLH + b * D + ch] = cr; }
}

__device__ __forceinline__ void sample_item(const Args& a, LAS unsigned char* lds, int idx) {
    int tid = threadIdx.x; asm volatile("" : "+v"(tid)); const int lane = tid & 63, wave = tid >> 6;
    unsigned char* ws = a.ws + opq0(); float* sm = (float*)(ws + WS_SMALL);
    const int sb = idx >> 2, h = idx & 3, row = MP + sb, sh = sb * 4 + h;
    const bf16_t* Q = (const bf16_t*)(ws + WS_Q); const bf16_t* Kb = (const bf16_t*)(ws + WS_K); const bf16_t* VT = (const bf16_t*)(ws + WS_VT); const bf16_t* Z = (const bf16_t*)(ws + WS_Z);
    LAS float* qs = (LAS float*)lds; LAS float* ks = qs + 256; LAS float* vs = ks + 256; LAS float* red = vs + 256  ; LAS float* r2 = red + 2048  ;
    if (tid < 256) { qs[tid] = bf2f(Q[(size_t)row * D + h * 256 + tid]); ks[tid] = bf2f(Kb[(size_t)row * D + h * 256 + tid]); vs[tid] = bf2f(VT[(size_t)(h * 256 + tid) * M + row]); }
    const float fpre = sm[SM_GF + row * 4 + h], ipre = sm[SM_GI + row * 4 + h], lf = log_sigmoid_(fpre), m0 = INP(7)[sh];
    const float mn = fmaxf(lf + m0, ipre), dec = __expf(lf + m0 - mn), wkk = __expf(ipre - mn);
    __syncthreads();
    {
        const int e4 = (tid & 63) * 4, dr = tid >> 6;
        const f32x4 v4 = *(const LAS f32x4*)(vs + e4);
        f32x4 ac = (f32x4){0.f, 0.f, 0.f, 0.f};
        const float* C0 = INP(5) + (size_t)sh * 65536; float* C1 = a.out + O_SC + (size_t)sh * 65536;
#pragma unroll 4
        for (int d = dr; d < 256; d += 8) { const f32x4 c0 = *(const f32x4*)(C0 + (size_t)d * 256 + e4); const float kd = ks[d] * wkk;
            const f32x4 cn = c0 * dec + v4 * kd; *(f32x4*)(C1 + (size_t)d * 256 + e4) = cn; ac += cn * qs[d]; }
        *(LAS f32x4*)(red + dr * 256 + e4) = ac;
    }
    float dn = 0.f;
    if (tid < 256) { const float nn = dec * INP(6)[sh * 256 + tid] + wkk * ks[tid]; a.out[O_SN + sh * 256 + tid] = nn; dn = qs[tid] * nn; }
    dn = wave_sum(dn);
    if (lane == 0) r2[wave] = dn;
    __syncthreads();
    const float den = (r2[0] + r2[1]) + (r2[2] + r2[3]);
    float hv = 0.f;
    if (tid < 256) { float num = 0.f;
#pragma unroll
        for (int r = 0; r < 8; ++r) num += red[r * 256 + tid];
        hv = num / fmaxf(fabsf(den), __expf(-mn)); }
    const float hq = wave_sum(hv * hv);
    if (lane == 0) r2[8 + wave] = hq;
    __syncthreads();
    if (tid < 256) {
        const float rs = 1.0f / sqrtf(((r2[8] + r2[9]) + (r2[10] + r2[11])) * (1.f / 256.f) + EPS);
        const int ch = h * 256 + tid, blk = ch >> 7, dd = ch & 127;
        const float ym = hv * rs * INP(25)[ch] * sigmoidf_(bf2f(Z[(size_t)row * NZ + 2048 + ch]));
        const float* xl = sm + SM_XLS + sb * D + blk * 128; const float* wa = INP(15) + (size_t)blk * 16384 + dd; const float* wx = INP(17) + (size_t)blk * 16384 + dd;
        float rp = INP(16)[ch], ip = INP(18)[ch];
#pragma unroll 8
        for (int c = 0; c < 128; ++c) { const float xv = xl[c]; rp += xv * wa[c * 128]; ip += xv * wx[c * 128]; }
        const float lam = INP(19)[ch], sp = fmaxf(-lam, 0.f) + log1pf(__expf(-fabsf(lam)));
        const float r = sigmoidf_(rp), ig = sigmoidf_(ip), la = -8.0f * r * sp, av = __expf(la);
        const float uv = sqrtf(-expm1f(2.f * la)) * ig * sm[SM_XLS + sb * D + ch];
        const float hn = av * INP(3)[sb * D + ch] + uv;
        a.out[O_SLH + sb * D + ch] = hn;
        const float mg = sigmoidf_(bf2f(Z[(size_t)row * NZ + 3072 + ch])) * hn + sigmoidf_(bf2f(Z[(size_t)row * NZ + 4096 + ch])) * ym;
        ((bf16_t*)(ws + WS_XB))[(size_t)row * D + ch] = (bf16_t)f2bf(mg);
        if (tid == 0) a.out[O_SM + sh] = mn;
    }
    __syncthreads();
}

__device__ __forceinline__ void p4w_item(const Args& a, LAS unsigned char* lds, int it) {
    int tid = threadIdx.x; asm volatile("" : "+v"(tid)); const int lane = tid & 63, wave = tid >> 6, fr = lane & 15, fq = lane >> 4;
    unsigned char* ws = a.ws + opq0(); float* sm = (float*)(ws + WS_SMALL);
    it = __builtin_amdgcn_readfirstlane(it);
    const int tt = it & 3, bch = it >> 2, h = bch & 3, c = (bch >> 2) & 31, b = bch >> 7, bh = b * 4 + h, tok0 = b * T + c * 64, gb = bh * T + c * 64;
    const bf16_t* Q = (const bf16_t*)(ws + WS_Q); const bf16_t* Kb = (const bf16_t*)(ws + WS_K); const bf16_t* VT = (const bf16_t*)(ws + WS_VT); const bf16_t* Z = (const bf16_t*)(ws + WS_Z);
    const bf16_t* NUMI = (const bf16_t*)(ws + WS_XC); const bf16_t* HL = (const bf16_t*)(ws + WS_HLOC); const bf16_t* CA = (const bf16_t*)(ws + WS_CUMA);
    bf16_t* MG = (bf16_t*)(ws + WS_XB);
    LAS bf16_t* Sl = (LAS bf16_t*)(lds + wave * 2304);
    const int t = tt * 16 + fr; const size_t tok = (size_t)(tok0 + t);
    bf16x8 qf[8];
#pragma unroll
    for (int ks = 0; ks < 8; ++ks) qf[ks] = *(const bf16x8*)(Q + tok * D + h * 256 + ks * 32 + fq * 8);
    float di = 0.f;
#pragma unroll
    for (int ks = 0; ks < 8; ++ks) { float qq[8]; unpack8(__builtin_bit_cast(u32x4, qf[ks]), qq);
        const f32x4 n0 = *(const f32x4*)(sm + SM_NST + (bh * 32 + c) * 256 + ks * 32 + fq * 8), n1 = *(const f32x4*)(sm + SM_NST + (bh * 32 + c) * 256 + ks * 32 + fq * 8 + 4);
        di += (qq[0] * n0[0] + qq[1] * n0[1]) + (qq[2] * n0[2] + qq[3] * n0[3]) + (qq[4] * n1[0] + qq[5] * n1[1]) + (qq[6] * n1[2] + qq[7] * n1[3]); }
    di += __shfl_xor(di, 16); di += __shfl_xor(di, 32);
    di *= sm[SM_SC + gb + t];
    const float bm = sm[SM_BM + gb + t];
    float ds = 0.f;
    for (int st = 0; st <= tt; ++st) {
        f32x4 sa = (f32x4){0.f, 0.f, 0.f, 0.f};
#pragma unroll
        for (int ks = 0; ks < 8; ++ks) { const bf16x8 kf = *(const bf16x8*)(Kb + (size_t)(tok0 + st * 16 + fr) * D + h * 256 + ks * 32 + fq * 8); sa = MFMA16(kf, qf[ks], sa); }
        const f32x4 gib = *(const f32x4*)(sm + SM_GIB + gb + st * 16 + fq * 4);
        float vv[4];
#pragma unroll
        for (int j = 0; j < 4; ++j) { const int s_ = st * 16 + fq * 4 + j; vv[j] = (s_ <= t) ? sa[j] * fexp_(bm + gib[j]) : 0.f; ds += vv[j]; }
        u32x2 w; w.x = pk2(vv[0], vv[1]); w.y = pk2(vv[2], vv[3]);
        *(LAS u32x2*)(Sl + fr * 72 + st * 16 + fq * 4) = w;
    }
    if ((tt & 1) == 0) { unsigned z0 = 0u; asm volatile("" : "+v"(z0)); *(LAS u32x2*)(Sl + fr * 72 + (tt + 1) * 16 + fq * 4) = (u32x2){z0, z0}; }
    ds += __shfl_xor(ds, 16); ds += __shfl_xor(ds, 32);
    const float den = ds + di;
    const float inv = 1.0f / fmaxf(fabsf(den), fexp_(-sm[SM_MM + gb + t]));
    asm volatile("s_waitcnt lgkmcnt(0)" ::: "memory");
    f32x4 acc[16];
#pragma unroll
    for (int e = 0; e < 16; ++e) acc[e] = (f32x4){0.f, 0.f, 0.f, 0.f};
    const int nks = tt < 2 ? 1 : 2;
    for (int ks = 0; ks < nks; ++ks) { const bf16x8 sf = *(const LAS bf16x8*)(Sl + fr * 72 + ks * 32 + fq * 8);
#pragma unroll
        for (int e = 0; e < 16; ++e) { const bf16x8 vf = *(const bf16x8*)(VT + (size_t)(h * 256 + e * 16 + fr) * M + tok0 + ks * 32 + fq * 8); acc[e] = MFMA16(vf, sf, acc[e]); } }
    asm volatile("s_waitcnt lgkmcnt(0)" ::: "memory");
    float hq = 0.f;
#pragma unroll
    for (int e = 0; e < 16; ++e) { float ni[4] = {0.f, 0.f, 0.f, 0.f};
        if (c > 0) { const u32x2 w = *(const u32x2*)(NUMI + tok * D + h * 256 + e * 16 + fq * 4); ni[0] = bflo(w.x); ni[1] = bfhi(w.x); ni[2] = bflo(w.y); ni[3] = bfhi(w.y); }
#pragma unroll
        for (int j = 0; j < 4; ++j) { const float hv = (acc[e][j] + ni[j]) * inv; acc[e][j] = hv; hq += hv * hv; } }
    hq += __shfl_xor(hq, 16); hq += __shfl_xor(hq, 32);
    const float rs = __builtin_amdgcn_rsqf(hq * (1.f / 256.f) + EPS);
#pragma unroll
    for (int e = 0; e < 16; ++e) { const int ch = h * 256 + e * 16 + fq * 4;
        const f32x4 mg = *(const f32x4*)(INP(25) + ch); const f32x4 cr = *(const f32x4*)(sm + SM_CARRY + (b * 32 + c) * D + ch);
        const u32x2 ow = *(const u32x2*)(Z + tok * NZ + 2048 + ch), glw = *(const u32x2*)(Z + tok * NZ + 3072 + ch), gmw = *(const u32x2*)(Z + tok * NZ + 4096 + ch);
        const u32x2 hlw = *(const u32x2*)(HL + tok * D + ch), caw = *(const u32x2*)(CA + tok * D + ch);
        const float ov[4] = {bflo(ow.x), bfhi(ow.x), bflo(ow.y), bfhi(ow.y)}, gl[4] = {bflo(glw.x), bfhi(glw.x), bflo(glw.y), bfhi(glw.y)}, gm[4] = {bflo(gmw.x), bfhi(gmw.x), bflo(gmw.y), bfhi(gmw.y)};
        const float hl[4] = {bflo(hlw.x), bfhi(hlw.x), bflo(hlw.y), bfhi(hlw.y)}, ca[4] = {bflo(caw.x), bfhi(caw.x), bflo(caw.y), bfhi(caw.y)};
        float o[4];
#pragma unroll
        for (int j = 0; j < 4; ++j) { const float ym = acc[e][j] * rs * mg[j] * sigmoidf_(ov[j]); const float yl = hl[j] + ca[j] * cr[j];
            o[j] = sigmoidf_(gl[j]) * yl + sigmoidf_(gm[j]) * ym; }
        u32x2 w; w.x = pk2(o[0], o[1]); w.y = pk2(o[2], o[3]);
        *(u32x2*)(MG + tok * D + ch) = w; }
}

__device__ __forceinline__ void p9_final(const Args& a, int G) {
    int tid = threadIdx.x; asm volatile("" : "+v"(tid)); const int lane = tid & 63, wave = tid >> 6;
    const float* sm = (const float*)(a.ws + WS_SMALL); const bf16_t* X = (const bf16_t*)(a.ws + WS_X1B);
    const int gw = blockIdx.x * 8 + wave, NGW = G * 8;
    f32x4 g4[4];
#pragma unroll
    for (int j = 0; j < 4; ++j) g4[j] = *((const f32x4*)INP(34) + lane + 64 * j);
    for (int row = gw; row < MR; row += NGW) {
        const float rs = 1.0f / sqrtf(sm[SM_SS3 + row] * (1.f / D) + EPS);
        const u32x2* xr = (const u32x2*)(X + (size_t)row * D) + lane;
        f32x4* o = (f32x4*)(a.out + (row < MP ? O_YP + (size_t)row * D : O_YS + (size_t)(row - MP) * D)) + lane;
#pragma unroll
        for (int j = 0; j < 4; ++j) { const u32x2 w = xr[64 * j]; const f32x4 v = (f32x4){bflo(w.x), bfhi(w.x), bflo(w.y), bfhi(w.y)}; o[64 * j] = v * rs * g4[j]; }
    }
}

template <int KS>
__device__ __forceinline__ void skinny_job(const Args& a, LAS unsigned char* lds, int kind, int G) {
    int tid = threadIdx.x; asm volatile("" : "+v"(tid)); const int lane = tid & 63, wave = tid >> 6, fr = lane & 15, fq = lane >> 4;
    unsigned char* ws = a.ws + opq0(); float* sm = (float*)(ws + WS_SMALL);
    const bf16_t* A; const bf16_t* Bt; int lda, ldb, K, nunits;
    switch (kind) {
    case 0: A = (const bf16_t*)(ws + WS_XB); lda = D; Bt = (const bf16_t*)(ws + WS_W1T); ldb = D; K = D; nunits = NZ / 16; break;
    case 1: A = (const bf16_t*)(ws + WS_XC); lda = D; Bt = (const bf16_t*)(ws + WS_WQKT); ldb = HD; K = HD; nunits = NH * 32; break;
    case 3: A = (const bf16_t*)(ws + WS_Z) + 1024; lda = NZ; Bt = (const bf16_t*)(ws + WS_WVT); ldb = HD; K = HD; nunits = NH * 16; break;
    case 4: A = (const bf16_t*)(ws + WS_XB); lda = D; Bt = (const bf16_t*)(ws + WS_WOT); ldb = D; K = D; nunits = D / 16; break;
    case 5: A = (const bf16_t*)(ws + WS_X1B); lda = D; Bt = (const bf16_t*)(ws + WS_WGUT); ldb = D; K = D; nunits = (DFF / 128) * 8; break;
    case 6: A = (const bf16_t*)(ws + WS_Z); lda = DFF; Bt = (const bf16_t*)(ws + WS_WDT); ldb = DFF; K = DFF; nunits = D / 16; break;
    case 7: A = (const bf16_t*)(ws + WS_PB); lda = PD; Bt = (const bf16_t*)(ws + WS_WPT); ldb = PD; K = PD; nunits = D / 16; break;
    default: A = (const bf16_t*)(ws + WS_X2B); lda = D; Bt = (const bf16_t*)(ws + WS_WPGT); ldb = D; K = D; nunits = D / 16; break;
    }
    const int row = MP + 16 * wave + fr, nksw = K / 256, kw = wave * (K / 8);
    LAS f32x4* red0 = (LAS f32x4*)lds; LAS f32x4* red1 = (LAS f32x4*)(lds + 65536);
    for (int u = blockIdx.x; u < nunits; u += G) {
        int acol = 0, brow0 = u * 16, brow1 = u * 16, z = 0; size_t boff = 0;
        if (kind == 1) { z = u >> 5; acol = z * 256; brow0 = (u & 31) * 16; brow1 = brow0; boff = (size_t)z * 512 * 256; }
        if (kind == 3) { z = u >> 4; acol = z * 256; brow0 = (u & 15) * 16; brow1 = brow0; boff = (size_t)z * 65536; }
        if (kind == 5) { brow0 = (u >> 3) * 256 + (u & 7) * 16; brow1 = brow0 + 128; }
        const bf16_t* Ap = A + (size_t)(MP + fr) * lda + acol + kw + fq * 8;
        const bf16_t* B0p = Bt + boff + (size_t)(brow0 + fr) * ldb + kw + fq * 8;
        const bf16_t* B1p = Bt + boff + (size_t)(brow1 + fr) * ldb + kw + fq * 8;
        bf16x8 b0[KS], b1[KS];
#pragma unroll
        for (int i = 0; i < KS; ++i) if (i < nksw) { b0[i] = *(const bf16x8*)(B0p + i * 32); if (kind == 5) b1[i] = *(const bf16x8*)(B1p + i * 32); }
        f32x4 p0[8], p1[8];
#pragma unroll
        for (int m = 0; m < 8; ++m) { p0[m] = (f32x4){0.f, 0.f, 0.f, 0.f}; p1[m] = (f32x4){0.f, 0.f, 0.f, 0.f}; }
        bf16x8 af[8];
#pragma unroll
        for (int m = 0; m < 8; ++m) af[m] = *(const bf16x8*)(Ap + (size_t)m * 16 * lda);
#pragma unroll
        for (int i = 0; i < KS; ++i) if (i < nksw) {
            bf16x8 an[8];
            const int inx = (i + 1 < nksw) ? i + 1 : i;
#pragma unroll
            for (int m = 0; m < 8; ++m) an[m] = *(const bf16x8*)(Ap + (size_t)m * 16 * lda + inx * 32);
#pragma unroll
            for (int m = 0; m < 8; ++m) { p0[m] = MFMA16(b0[i], af[m], p0[m]); if (kind == 5) p1[m] = MFMA16(b1[i], af[m], p1[m]); }
#pragma unroll
            for (int m = 0; m < 8; ++m) af[m] = an[m];
        }
#pragma unroll
        for (int m = 0; m < 8; ++m) { red0[(wave * 8 + m) * 64 + lane] = p0[m]; if (kind == 5) red1[(wave * 8 + m) * 64 + lane] = p1[m]; }
        __syncthreads();
        f32x4 acc0 = (f32x4){0.f, 0.f, 0.f, 0.f}, acc1 = (f32x4){0.f, 0.f, 0.f, 0.f};
#pragma unroll
        for (int w = 0; w < 8; ++w) { acc0 += red0[(w * 8 + wave) * 64 + lane]; if (kind == 5) acc1 += red1[(w * 8 + wave) * 64 + lane]; }
        __syncthreads();
        switch (kind) {
        case 0: { const float s = sm[SM_RSTD0 + row]; u32x2 w; w.x = pk2(acc0[0] * s, acc0[1] * s); w.y = pk2(acc0[2] * s, acc0[3] * s);
                  *(u32x2*)((bf16_t*)(ws + WS_Z) + (size_t)row * NZ + u * 16 + fq * 4) = w; } break;
        case 1: { const int col = brow0 + fq * 4; bf16_t* dst = (col < 256 ? (bf16_t*)(ws + WS_Q) + col : (bf16_t*)(ws + WS_K) + col - 256) + (size_t)row * D + z * 256;
                  u32x2 w; w.x = pk2(acc0[0], acc0[1]); w.y = pk2(acc0[2], acc0[3]); *(u32x2*)dst = w; } break;
        case 3: { bf16_t* VT = (bf16_t*)(ws + WS_VT);
#pragma unroll
                  for (int j = 0; j < 4; ++j) VT[(size_t)(z * 256 + brow0 + fq * 4 + j) * M + row] = (bf16_t)f2bf(acc0[j]); } break;
        case 4: case 6: { const int col = u * 16 + fq * 4; f32x4 b;
                  if (kind == 4) b = *(const f32x4*)(INP(1) + (size_t)(row - MP) * D + col);
                  else { const u32x2 w = *(const u32x2*)((const bf16_t*)(ws + WS_X1B) + (size_t)row * D + col); b = (f32x4){bflo(w.x), bfhi(w.x), bflo(w.y), bfhi(w.y)}; }
                  const f32x4 v = acc0 + b; u32x2 w; w.x = pk2(v[0], v[1]); w.y = pk2(v[2], v[3]);
                  *(u32x2*)((bf16_t*)(ws + (kind == 4 ? WS_X1B : WS_X2B)) + (size_t)row * D + col) = w;
                  float q = (v[0] * v[0] + v[1] * v[1]) + (v[2] * v[2] + v[3] * v[3]); q += __shfl_xor(q, 16); q += __shfl_xor(q, 32);
                  if (fq == 0) atomicAdd(sm + (kind == 4 ? SM_SS1 : SM_SS2) + row, q); } break;
        case 5: { const float s = __builtin_amdgcn_rsqf(sm[SM_SS1 + row] * (1.f / D) + EPS); float o[4];
#pragma unroll
                  for (int j = 0; j < 4; ++j) { const float gv = acc0[j] * s, uv = acc1[j] * s; o[j] = gv * sigmoidf_(gv) * uv; }
                  u32x2 w; w.x = pk2(o[0], o[1]); w.y = pk2(o[2], o[3]);
                  *(u32x2*)((bf16_t*)(ws + WS_Z) + (size_t)row * DFF + (u >> 3) * 128 + (u & 7) * 16 + fq * 4) = w; } break;
        case 7: { u32x2 w; w.x = pk2(acc0[0], acc0[1]); w.y = pk2(acc0[2], acc0[3]); *(u32x2*)((bf16_t*)(ws + WS_PE) + (size_t)row * D + u * 16 + fq * 4) = w; } break;
        default: { const int col = u * 16 + fq * 4; const float s = __builtin_amdgcn_rsqf(sm[SM_SS2 + row] * (1.f / D) + EPS);
                  const u32x2 xw = *(const u32x2*)((const bf16_t*)(ws + WS_X2B) + (size_t)row * D + col), pw = *(const u32x2*)((const bf16_t*)(ws + WS_PE) + (size_t)row * D + col);
                  const float xb[4] = {bflo(xw.x), bfhi(xw.x), bflo(xw.y), bfhi(xw.y)}, pe[4] = {bflo(pw.x), bfhi(pw.x), bflo(pw.y), bfhi(pw.y)};
                  float v[4], q = 0.f;
#pragma unroll
                  for (int j = 0; j < 4; ++j) { v[j] = xb[j] + sigmoidf_(acc0[j] * s) * pe[j]; q += v[j] * v[j]; }
                  u32x2 w; w.x = pk2(v[0], v[1]); w.y = pk2(v[2], v[3]); *(u32x2*)((bf16_t*)(ws + WS_X1B) + (size_t)row * D + col) = w;
                  q += __shfl_xor(q, 16); q += __shfl_xor(q, 32);
                  if (fq == 0) atomicAdd(sm + SM_SS3 + row, q); } break;
        }
    }
}
__device__ __forceinline__ int skinny_kind(int ph, int j) {
    if (ph == 1) return j == 0 ? 0 : -1;
    if (ph == 3) return j == 0 ? 1 : (j == 1 ? 3 : -1);
    if (ph == 6) return j == 0 ? 4 : -1;
    if (ph == 7) return j == 0 ? 5 : -1;
    if (ph == 8) return j == 0 ? 6 : -1;
    if (ph == 9) return j == 0 ? 7 : (j == 1 ? 8 : -1);
    return -1;
}

namespace pg8 {
struct EpiAny {
    int kind; unsigned char* ws; const float* xp; const float* xs;
    __device__ __forceinline__ void operator()(const f32x4 (&acc)[2][2][4][2], const Unit& u, int wr, int wc, int fr, int fq) const {
        float* sm = (float*)(ws + WS_SMALL);
        switch (kind) {
        case 0: { EpiZ E{(bf16_t*)(ws + WS_Z), sm + SM_RSTD0}; E(acc, u, wr, wc, fr, fq); } break;
        case 1: { EpiQK E{(bf16_t*)(ws + WS_Q), (bf16_t*)(ws + WS_K)}; E(acc, u, wr, wc, fr, fq); } break;
        case 2: { EpiT E{(bf16_t*)(ws + WS_KT)}; E(acc, u, wr, wc, fr, fq); } break;
        case 3: { EpiT E{(bf16_t*)(ws + WS_VT)}; E(acc, u, wr, wc, fr, fq); } break;
        case 4: { EpiRes<0> E{xp, xs, nullptr, (bf16_t*)(ws + WS_X1B), sm + SM_SS1}; E(acc, u, wr, wc, fr, fq); } break;
        case 5: { EpiGU E{(bf16_t*)(ws + WS_Z), sm + SM_SS1}; E(acc, u, wr, wc, fr, fq); } break;
        case 6: { EpiRes<1> E{nullptr, nullptr, (const bf16_t*)(ws + WS_X1B), (bf16_t*)(ws + WS_X2B), sm + SM_SS2}; E(acc, u, wr, wc, fr, fq); } break;
        case 7: { EpiPlain E{(bf16_t*)(ws + WS_PE), D}; E(acc, u, wr, wc, fr, fq); } break;
        default: { EpiPle E{(const bf16_t*)(ws + WS_X2B), (bf16_t*)(ws + WS_X1B), (const bf16_t*)(ws + WS_PE), sm + SM_SS2, sm + SM_SS3}; E(acc, u, wr, wc, fr, fq); } break;
        }
    }
};
}

__device__ __forceinline__ bool gemm_job(unsigned char* ws, int ph, int j, pg8::Gemm& g, int& nM, int& nN, int& nZ, int& kind) {
    using namespace pg8;
    const bf16_t* w = (const bf16_t*)ws;
#define WSB(off) ((const bf16_t*)(ws + (off)))
    if (ph == 1 && j == 0) { g = Gemm{WSB(WS_XB), WSB(WS_W1T), D, D, D, 0, 0}; nM = MP / 256; nN = NZ / 256; nZ = 1; kind = 0; return true; }
    if (ph == 3 && j == 0) { g = Gemm{WSB(WS_XC), WSB(WS_WQKT), D, HD, HD, 512, (size_t)512 * 256 * 2}; nM = MP / 256; nN = 2; nZ = NH; kind = 1; return true; }
    if (ph == 3 && j == 1) { g = Gemm{WSB(WS_WQKT) + 65536, WSB(WS_XC), HD, D, HD, (size_t)512 * 256 * 2, 512}; nM = 1; nN = MP / 256; nZ = NH; kind = 2; return true; }
    if (ph == 3 && j == 2) { g = Gemm{WSB(WS_WVT), WSB(WS_Z) + 1024, HD, NZ, HD, (size_t)65536 * 2, 512}; nM = 1; nN = MP / 256; nZ = NH; kind = 3; return true; }
    if (ph == 6 && j == 0) { g = Gemm{WSB(WS_XB), WSB(WS_WOT), D, D, D, 0, 0}; nM = MP / 256; nN = D / 256; nZ = 1; kind = 4; return true; }
    if (ph == 7 && j == 0) { g = Gemm{WSB(WS_X1B), WSB(WS_WGUT), D, D, D, 0, 0}; nM = MP / 256; nN = NGU / 256; nZ = 1; kind = 5; return true; }
    if (ph == 8 && j == 0) { g = Gemm{WSB(WS_Z), WSB(WS_WDT), DFF, DFF, DFF, 0, 0}; nM = MP / 256; nN = D / 256; nZ = 1; kind = 6; return true; }
    if (ph == 9 && j == 0) { g = Gemm{WSB(WS_PB), WSB(WS_WPT), PD, PD, PD, 0, 0}; nM = MP / 256; nN = D / 256; nZ = 1; kind = 7; return true; }
    if (ph == 9 && j == 1) { g = Gemm{WSB(WS_X2B), WSB(WS_WPGT), D, D, D, 0, 0}; nM = MP / 256; nN = D / 256; nZ = 1; kind = 8; return true; }
#undef WSB
    (void)w; return false;
}

#ifndef REPMASK
#define REPMASK 0
#endif
constexpr int NPHASE = 11;
__global__ void __launch_bounds__(NT, 2) hawk_fwd(Args a) {
    extern __shared__ __attribute__((aligned(16))) unsigned char lds_raw[];
    LAS unsigned char* lds = (LAS unsigned char*)lds_raw;
    cg::grid_group grid = cg::this_grid();
    const int G = gridDim.x, bx = blockIdx.x;
    for (int ph = a.ph_lo; ph < a.ph_hi; ++ph) {
        for (int rep = 0; rep < 1 + ((REPMASK >> ph) & 1); ++rep) {
            if (rep) grid.sync();
            switch (ph) {
            case 0: p0_prologue(a, lds, G); break;
            case 2: for (int it = bx; it < 2048 + MS; it += G) p2a_item(a, lds, it); break;
            case 3: for (int bh = bx; bh < 32; bh += G) gate_scan(a, lds, bh); break;
            case 4: carry_scan(a, G);
                    for (int it = bx; it < 256; it += G) p3_item(a, lds, it); break;
            case 5: { int tw = threadIdx.x; asm volatile("" : "+v"(tw)); for (int it = bx * 8 + (tw >> 6); it < 4096; it += G * 8) p4w_item(a, lds, it); } break;
            case 10: p9_final(a, G); break;
            default: break;
            }
            for (int sj = 0; sj < 2; ++sj) { const int sk = skinny_kind(ph, sj); if (sk < 0) break; if (sk == 6) skinny_job<11>(a, lds, sk, G); else skinny_job<4>(a, lds, sk, G); __syncthreads(); }
            __syncthreads();
            for (int j = 0; j < 3; ++j) {
                pg8::Gemm g; int nM, nN, nZ, kind;
                if (!gemm_job(a.ws, ph, j, g, nM, nN, nZ, kind)) break;
                pg8::Order S; S.init(nM, nN, nZ, G, bx);
                pg8::EpiAny E{kind, a.ws, a.in[0], a.in[1]};
                pg8::gemm_phase(lds, g, S, E);
            }
        }
        if (ph + 1 < a.ph_hi) grid.sync();
    }
}

#ifndef N_LAUNCH_SPLIT
#define N_LAUNCH_SPLIT 0
#endif
extern "C" void kernel_launch(void* const* d_in, const int* in_sizes, int n_in, void* d_out, int out_size, void* d_ws, size_t ws_size, hipStream_t stream) {
    static int grid = 0;
    if (grid == 0) {
        int dev = 0, cus = 0, per_cu = 0;
        hipGetDevice(&dev);
        hipDeviceGetAttribute(&cus, hipDeviceAttributeMultiprocessorCount, dev);
        hipFuncSetAttribute((const void*)hawk_fwd, hipFuncAttributeMaxDynamicSharedMemorySize, LDS_BYTES);
        hipOccupancyMaxActiveBlocksPerMultiprocessor(&per_cu, (const void*)hawk_fwd, NT, LDS_BYTES);
        if (per_cu < 1) { fprintf(stderr, "kernel_launch: occupancy query says %d blocks per CU\n", per_cu); per_cu = 1; }
        grid = cus * per_cu;
        if (n_in != 35 || ws_size < WS_END || (size_t)out_size != O_END) fprintf(stderr, "kernel_launch: unexpected sizes n_in %d ws %zu out %d\n", n_in, ws_size, out_size);
    }
    Args a{};
    for (int i = 0; i < 35; ++i) a.in[i] = (const float*)d_in[i];
    a.out = (float*)d_out; a.ws = (unsigned char*)d_ws;
#if N_LAUNCH_SPLIT
    for (int p = 0; p < NPHASE; ++p) { a.ph_lo = p; a.ph_hi = p + 1; hipLaunchKernelGGL(hawk_fwd, dim3(grid), dim3(NT), LDS_BYTES, stream, a); }
#else
    a.ph_lo = 0; a.ph_hi = NPHASE;
    void* args[] = {&a};
    hipError_t e = hipLaunchCooperativeKernel((const void*)hawk_fwd, dim3(grid), dim3(NT), args, LDS_BYTES, stream);
    if (e != hipSuccess) fprintf(stderr, "cooperative launch failed: %s (grid %d)\n", hipGetErrorString(e), grid);
#endif
}
```

```cpp
#include <hip/hip_runtime.h>
#include <hip/hip_cooperative_groups.h>
#include <cstdio>
#include <cstdint>
namespace cg = cooperative_groups;

#define LAS __attribute__((address_space(3)))
typedef unsigned short bf16_t;
typedef short bf16x8 __attribute__((ext_vector_type(8)));
typedef float f32x4 __attribute__((ext_vector_type(4)));
typedef float f32x2 __attribute__((ext_vector_type(2)));
typedef unsigned u32x4 __attribute__((ext_vector_type(4)));
typedef unsigned u32x2 __attribute__((ext_vector_type(2)));

constexpr int D = 1024, NB = 8, T = 2048, MP = NB * T, MS = 128, MR = MP + MS, M = 16640  ;
constexpr int NZ = 5120, DFF = 2816, NGU = 2 * DFF, PD = 256, NIN = 5128, NH = 4, HD = 256, NCH = T / 64;
constexpr float EPS = 1e-6f;
constexpr float M_INIT = -1e30f;

constexpr size_t MiB = 1u << 20;
constexpr size_t WS_W1T = 0;
constexpr size_t WS_WOT = 10 * MiB;
constexpr size_t WS_WGUT = 12 * MiB;
constexpr size_t WS_WDT = 23 * MiB;
constexpr size_t WS_WPGT = 57 * MiB / 2;
constexpr size_t WS_WPT = 61 * MiB / 2;
constexpr size_t WS_WQKT = 31 * MiB;
constexpr size_t WS_WVT = 32 * MiB;
constexpr size_t WS_WLRUT = 65 * MiB / 2;
constexpr size_t WS_BAR = 40 * MiB - 16384;
constexpr size_t WS_SMALL = 33 * MiB;
constexpr size_t WS_XB = 40 * MiB;
constexpr size_t WS_PB = 73 * MiB;
constexpr size_t WS_Z = 82 * MiB;
constexpr size_t WS_XC = 245 * MiB;
constexpr size_t WS_Q = 278 * MiB;
constexpr size_t WS_K = 311 * MiB;
constexpr size_t WS_KT = 344 * MiB;
constexpr size_t WS_VT = 377 * MiB;
constexpr size_t WS_HLOC = 410 * MiB;
constexpr size_t WS_CUMA = 443 * MiB;
constexpr size_t WS_END = 476 * MiB;
constexpr size_t WS_X1 = WS_Q;
constexpr size_t WS_X1B = WS_KT;
constexpr size_t WS_X2B = WS_VT;
constexpr size_t WS_PE = WS_HLOC;
constexpr int SM_RSTD0 = 0;
constexpr int SM_SS1 = SM_RSTD0 + M;
constexpr int SM_SS2 = SM_SS1 + M;
constexpr int SM_SS3 = SM_SS2 + M;
constexpr int SM_GI = SM_SS3 + M;
constexpr int SM_GF = SM_GI + 4 * M;
constexpr int SM_BM = SM_GF + 4 * M;
constexpr int SM_GIB = SM_BM + 32 * T;
constexpr int SM_SC = SM_GIB + 32 * T;
constexpr int SM_WK = SM_SC + 32 * T;
constexpr int SM_MM = SM_WK + 32 * T;
constexpr int SM_DEC = SM_MM + 32 * T;
constexpr int SM_NST = SM_DEC + 1024;
constexpr int SM_LRA = SM_NST + 32 * 32 * 256;
constexpr int SM_LRH = SM_LRA + 8 * 32 * 1024;
constexpr int SM_XLS = SM_LRH + 8 * 32 * 1024;
constexpr int SM_CARRY = SM_XLS + 128 * 1024;
constexpr int SM_END = SM_CARRY + 8 * 32 * 1024;
static_assert((size_t)SM_END * 4 <= 7 * MiB - 16384, "small arrays");
static_assert(WS_END <= 512 * MiB, "workspace");

constexpr size_t O_YP = 0, O_YS = O_YP + (size_t)MP * D, O_PLC = O_YS + (size_t)MS * D, O_PLH = O_PLC + 8 * 3 * 1024, O_PMC = O_PLH + 8 * 1024,
                 O_PC = O_PMC + 8 * 3 * 1024, O_PN = O_PC + (size_t)8 * 4 * 65536, O_PM = O_PN + 8 * 4 * 256, O_SLC = O_PM + 32, O_SLH = O_SLC + (size_t)128 * 3 * 1024,
                 O_SMC = O_SLH + 128 * 1024, O_SC = O_SMC + (size_t)128 * 3 * 1024, O_SN = O_SC + (size_t)128 * 4 * 65536, O_SM = O_SN + 128 * 4 * 256, O_END = O_SM + 512;

constexpr int LDS_BYTES = 147456;
constexpr int NT = 512;

struct Args {
    const float* in[35];
    float* out;
    unsigned char* ws;
    int ph_lo, ph_hi;
};

__device__ __forceinline__ size_t opq0() { size_t z = 0; asm volatile("" : "+s"(z)); return z; }
#define INP(k) (a.in[k] + opq0())
__device__ __forceinline__ unsigned f2bf(float f) { unsigned u = __builtin_bit_cast(unsigned, f); return (u + 0x7fffu + ((u >> 16) & 1u)) >> 16; }
__device__ __forceinline__ unsigned pk2(float lo, float hi) { return f2bf(lo) | (f2bf(hi) << 16); }
__device__ __forceinline__ float bf2f(unsigned short h) { return __builtin_bit_cast(float, (unsigned)h << 16); }
__device__ __forceinline__ float bflo(unsigned w) { return __builtin_bit_cast(float, w << 16); }
__device__ __forceinline__ float bfhi(unsigned w) { return __builtin_bit_cast(float, w & 0xffff0000u); }
__device__ __forceinline__ float sigmoidf_(float x) { return __builtin_amdgcn_rcpf(1.f + __builtin_amdgcn_exp2f(-1.4426950408889634f * x)); }
__device__ __forceinline__ float fexp_(float x) { return __builtin_amdgcn_exp2f(1.4426950408889634f * x); }
__device__ __forceinline__ void unpack8x(const u32x4 w, float (&o)[8]) { o[0] = bflo(w.x); o[1] = bfhi(w.x); o[2] = bflo(w.y); o[3] = bfhi(w.y); o[4] = bflo(w.z); o[5] = bfhi(w.z); o[6] = bflo(w.w); o[7] = bfhi(w.w); }
__device__ __forceinline__ float wave_sum(float v) {
#pragma unroll
    for (int o = 1; o < 64; o <<= 1) v += __shfl_xor(v, o);
    return v;
}
__device__ __forceinline__ const float* xrow_ptr(const Args& a, int row) {
    return row < MP ? INP(0) + (size_t)row * D : INP(1) + (size_t)(row - MP) * D;
}

namespace pg8 {
constexpr int BM = 256, BK = 64, HALF = 128, HTB = HALF * BK * 2, STAGE_BYTES = 8 * HTB, NXCD = 8, WGM = 8;
__device__ __forceinline__ int lds_byte(int r, int c) { const int st = (r >> 4) * 2 + (c >> 5), rr = r & 15, cc = c & 31, ob = rr * 64 + cc * 2; return st * 1024 + (ob ^ (((ob >> 9) & 1) << 5)); }
__device__ __forceinline__ void stage_rc(int b, int& R, int& C) { const int st = b / 1024, sb = b % 1024, swz = sb ^ (((sb >> 9) & 1) << 5); R = (st >> 1) * 16 + swz / 64; C = (st & 1) * 32 + (swz % 64) / 2; }
__device__ __forceinline__ int perm32(int rho) { const int n = rho >> 4, i = rho & 15; return 8 * (i >> 2) + 4 * n + (i & 3); }

struct Unit { int pm, pn, z; };
struct Gemm { const bf16_t* A; const bf16_t* Bt; int lda, ldb, K; size_t zA, zB; };

struct Order {
    int nM, nN, nwg, total, G, c;
    __device__ void init(int nM_, int nN_, int nZ_, int G_, int c_) { nM = nM_; nN = nN_; nwg = nM * nN; total = nwg * nZ_; G = G_; c = c_; }
    __device__ bool next(int i, Unit& u) const {
        const long L = (long)i * G + c; if (L >= total) return false;
        u.z = (int)(L / nwg); int wgid = (int)(L % nwg);
        { const int q = nwg / NXCD, r = nwg % NXCD, xcd = wgid % NXCD, off = wgid / NXCD; wgid = (xcd < r ? xcd * (q + 1) : r * (q + 1) + (xcd - r) * q) + off; }
        const int nig = WGM * nN, gid = wgid / nig, fm = gid * WGM, gsz = (nM - fm) < WGM ? (nM - fm) : WGM;
        u.pm = fm + ((wgid % nig) % gsz); u.pn = (wgid % nig) / gsz; return true;
    }
};

__device__ __forceinline__ unsigned cvt_pk_bf16(float lo, float hi) { unsigned r; asm volatile("v_cvt_pk_bf16_f32 %0, %1, %2" : "=v"(r) : "v"(lo), "v"(hi)); return r; }

template <class Epi>
__device__ __forceinline__ void gemm_phase(LAS unsigned char* lds, const Gemm g, const Order& S, const Epi& E) {
    int tid = threadIdx.x; asm volatile("" : "+v"(tid));
    const int wid = __builtin_amdgcn_readfirstlane(tid >> 6), lane = tid & 63, wr = wid >> 2, wc = wid & 3, fr = lane & 15, fq = lane >> 4;
    const int K = g.K, nt = K / BK;
    unsigned voffA[2], voffB[2];
#pragma unroll
    for (int i = 0; i < 2; ++i) { int R, C; stage_rc(tid * 16 + i * 8192, R, C); const int Rb = (R & ~31) + perm32(R & 31);
        voffA[i] = (unsigned)(R * g.lda + C) * 2u; voffB[i] = (unsigned)(Rb * g.ldb + C) * 2u; }
    const size_t kstep = (size_t)(BK * 2);
    const size_t hstepA = (size_t)HALF * g.lda * 2, hstepB = (size_t)HALF * g.ldb * 2;
    const size_t tstepA = 2 * hstepA, tstepB = 2 * hstepB;
    const unsigned ldsw = (unsigned)wid * 1024u;
    const int aoff = lds_byte(wr * 64 + fr, fq * 8), boff = lds_byte(wc * 32 + fr, fq * 8);
#define PG8_SA(b, h) (((b) * 2 + (h)) * HTB)
#define PG8_SB(b, h) ((4 + (b) * 2 + (h)) * HTB)
#define PG8_STAGE(bufoff, gbase, voff) do { _Pragma("unroll") for (int _i = 0; _i < 2; ++_i) \
        __builtin_amdgcn_global_load_lds((const unsigned*)((const char*)(gbase) + (voff)[_i]), (LAS unsigned*)(lds + (bufoff) + ldsw + _i * 8192), 16, 0, 0); } while (0)
#define PG8_LDA(dst, b, h) do { _Pragma("unroll") for (int m = 0; m < 4; ++m) _Pragma("unroll") for (int k = 0; k < 2; ++k) dst[m][k] = *(const LAS bf16x8*)(lds + PG8_SA(b, h) + aoff + m * 2048 + k * 1024); } while (0)
#define PG8_LDB(dst, b, h) do { _Pragma("unroll") for (int n = 0; n < 2; ++n) _Pragma("unroll") for (int k = 0; k < 2; ++k) dst[n][k] = *(const LAS bf16x8*)(lds + PG8_SB(b, h) + boff + n * 2048 + k * 1024); } while (0)
#define PG8_MMA(ai, bj, At, Bt) do { __builtin_amdgcn_s_setprio(1); _Pragma("unroll") for (int m = 0; m < 4; ++m) _Pragma("unroll") for (int n = 0; n < 2; ++n) _Pragma("unroll") for (int k = 0; k < 2; ++k) \
        acc[ai][bj][m][n] = __builtin_amdgcn_mfma_f32_16x16x32_bf16(Bt[n][k], At[m][k], acc[ai][bj][m][n], 0, 0, 0); __builtin_amdgcn_s_setprio(0); } while (0)
#define PG8_WAIT_V(n) asm volatile("s_waitcnt vmcnt(" #n ")" ::: "memory")
#define PG8_WAIT_L(n) asm volatile("s_waitcnt lgkmcnt(" #n ")" ::: "memory")
#define PG8_BAR __builtin_amdgcn_s_barrier()
#define PG8_SCHED __builtin_amdgcn_sched_barrier(0)
    Unit cur, nxt; int ui = 0;
    if (!S.next(0, cur)) return;
    f32x4 acc[2][2][4][2];
#pragma unroll
    for (int a = 0; a < 2; ++a)
#pragma unroll
        for (int b = 0; b < 2; ++b)
#pragma unroll
            for (int m = 0; m < 4; ++m)
#pragma unroll
                for (int n = 0; n < 2; ++n) acc[a][b][m][n] = (f32x4){0.f, 0.f, 0.f, 0.f};
    bf16x8 At[4][2], B0[2][2], B1[2][2];
    const char* cA = (const char*)g.A + (size_t)cur.pm * tstepA + (size_t)cur.z * g.zA; const char* cB = (const char*)g.Bt + (size_t)cur.pn * tstepB + (size_t)cur.z * g.zB;
    PG8_STAGE(PG8_SB(0, 0), cB, voffB); PG8_STAGE(PG8_SB(0, 1), cB + hstepB, voffB); PG8_STAGE(PG8_SA(0, 0), cA, voffA); PG8_STAGE(PG8_SA(0, 1), cA + hstepA, voffA);
    if (wr == 1) PG8_BAR;
    PG8_WAIT_V(2); PG8_BAR;
    PG8_STAGE(PG8_SB(1, 0), cB + kstep, voffB); PG8_STAGE(PG8_SA(1, 0), cA + kstep, voffA); PG8_STAGE(PG8_SB(1, 1), cB + hstepB + kstep, voffB);
    PG8_WAIT_V(6); PG8_BAR;
    for (;;) {
        const bool has_next = S.next(ui + 1, nxt);
        const char* nA = has_next ? (const char*)g.A + (size_t)nxt.pm * tstepA + (size_t)nxt.z * g.zA : cA;
        const char* nB = has_next ? (const char*)g.Bt + (size_t)nxt.pn * tstepB + (size_t)nxt.z * g.zB : cB;
        for (int t = 0; t < nt; t += 2) {
            const bool last = (t == nt - 2);
            const char* a1 = cA + (size_t)(t + 1) * kstep;
            const char* a2 = last ? nA : cA + (size_t)(t + 2) * kstep; const char* b2 = last ? nB : cB + (size_t)(t + 2) * kstep;
            const char* a3 = a2 + kstep; const char* b3 = b2 + kstep;
            PG8_LDB(B0, 0, 0); PG8_LDB(B1, 0, 1); PG8_SCHED; PG8_LDA(At, 0, 0); PG8_STAGE(PG8_SA(1, 1), a1 + hstepA, voffA);
            PG8_WAIT_V(8); PG8_WAIT_L(0); PG8_BAR; PG8_MMA(0, 0, At, B0); PG8_MMA(0, 1, At, B1); PG8_BAR; PG8_SCHED;
            PG8_LDA(At, 0, 1); PG8_STAGE(PG8_SB(0, 0), b2, voffB); PG8_STAGE(PG8_SB(0, 1), b2 + hstepB, voffB); PG8_STAGE(PG8_SA(0, 0), a2, voffA);
            PG8_WAIT_V(8); PG8_WAIT_L(0); PG8_BAR; PG8_MMA(1, 0, At, B0); PG8_MMA(1, 1, At, B1); PG8_BAR; PG8_SCHED;
            PG8_LDB(B0, 1, 0); PG8_LDB(B1, 1, 1); PG8_SCHED; PG8_LDA(At, 1, 0); PG8_STAGE(PG8_SA(0, 1), a2 + hstepA, voffA);
            PG8_WAIT_V(8); PG8_WAIT_L(0); PG8_BAR; PG8_MMA(0, 0, At, B0); PG8_MMA(0, 1, At, B1); PG8_BAR; PG8_SCHED;
            PG8_LDA(At, 1, 1); PG8_STAGE(PG8_SB(1, 0), b3, voffB); PG8_STAGE(PG8_SB(1, 1), b3 + hstepB, voffB); PG8_STAGE(PG8_SA(1, 0), a3, voffA);
            PG8_WAIT_V(8); PG8_WAIT_L(0); PG8_BAR; PG8_MMA(1, 0, At, B0); PG8_MMA(1, 1, At, B1); PG8_BAR; PG8_SCHED;
        }
        if (wr == 0) PG8_BAR;
        E(acc, cur, wr, wc, fr, fq);
        if (!has_next) break;
#pragma unroll
        for (int a = 0; a < 2; ++a)
#pragma unroll
            for (int b = 0; b < 2; ++b)
#pragma unroll
                for (int m = 0; m < 4; ++m)
#pragma unroll
                    for (int n = 0; n < 2; ++n) acc[a][b][m][n] = (f32x4){0.f, 0.f, 0.f, 0.f};
        cur = nxt; cA = nA; cB = nB; ++ui;
        if (wr == 1) PG8_BAR;
    }
    PG8_WAIT_V(0);
    PG8_BAR;
#undef PG8_SA
#undef PG8_SB
#undef PG8_STAGE
#undef PG8_LDA
#undef PG8_LDB
#undef PG8_MMA
#undef PG8_WAIT_V
#undef PG8_WAIT_L
#undef PG8_BAR
#undef PG8_SCHED
}

#define EPI_ROW0(u) ((u).pm * BM + wr * 64 + fr)
#define EPI_COL0(u) ((u).pn * BM + wc * 32 + 8 * fq)

struct EpiZ {
    bf16_t* Zp; const float* rstd;
    __device__ __forceinline__ void operator()(const f32x4 (&acc)[2][2][4][2], const Unit& u, int wr, int wc, int fr, int fq) const {
        const int row0 = EPI_ROW0(u), col0 = EPI_COL0(u);
#pragma unroll
        for (int ai = 0; ai < 2; ++ai)
#pragma unroll
            for (int m = 0; m < 4; ++m) { const int row = row0 + ai * HALF + m * 16; const float s = rstd[row]; bf16_t* rp = Zp + (size_t)row * NZ + col0;
#pragma unroll
                for (int bj = 0; bj < 2; ++bj) { const f32x4 v0 = acc[ai][bj][m][0] * s, v1 = acc[ai][bj][m][1] * s; u32x4 w;
                    w.x = cvt_pk_bf16(v0[0], v0[1]); w.y = cvt_pk_bf16(v0[2], v0[3]); w.z = cvt_pk_bf16(v1[0], v1[1]); w.w = cvt_pk_bf16(v1[2], v1[3]);
                    *(u32x4*)(rp + bj * HALF) = w; } }
    }
};
struct EpiQK {
    bf16_t* Qp; bf16_t* Kp;
    __device__ __forceinline__ void operator()(const f32x4 (&acc)[2][2][4][2], const Unit& u, int wr, int wc, int fr, int fq) const {
        const int row0 = EPI_ROW0(u), col0 = u.z * 256 + wc * 32 + 8 * fq; bf16_t* base = u.pn ? Kp : Qp;
#pragma unroll
        for (int ai = 0; ai < 2; ++ai)
#pragma unroll
            for (int m = 0; m < 4; ++m) { const int row = row0 + ai * HALF + m * 16; bf16_t* rp = base + (size_t)row * D + col0;
#pragma unroll
                for (int bj = 0; bj < 2; ++bj) { const f32x4 v0 = acc[ai][bj][m][0], v1 = acc[ai][bj][m][1]; u32x4 w;
                    w.x = cvt_pk_bf16(v0[0], v0[1]); w.y = cvt_pk_bf16(v0[2], v0[3]); w.z = cvt_pk_bf16(v1[0], v1[1]); w.w = cvt_pk_bf16(v1[2], v1[3]);
                    *(u32x4*)(rp + bj * HALF) = w; } }
    }
};
struct EpiT {
    bf16_t* Op;
    __device__ __forceinline__ void operator()(const f32x4 (&acc)[2][2][4][2], const Unit& u, int wr, int wc, int fr, int fq) const {
        const int row0 = wr * 64 + fr, col0 = EPI_COL0(u);
#pragma unroll
        for (int ai = 0; ai < 2; ++ai)
#pragma unroll
            for (int m = 0; m < 4; ++m) { const int row = row0 + ai * HALF + m * 16; bf16_t* rp = Op + ((size_t)u.z * 256 + row) * M + col0;
#pragma unroll
                for (int bj = 0; bj < 2; ++bj) { const f32x4 v0 = acc[ai][bj][m][0], v1 = acc[ai][bj][m][1]; u32x4 w;
                    w.x = cvt_pk_bf16(v0[0], v0[1]); w.y = cvt_pk_bf16(v0[2], v0[3]); w.z = cvt_pk_bf16(v1[0], v1[1]); w.w = cvt_pk_bf16(v1[2], v1[3]);
                    *(u32x4*)(rp + bj * HALF) = w; } }
    }
};
struct EpiPlain {
    bf16_t* Op; int ldc;
    __device__ __forceinline__ void operator()(const f32x4 (&acc)[2][2][4][2], const Unit& u, int wr, int wc, int fr, int fq) const {
        const int row0 = EPI_ROW0(u), col0 = EPI_COL0(u);
#pragma unroll
        for (int ai = 0; ai < 2; ++ai)
#pragma unroll
            for (int m = 0; m < 4; ++m) { const int row = row0 + ai * HALF + m * 16; bf16_t* rp = Op + (size_t)row * ldc + col0;
#pragma unroll
                for (int bj = 0; bj < 2; ++bj) { const f32x4 v0 = acc[ai][bj][m][0], v1 = acc[ai][bj][m][1]; u32x4 w;
                    w.x = cvt_pk_bf16(v0[0], v0[1]); w.y = cvt_pk_bf16(v0[2], v0[3]); w.z = cvt_pk_bf16(v1[0], v1[1]); w.w = cvt_pk_bf16(v1[2], v1[3]);
                    *(u32x4*)(rp + bj * HALF) = w; } }
    }
};
template <int MODE> struct EpiRes {
    const float* xp; const float* xs; const bf16_t* XI; bf16_t* XO; float* ss;
    __device__ __forceinline__ void operator()(const f32x4 (&acc)[2][2][4][2], const Unit& u, int wr, int wc, int fr, int fq) const {
        const int row0 = EPI_ROW0(u), col0 = EPI_COL0(u);
#pragma unroll
        for (int ai = 0; ai < 2; ++ai)
#pragma unroll
            for (int m = 0; m < 4; ++m) { const int row = row0 + ai * HALF + m * 16;
                float q = 0.f;
                if (row < MR) {
#pragma unroll
                    for (int bj = 0; bj < 2; ++bj) { const int c = col0 + bj * HALF;
                        f32x4 b0, b1;
                        if (MODE == 0) { const float* bp = row < MP ? xp + (size_t)row * D : xs + (size_t)(row - MP) * D; b0 = *(const f32x4*)(bp + c); b1 = *(const f32x4*)(bp + c + 4); }
                        else { const u32x4 w = *(const u32x4*)(XI + (size_t)row * D + c); b0 = (f32x4){bflo(w.x), bfhi(w.x), bflo(w.y), bfhi(w.y)}; b1 = (f32x4){bflo(w.z), bfhi(w.z), bflo(w.w), bfhi(w.w)}; }
                        const f32x4 v0 = acc[ai][bj][m][0] + b0, v1 = acc[ai][bj][m][1] + b1;
                        u32x4 w; w.x = cvt_pk_bf16(v0[0], v0[1]); w.y = cvt_pk_bf16(v0[2], v0[3]); w.z = cvt_pk_bf16(v1[0], v1[1]); w.w = cvt_pk_bf16(v1[2], v1[3]);
                        *(u32x4*)(XO + (size_t)row * D + c) = w;
                        q += (v0[0] * v0[0] + v0[1] * v0[1]) + (v0[2] * v0[2] + v0[3] * v0[3]) + (v1[0] * v1[0] + v1[1] * v1[1]) + (v1[2] * v1[2] + v1[3] * v1[3]); }
                }
                q += __shfl_xor(q, 16); q += __shfl_xor(q, 32);
                if (fq == 0 && row < MR) atomicAdd(ss + row, q);
            }
    }
};
struct EpiGU {
    bf16_t* Hp; const float* ss;
    __device__ __forceinline__ void operator()(const f32x4 (&acc)[2][2][4][2], const Unit& u, int wr, int wc, int fr, int fq) const {
        const int row0 = EPI_ROW0(u), col0 = u.pn * HALF + wc * 32 + 8 * fq;
#pragma unroll
        for (int ai = 0; ai < 2; ++ai)
#pragma unroll
            for (int m = 0; m < 4; ++m) { const int row = row0 + ai * HALF + m * 16; const float s = __builtin_amdgcn_rsqf(ss[row] * (1.f / D) + EPS);
                float o[8];
#pragma unroll
                for (int n = 0; n < 2; ++n)
#pragma unroll
                    for (int i = 0; i < 4; ++i) { const float gv = acc[ai][0][m][n][i] * s, uv = acc[ai][1][m][n][i] * s; o[n * 4 + i] = gv * sigmoidf_(gv) * uv; }
                u32x4 w; w.x = cvt_pk_bf16(o[0], o[1]); w.y = cvt_pk_bf16(o[2], o[3]); w.z = cvt_pk_bf16(o[4], o[5]); w.w = cvt_pk_bf16(o[6], o[7]);
                *(u32x4*)(Hp + (size_t)row * DFF + col0) = w; }
    }
};
struct EpiPle {
    const bf16_t* XI; bf16_t* XO; const bf16_t* PEp; const float* ss2; float* ss3;
    __device__ __forceinline__ void operator()(const f32x4 (&acc)[2][2][4][2], const Unit& u, int wr, int wc, int fr, int fq) const {
        const int row0 = EPI_ROW0(u), col0 = EPI_COL0(u);
#pragma unroll
        for (int ai = 0; ai < 2; ++ai)
#pragma unroll
            for (int m = 0; m < 4; ++m) { const int row = row0 + ai * HALF + m * 16;
                float q = 0.f;
                if (row < MR) {
                    const float s = __builtin_amdgcn_rsqf(ss2[row] * (1.f / D) + EPS);
#pragma unroll
                    for (int bj = 0; bj < 2; ++bj) { const int c = col0 + bj * HALF;
                        float xb[8], pe[8];
                        unpack8x(*(const u32x4*)(XI + (size_t)row * D + c), xb); unpack8x(*(const u32x4*)(PEp + (size_t)row * D + c), pe);
                        float v[8];
#pragma unroll
                        for (int i = 0; i < 4; ++i) { v[i] = xb[i] + sigmoidf_(acc[ai][bj][m][0][i] * s) * pe[i]; v[4 + i] = xb[4 + i] + sigmoidf_(acc[ai][bj][m][1][i] * s) * pe[4 + i]; }
                        u32x4 w; w.x = cvt_pk_bf16(v[0], v[1]); w.y = cvt_pk_bf16(v[2], v[3]); w.z = cvt_pk_bf16(v[4], v[5]); w.w = cvt_pk_bf16(v[6], v[7]);
                        *(u32x4*)(XO + (size_t)row * D + c) = w;
#pragma unroll
                        for (int i = 0; i < 8; ++i) q += v[i] * v[i]; }
                }
                q += __shfl_xor(q, 16); q += __shfl_xor(q, 32);
                if (fq == 0 && row < MR) atomicAdd(ss3 + row, q);
            }
    }
};
}

#define MFMA16(a, b, c) __builtin_amdgcn_mfma_f32_16x16x32_bf16((a), (b), (c), 0, 0, 0)
__device__ __forceinline__ float log_sigmoid_(float f) { return fminf(f, 0.f) - log1pf(__expf(-fabsf(f))); }
__device__ __forceinline__ void unpack8(const u32x4 w, float (&o)[8]) { o[0] = bflo(w.x); o[1] = bfhi(w.x); o[2] = bflo(w.y); o[3] = bfhi(w.y); o[4] = bflo(w.z); o[5] = bfhi(w.z); o[6] = bflo(w.w); o[7] = bfhi(w.w); }
__device__ __forceinline__ u32x4 pack8(const float (&o)[8]) { u32x4 w; w.x = pk2(o[0], o[1]); w.y = pk2(o[2], o[3]); w.z = pk2(o[4], o[5]); w.w = pk2(o[6], o[7]); return w; }

__device__ __forceinline__ void transpose_item(const float* W, int ldw, int col0, bf16_t* WT, int drow0, int ldt, const float* gk, float scal, LAS float* scr, int k0, int lane) {
    float wv[32];
#pragma unroll
    for (int i = 0; i < 32; ++i) { const int kk = 2 * i + (lane >> 5); wv[i] = W[(size_t)(k0 + kk) * ldw + col0 + (lane & 31)]; }
    const float g0 = gk ? gk[k0 + (lane >> 5) + 2 * (lane & 31)] : 1.f;
#pragma unroll
    for (int i = 0; i < 32; ++i) { const int kk = 2 * i + (lane >> 5); const float gg = __shfl(g0, (lane & 32) + i) * scal;
        scr[kk * 33 + (lane & 31)] = wv[i] * gg; }
    asm volatile("s_waitcnt lgkmcnt(0)" ::: "memory");
    const int c = lane & 7;
#pragma unroll
    for (int j = 0; j < 4; ++j) { const int n = (lane >> 3) + 8 * j; const LAS float* s = scr + (8 * c) * 33 + n;
        u32x4 o; o.x = pk2(s[0 * 33], s[1 * 33]); o.y = pk2(s[2 * 33], s[3 * 33]); o.z = pk2(s[4 * 33], s[5 * 33]); o.w = pk2(s[6 * 33], s[7 * 33]);
        *(u32x4*)(WT + (size_t)(drow0 + n) * ldt + k0 + 8 * c) = o; }
    asm volatile("s_waitcnt lgkmcnt(0)" ::: "memory");
}

__device__ __forceinline__ void p0_prologue(const Args& a, LAS unsigned char* lds, int G) {
    int tid = threadIdx.x; asm volatile("" : "+v"(tid)); const int lane = tid & 63, wave = tid >> 6;
    unsigned char* ws = a.ws + opq0();
    float* sm = (float*)(ws + WS_SMALL);
    const int gw = blockIdx.x * 8 + wave, NGW = G * 8;
    LAS float* scr = (LAS float*)(lds + wave * 16384);
    constexpr int I0 = 16 * 96, I1 = 16 * 64, I2 = 16 * 32, I3 = 16 * 88, I4 = I3, I5 = 44 * 32, I6 = 16 * 32, I7 = 4 * 32, I8 = 4 * 32, I9 = I8, I10 = I8, I11 = 8 * 8, I12 = I11;
    constexpr int NIT = I0 + I1 + I2 + I3 + I4 + I5 + I6 + I7 + I8 + I9 + I10 + I11 + I12;
    for (int it = gw; it < NIT; it += NGW) {
        int r = it;
        if (r < I0) { const int kb = r / 96, nb = r % 96; transpose_item(INP(11), NIN, nb * 32, (bf16_t*)(ws + WS_W1T), nb * 32, D, INP(10), 1.f, scr, kb * 64, lane); continue; } r -= I0;
        if (r < I1) { const int kb = r / 64, nb = r % 64; transpose_item(INP(11), NIN, 3080 + nb * 32, (bf16_t*)(ws + WS_W1T), 3072 + nb * 32, D, INP(10), 1.f, scr, kb * 64, lane); continue; } r -= I1;
        if (r < I2) { const int kb = r / 32, nb = r % 32; transpose_item(INP(26), D, nb * 32, (bf16_t*)(ws + WS_WOT), nb * 32, D, nullptr, 1.f, scr, kb * 64, lane); continue; } r -= I2;
        if (r < I3) { const int kb = r / 88, nb = r % 88, n0 = nb * 32; transpose_item(INP(28), DFF, n0, (bf16_t*)(ws + WS_WGUT), (n0 / 128) * 256 + (n0 % 128), D, INP(27), 1.f, scr, kb * 64, lane); continue; } r -= I3;
        if (r < I4) { const int kb = r / 88, nb = r % 88, n0 = nb * 32; transpose_item(INP(29), DFF, n0, (bf16_t*)(ws + WS_WGUT), (n0 / 128) * 256 + 128 + (n0 % 128), D, INP(27), 1.f, scr, kb * 64, lane); continue; } r -= I4;
        if (r < I5) { const int kb = r / 32, nb = r % 32; transpose_item(INP(30), D, nb * 32, (bf16_t*)(ws + WS_WDT), nb * 32, DFF, nullptr, 1.f, scr, kb * 64, lane); continue; } r -= I5;
        if (r < I6) { const int kb = r / 32, nb = r % 32; transpose_item(INP(32), D, nb * 32, (bf16_t*)(ws + WS_WPGT), nb * 32, D, INP(31), 1.f, scr, kb * 64, lane); continue; } r -= I6;
        if (r < I7) { const int kb = r / 32, nb = r % 32; transpose_item(INP(33), D, nb * 32, (bf16_t*)(ws + WS_WPT), nb * 32, PD, nullptr, 1.f, scr, kb * 64, lane); continue; } r -= I7;
        if (r < I8) { const int h = r / 32, q = r % 32, kb = q / 8, nb = q % 8; transpose_item(INP(22) + (size_t)h * 65536, HD, nb * 32, (bf16_t*)(ws + WS_WQKT) + (size_t)h * 512 * 256, nb * 32, HD, nullptr, 0.0625f, scr, kb * 64, lane); continue; } r -= I8;
        if (r < I9) { const int h = r / 32, q = r % 32, kb = q / 8, nb = q % 8; transpose_item(INP(23) + (size_t)h * 65536, HD, nb * 32, (bf16_t*)(ws + WS_WQKT) + (size_t)h * 512 * 256, 256 + nb * 32, HD, nullptr, 1.f, scr, kb * 64, lane); continue; } r -= I9;
        if (r < I10) { const int h = r / 32, q = r % 32, kb = q / 8, nb = q % 8; transpose_item(INP(24) + (size_t)h * 65536, HD, nb * 32, (bf16_t*)(ws + WS_WVT) + (size_t)h * 65536, nb * 32, HD, nullptr, 1.f, scr, kb * 64, lane); continue; } r -= I10;
        if (r < I11) { const int bl = r / 8, q = r % 8, kb = q / 4, nb = q % 4; transpose_item(INP(15) + (size_t)bl * 16384, 128, nb * 32, (bf16_t*)(ws + WS_WLRUT) + (size_t)bl * 256 * 128, nb * 32, 128, nullptr, 1.f, scr, kb * 64, lane); continue; } r -= I11;
        { const int bl = r / 8, q = r % 8, kb = q / 4, nb = q % 4; transpose_item(INP(17) + (size_t)bl * 16384, 128, nb * 32, (bf16_t*)(ws + WS_WLRUT) + (size_t)bl * 256 * 128, 128 + nb * 32, 128, nullptr, 1.f, scr, kb * 64, lane); }
    }
    __syncthreads();
    LAS float* gwL = (LAS float*)lds;
    for (int i = tid; i < 8192; i += NT) { const int j = i >> 10, k = i & 1023; gwL[i] = INP(10)[k] * INP(11)[(size_t)k * NIN + 3072 + j]; }
    __syncthreads();
    bf16_t* XB = (bf16_t*)(ws + WS_XB);
    {
        f32x4 v[4], vn[4];
        if (gw < MR) { const f32x4* xr = (const f32x4*)xrow_ptr(a, gw) + lane;
#pragma unroll
            for (int j = 0; j < 4; ++j) v[j] = xr[64 * j]; }
        for (int row = gw; row < M; row += NGW) {
            unsigned long long* o8 = (unsigned long long*)(XB + (size_t)row * D) + lane;
            const int rn = row + NGW;
            if (rn < MR) { const f32x4* xr = (const f32x4*)xrow_ptr(a, rn) + lane;
#pragma unroll
                for (int j = 0; j < 4; ++j) vn[j] = xr[64 * j]; }
            if (row >= MR) {
#pragma unroll
                for (int j = 0; j < 4; ++j) o8[64 * j] = 0ull;
                if (lane == 0) sm[SM_RSTD0 + row] = 0.f;
            } else {
                float s = 0.f;
#pragma unroll
                for (int j = 0; j < 4; ++j) s += (v[j].x * v[j].x + v[j].y * v[j].y) + (v[j].z * v[j].z + v[j].w * v[j].w);
                float dt[8];
#pragma unroll
                for (int jj = 0; jj < 8; ++jj) { float d = 0.f;
#pragma unroll
                    for (int j = 0; j < 4; ++j) { const f32x4 w = *(const LAS f32x4*)(gwL + jj * 1024 + j * 256 + lane * 4); d += (v[j].x * w.x + v[j].y * w.y) + (v[j].z * w.z + v[j].w * w.w); }
                    dt[jj] = wave_sum(d); }
                s = wave_sum(s);
                const float rstd = 1.0f / sqrtf(s * (1.f / D) + EPS);
#pragma unroll
                for (int j = 0; j < 4; ++j) o8[64 * j] = (unsigned long long)pk2(v[j].x, v[j].y) | ((unsigned long long)pk2(v[j].z, v[j].w) << 32);
                if (lane == 0) { sm[SM_RSTD0 + row] = rstd;
#pragma unroll
                    for (int jj = 0; jj < 4; ++jj) { sm[SM_GI + row * 4 + jj] = dt[jj] * rstd + INP(12)[jj]; sm[SM_GF + row * 4 + jj] = dt[4 + jj] * rstd + INP(12)[4 + jj]; } }
            }
#pragma unroll
            for (int j = 0; j < 4; ++j) v[j] = vn[j];
        }
    }
    const int gt = blockIdx.x * NT + tid, NGT = G * NT;
    bf16_t* PB = (bf16_t*)(ws + WS_PB);
    for (int i0 = gt; i0 < M * (PD / 4); i0 += 4 * NGT) { asm volatile("" : "+v"(i0));
        f32x4 pv[4];
#pragma unroll
        for (int q = 0; q < 4; ++q) { const int i = i0 + q * NGT, row = i >> 6, c4 = (i & 63) * 4; pv[q] = (f32x4){0.f, 0.f, 0.f, 0.f};
            if (row < MP) pv[q] = *(const f32x4*)(INP(8) + (size_t)row * PD + c4); else if (row < MR) pv[q] = *(const f32x4*)(INP(9) + (size_t)(row - MP) * PD + c4); }
#pragma unroll
        for (int q = 0; q < 4; ++q) { const int i = i0 + q * NGT, row = i >> 6, c4 = (i & 63) * 4;
            if (row < M) *(unsigned long long*)(PB + (size_t)row * PD + c4) = (unsigned long long)pk2(pv[q].x, pv[q].y) | ((unsigned long long)pk2(pv[q].z, pv[q].w) << 32); } }
    for (int i = gt; i < 3 * M; i += NGT) { sm[SM_SS1 + i] = 0.f; asm volatile("" : "+v"(i)); }
}

__device__ __forceinline__ void p2a_item(const Args& a, LAS unsigned char* lds, int idx) {
    int tid = threadIdx.x; asm volatile("" : "+v"(tid)); const int lane = tid & 63, wave = tid >> 6;
    unsigned char* ws = a.ws + opq0(); float* sm = (float*)(ws + WS_SMALL);
    const bf16_t* Z = (const bf16_t*)(ws + WS_Z); bf16_t* XC = (bf16_t*)(ws + WS_XC);
    if (idx >= 2048) {
        const int sb = idx - 2048, row = MP + sb;
#pragma unroll
        for (int cc = 0; cc < 2; ++cc) { const int ch = tid * 2 + cc;
            { const float s0 = INP(2)[((size_t)sb * 3 + 0) * D + ch], s1 = INP(2)[((size_t)sb * 3 + 1) * D + ch], s2 = INP(2)[((size_t)sb * 3 + 2) * D + ch], xv = bf2f(Z[(size_t)row * NZ + ch]);
              const float o = INP(14)[ch] + INP(13)[ch] * s0 + INP(13)[D + ch] * s1 + INP(13)[2 * D + ch] * s2 + INP(13)[3 * D + ch] * xv;
              sm[SM_XLS + sb * D + ch] = o;
              a.out[O_SLC + ((size_t)sb * 3 + 0) * D + ch] = s1; a.out[O_SLC + ((size_t)sb * 3 + 1) * D + ch] = s2; a.out[O_SLC + ((size_t)sb * 3 + 2) * D + ch] = xv; }
            { const float s0 = INP(4)[((size_t)sb * 3 + 0) * D + ch], s1 = INP(4)[((size_t)sb * 3 + 1) * D + ch], s2 = INP(4)[((size_t)sb * 3 + 2) * D + ch], xv = bf2f(Z[(size_t)row * NZ + 1024 + ch]);
              const float o = INP(21)[ch] + INP(20)[ch] * s0 + INP(20)[D + ch] * s1 + INP(20)[2 * D + ch] * s2 + INP(20)[3 * D + ch] * xv;
              XC[(size_t)row * D + ch] = (bf16_t)f2bf(o * sigmoidf_(o));
              a.out[O_SMC + ((size_t)sb * 3 + 0) * D + ch] = s1; a.out[O_SMC + ((size_t)sb * 3 + 1) * D + ch] = s2; a.out[O_SMC + ((size_t)sb * 3 + 2) * D + ch] = xv; }
        }
        return;
    }
    const int cb = idx & 7, tt = (idx >> 3) & 31, b = idx >> 8;
    LAS bf16_t* AL = (LAS bf16_t*)lds;
    LAS float* U = (LAS float*)(lds + 17408);
    LAS float* AA = (LAS float*)(lds + 17408 + 32768);
    const int t0 = tt * 64, tokb = b * T;
    {
        const int c8 = tid & 15, rs = tid >> 4, chl = cb * 128 + c8 * 8;
        float wl[4][8], wm[4][8], bl[8], bm[8];
#pragma unroll
        for (int j = 0; j < 4; ++j)
#pragma unroll
            for (int i = 0; i < 8; ++i) { wl[j][i] = INP(13)[j * D + chl + i]; wm[j][i] = INP(20)[j * D + chl + i]; }
#pragma unroll
        for (int i = 0; i < 8; ++i) { bl[i] = INP(14)[chl + i]; bm[i] = INP(21)[chl + i]; }
#pragma unroll
        for (int rr = 0; rr < 2; ++rr) { const int tl = rs + 32 * rr, tg = t0 + tl;
            float ol[8], om[8], xl3[8], xm3[8];
#pragma unroll
            for (int i = 0; i < 8; ++i) { ol[i] = bl[i]; om[i] = bm[i]; xl3[i] = 0.f; xm3[i] = 0.f; }
#pragma unroll
            for (int j = 0; j < 4; ++j) { const int ts = tg - 3 + j;
                if (ts >= 0) { float xl[8], xm[8];
                    unpack8(*(const u32x4*)(Z + (size_t)(tokb + ts) * NZ + chl), xl); unpack8(*(const u32x4*)(Z + (size_t)(tokb + ts) * NZ + 1024 + chl), xm);
#pragma unroll
                    for (int i = 0; i < 8; ++i) { ol[i] += wl[j][i] * xl[i]; om[i] += wm[j][i] * xm[i]; if (j == 3) { xl3[i] = xl[i]; xm3[i] = xm[i]; } } } }
            *(LAS u32x4*)(AL + tl * 136 + c8 * 8) = pack8(ol);
            *(LAS f32x4*)(U + tl * 128 + c8 * 8) = (f32x4){ol[0], ol[1], ol[2], ol[3]}; *(LAS f32x4*)(U + tl * 128 + c8 * 8 + 4) = (f32x4){ol[4], ol[5], ol[6], ol[7]};
            float xs[8];
#pragma unroll
            for (int i = 0; i < 8; ++i) xs[i] = om[i] * sigmoidf_(om[i]);
            *(u32x4*)(XC + (size_t)(tokb + tg) * D + chl) = pack8(xs);
            if (tg >= T - 3) { const int j3 = tg - (T - 3);
#pragma unroll
                for (int i = 0; i < 8; ++i) { a.out[O_PLC + ((size_t)b * 3 + j3) * D + chl + i] = xl3[i]; a.out[O_PMC + ((size_t)b * 3 + j3) * D + chl + i] = xm3[i]; } }
        }
    }
    __syncthreads();
    {
        const int fr = lane & 15, fq = lane >> 4;
        const bf16_t* Wl = (const bf16_t*)(ws + WS_WLRUT) + (size_t)cb * 256 * 128;
        f32x4 ar[4], ai[4];
#pragma unroll
        for (int m = 0; m < 4; ++m) { ar[m] = (f32x4){0.f, 0.f, 0.f, 0.f}; ai[m] = (f32x4){0.f, 0.f, 0.f, 0.f}; }
#pragma unroll
        for (int ks = 0; ks < 4; ++ks) {
            const bf16x8 br = *(const bf16x8*)(Wl + (size_t)(16 * wave + fr) * 128 + ks * 32 + fq * 8);
            const bf16x8 bi = *(const bf16x8*)(Wl + (size_t)(128 + 16 * wave + fr) * 128 + ks * 32 + fq * 8);
#pragma unroll
            for (int m = 0; m < 4; ++m) { const bf16x8 af = *(const LAS bf16x8*)(AL + (m * 16 + fr) * 136 + ks * 32 + fq * 8);
                ar[m] = MFMA16(af, br, ar[m]); ai[m] = MFMA16(af, bi, ai[m]); }
        }
        const int c = 16 * wave + fr, ch = cb * 128 + c;
        const float ba = INP(16)[ch], bx = INP(18)[ch], lam = INP(19)[ch];
        const float sp = fmaxf(-lam, 0.f) + log1pf(__expf(-fabsf(lam)));
#pragma unroll
        for (int m = 0; m < 4; ++m)
#pragma unroll
            for (int j = 0; j < 4; ++j) { const int t = m * 16 + fq * 4 + j;
                const float r = sigmoidf_(ar[m][j] + ba), ig = sigmoidf_(ai[m][j] + bx);
                const float la = -8.0f * r * sp, av = fexp_(la);
                const float uv = __builtin_amdgcn_sqrtf(fmaxf(1.f - av * av, 0.f)) * ig * U[t * 128 + c];
                AA[t * 128 + c] = av; U[t * 128 + c] = uv; }
    }
    __syncthreads();
    {
        const int c = tid & 127, seg = tid >> 7;
        float h = 0.f, P = 1.f;
#pragma unroll
        for (int i = 0; i < 16; ++i) { const int t = seg * 16 + i; const float av = AA[t * 128 + c], uv = U[t * 128 + c]; h = av * h + uv; P *= av; U[t * 128 + c] = h; AA[t * 128 + c] = P; }
        __syncthreads();
        float hc = 0.f, pc = 1.f;
        for (int s = 0; s < seg; ++s) { const int te = s * 16 + 15; const float pe = AA[te * 128 + c]; hc = pe * hc + U[te * 128 + c]; pc *= pe; }
        __syncthreads();
        if (seg > 0) {
#pragma unroll
            for (int i = 0; i < 16; ++i) { const int t = seg * 16 + i; const float pv = AA[t * 128 + c]; U[t * 128 + c] += pv * hc; AA[t * 128 + c] = pv * pc; }
        }
    }
    __syncthreads();
    {
        const int c8 = tid & 15, rs = tid >> 4, chl = cb * 128 + c8 * 8;
        bf16_t* HL = (bf16_t*)(ws + WS_HLOC); bf16_t* CA = (bf16_t*)(ws + WS_CUMA);
#pragma unroll
        for (int rr = 0; rr < 2; ++rr) { const int tl = rs + 32 * rr; float hv[8], cv[8];
#pragma unroll
            for (int i = 0; i < 8; ++i) { hv[i] = U[tl * 128 + c8 * 8 + i]; cv[i] = AA[tl * 128 + c8 * 8 + i]; }
            *(u32x4*)(HL + (size_t)(tokb + t0 + tl) * D + chl) = pack8(hv); *(u32x4*)(CA + (size_t)(tokb + t0 + tl) * D + chl) = pack8(cv); }
        if (tid < 128) { sm[SM_LRA + (b * 32 + tt) * D + cb * 128 + tid] = AA[63 * 128 + tid]; sm[SM_LRH + (b * 32 + tt) * D + cb * 128 + tid] = U[63 * 128 + tid]; }
    }
    __syncthreads();
}

__device__ __forceinline__ float block_excl_sum(float v, LAS float* red, int tid) {
    const int lane = tid & 63, wave = tid >> 6; float inc = v;
#pragma unroll
    for (int o = 1; o < 64; o <<= 1) { const float t = __shfl_up(inc, o); if (lane >= o) inc += t; }
    __syncthreads();
    if (lane == 63) red[wave] = inc;
    __syncthreads();
    float base = 0.f;
    for (int w = 0; w < wave; ++w) base += red[w];
    return base + inc - v;
}
__device__ __forceinline__ float block_excl_max(float v, LAS float* red, int tid) {
    const int lane = tid & 63, wave = tid >> 6; float inc = v;
#pragma unroll
    for (int o = 1; o < 64; o <<= 1) { const float t = __shfl_up(inc, o); if (lane >= o) inc = fmaxf(inc, t); }
    __syncthreads();
    if (lane == 63) red[wave] = inc;
    __syncthreads();
    float base = -INFINITY;
    for (int w = 0; w < wave; ++w) base = fmaxf(base, red[w]);
    const float prev = __shfl_up(inc, 1);
    return fmaxf(base, lane > 0 ? prev : -INFINITY);
}
__device__ __forceinline__ void gate_scan(const Args& a, LAS unsigned char* lds, int bh) {
    int tid = threadIdx.x; asm volatile("" : "+v"(tid)); float* sm = (float*)(a.ws + WS_SMALL);
    LAS float* BCl = (LAS float*)lds; LAS float* MMl = BCl + T; LAS float* red = MMl + T;
    const int b = bh >> 2, h = bh & 3;
    float lf[4], ig[4], bc[4], gv[4], pmx[4];
#pragma unroll
    for (int i = 0; i < 4; ++i) { const int row = b * T + tid * 4 + i; lf[i] = log_sigmoid_(sm[SM_GF + row * 4 + h]); ig[i] = sm[SM_GI + row * 4 + h]; }
    const float tot = (lf[0] + lf[1]) + (lf[2] + lf[3]);
    const float ex = block_excl_sum(tot, red, tid);
    float run = ex;
#pragma unroll
    for (int i = 0; i < 4; ++i) { run += lf[i]; bc[i] = run; gv[i] = ig[i] - run; }
    const float lm = fmaxf(fmaxf(gv[0], gv[1]), fmaxf(gv[2], gv[3]));
    const float exm = block_excl_max(lm, red, tid);
    float rm = exm;
#pragma unroll
    for (int i = 0; i < 4; ++i) { rm = fmaxf(rm, gv[i]); pmx[i] = rm; BCl[tid * 4 + i] = bc[i]; MMl[tid * 4 + i] = bc[i] + rm; }
    __syncthreads();
#pragma unroll
    for (int i = 0; i < 4; ++i) { const int t = tid * 4 + i, c = t >> 6;
        const float Bprev = c ? BCl[64 * c - 1] : 0.f, mprev = c ? MMl[64 * c - 1] : M_INIT, Blast = BCl[64 * c + 63], mlast = MMl[64 * c + 63];
        const float mm = bc[i] + pmx[i];
        sm[SM_BM + bh * T + t] = -pmx[i]; sm[SM_GIB + bh * T + t] = gv[i]; sm[SM_MM + bh * T + t] = mm;
        sm[SM_SC + bh * T + t] = __expf(bc[i] - Bprev + mprev - mm);
        sm[SM_WK + bh * T + t] = __expf(Blast - bc[i] + ig[i] - mlast);
        if ((t & 63) == 0) sm[SM_DEC + bh * 32 + c] = __expf(Blast - Bprev + mprev - mlast);
        if (t == T - 1) a.out[O_PM + bh] = mm; }
    __syncthreads();
}

#define LBAR() do { asm volatile("s_waitcnt lgkmcnt(0)" ::: "memory"); __builtin_amdgcn_s_barrier(); asm volatile("" ::: "memory"); } while (0)
struct P3Ops { u32x4 vraw[2][2]; bf16x8 kf[2][2]; f32x4 wk[2][2]; float sc, dec; };
__device__ __forceinline__ void p3_load(P3Ops& o, const bf16_t* Q, const bf16_t* KT, const bf16_t* VT, const float* sm, int b, int h, int bh, int es, int c, int wave, int fr, int fq) {
    const int tok0 = b * T + c * 64, gb = bh * T + c * 64, mt = wave >> 1;
#pragma unroll
    for (int ks = 0; ks < 2; ++ks) {
        o.wk[ks][0] = *(const f32x4*)(sm + SM_WK + gb + ks * 32 + fq * 8); o.wk[ks][1] = *(const f32x4*)(sm + SM_WK + gb + ks * 32 + fq * 8 + 4);
#pragma unroll
        for (int e = 0; e < 2; ++e) o.vraw[ks][e] = *(const u32x4*)(VT + (size_t)(h * 256 + es * 32 + e * 16 + fr) * M + tok0 + ks * 32 + fq * 8);
#pragma unroll
        for (int d = 0; d < 2; ++d) o.kf[ks][d] = *(const bf16x8*)(KT + (size_t)(h * 256 + 32 * wave + d * 16 + fr) * M + tok0 + ks * 32 + fq * 8);
    }
    o.sc = sm[SM_SC + gb + mt * 16 + fr]; o.dec = sm[SM_DEC + bh * 32 + c];
}
__device__ __forceinline__ void p3_item(const Args& a, LAS unsigned char* lds, int idx) {
    int tid = threadIdx.x; asm volatile("" : "+v"(tid)); const int lane = tid & 63, wave = tid >> 6, fr = lane & 15, fq = lane >> 4;
    unsigned char* ws = a.ws + opq0(); float* sm = (float*)(ws + WS_SMALL);
    const int es = idx & 7, bh = idx >> 3, b = bh >> 2, h = bh & 3;
    const bf16_t* Q = (const bf16_t*)(ws + WS_Q); const bf16_t* KT = (const bf16_t*)(ws + WS_KT); const bf16_t* VT = (const bf16_t*)(ws + WS_VT);
    bf16_t* NUMI = (bf16_t*)(ws + WS_XC);
    const int ii = tid >> 8, q_ = tid & 255, sit = idx * 2 + ii, ssb = sit >> 2, shh = sit & 3, srow = MP + ssb, ssh = ssb * 4 + shh;
    LAS float* SQ = (LAS float*)(lds + 34816) + ii * 256; LAS float* SK = (LAS float*)(lds + 36864) + ii * 256; LAS float* SV = (LAS float*)(lds + 38912) + ii * 256;
    LAS float* SRED = (LAS float*)(lds + 40960) + ii * 1024; LAS float* SR2 = (LAS float*)(lds + 49152) + ii * 16;
    SQ[q_] = bf2f(Q[(size_t)srow * D + shh * 256 + q_]); SK[q_] = bf2f(((const bf16_t*)(ws + WS_K))[(size_t)srow * D + shh * 256 + q_]); SV[q_] = bf2f(VT[(size_t)(shh * 256 + q_) * M + srow]);
    const float s_lf = log_sigmoid_(sm[SM_GF + srow * 4 + shh]), s_ip = sm[SM_GI + srow * 4 + shh], s_m0 = INP(7)[ssh];
    const float s_mn = fmaxf(s_lf + s_m0, s_ip), s_dec = fexp_(s_lf + s_m0 - s_mn), s_wkk = fexp_(s_ip - s_mn);
    const int s_r = q_ >> 6, s_e4 = (q_ & 63) * 4;
    const float* sC0 = INP(5) + (size_t)ssh * 65536 + s_e4; float* sC1 = a.out + O_SC + (size_t)ssh * 65536 + s_e4;
    f32x4 sacc = (f32x4){0.f, 0.f, 0.f, 0.f};
    f32x4 acc[2][2], accn[2];
#pragma unroll
    for (int e = 0; e < 2; ++e)
#pragma unroll
        for (int d = 0; d < 2; ++d) acc[e][d] = (f32x4){0.f, 0.f, 0.f, 0.f};
    accn[0] = (f32x4){0.f, 0.f, 0.f, 0.f}; accn[1] = (f32x4){0.f, 0.f, 0.f, 0.f};
    P3Ops cur, nxt;
    p3_load(cur, Q, KT, VT, sm, b, h, bh, es, 0, wave, fr, fq);
    bf16x8 qf[8];
#pragma unroll
    for (int ks = 0; ks < 8; ++ks) qf[ks] = *(const bf16x8*)(Q + (size_t)(b * T + 64 + (wave >> 1) * 16 + fr) * D + h * 256 + ks * 32 + fq * 8);
    __syncthreads();
    const f32x4 s_v4 = *(const LAS f32x4*)(SV + s_e4);
    for (int c = 0; c < NCH; ++c) {
        const int tok0 = b * T + c * 64;
        LAS bf16_t* CTr = (LAS bf16_t*)(lds + (c & 1) * 16896);
        LAS bf16_t* CTw = (LAS bf16_t*)(lds + ((c + 1) & 1) * 16896);
        p3_load(nxt, Q, KT, VT, sm, b, h, bh, es, c + 1 < NCH ? c + 1 : c, wave, fr, fq);
        const int sd0 = c * 8 + s_r, sd1 = sd0 + 4;
        const f32x4 sc0 = *(const f32x4*)(sC0 + (size_t)sd0 * 256), sc1 = *(const f32x4*)(sC0 + (size_t)sd1 * 256);
        if (c > 0) {
            const int mt = wave >> 1, et = wave & 1;
            f32x4 ai = (f32x4){0.f, 0.f, 0.f, 0.f};
#pragma unroll
            for (int ks = 0; ks < 8; ++ks) { const bf16x8 cf = *(const LAS bf16x8*)(CTr + (et * 16 + fr) * 264 + ks * 32 + fq * 8); ai = MFMA16(cf, qf[ks], ai); }
            u32x2 w; w.x = pk2(ai[0] * cur.sc, ai[1] * cur.sc); w.y = pk2(ai[2] * cur.sc, ai[3] * cur.sc);
            *(u32x2*)(NUMI + (size_t)(tok0 + mt * 16 + fr) * D + h * 256 + es * 32 + et * 16 + fq * 4) = w;
            const int cq = c + 1 < NCH ? c + 1 : c;
#pragma unroll
            for (int ks = 0; ks < 8; ++ks) qf[ks] = *(const bf16x8*)(Q + (size_t)(b * T + cq * 64 + mt * 16 + fr) * D + h * 256 + ks * 32 + fq * 8);
        }
        if (es == 0 && fq == 0) { sm[SM_NST + (bh * 32 + c) * 256 + 32 * wave + fr] = accn[0][0]; sm[SM_NST + (bh * 32 + c) * 256 + 32 * wave + 16 + fr] = accn[1][0]; }
        const float dec = cur.dec;
#pragma unroll
        for (int e = 0; e < 2; ++e)
#pragma unroll
            for (int d = 0; d < 2; ++d) acc[e][d] = acc[e][d] * dec;
        accn[0] = accn[0] * dec; accn[1] = accn[1] * dec;
#pragma unroll
        for (int ks = 0; ks < 2; ++ks) {
            const f32x4 w0 = cur.wk[ks][0], w1 = cur.wk[ks][1];
            bf16x8 vf[2];
#pragma unroll
            for (int e = 0; e < 2; ++e) { float vv[8]; unpack8(cur.vraw[ks][e], vv);
                vv[0] *= w0[0]; vv[1] *= w0[1]; vv[2] *= w0[2]; vv[3] *= w0[3]; vv[4] *= w1[0]; vv[5] *= w1[1]; vv[6] *= w1[2]; vv[7] *= w1[3];
                const u32x4 pw = pack8(vv); vf[e] = __builtin_bit_cast(bf16x8, pw); }
#pragma unroll
            for (int e = 0; e < 2; ++e)
#pragma unroll
                for (int d = 0; d < 2; ++d) acc[e][d] = MFMA16(vf[e], cur.kf[ks][d], acc[e][d]);
            if (es == 0) {
                float ww[8] = {w0[0], w0[1], w0[2], w0[3], w1[0], w1[1], w1[2], w1[3]};
                u32x4 pw = pack8(ww); if (fr != 0) pw = (u32x4){0u, 0u, 0u, 0u};
                const bf16x8 nf = __builtin_bit_cast(bf16x8, pw);
                accn[0] = MFMA16(nf, cur.kf[ks][0], accn[0]); accn[1] = MFMA16(nf, cur.kf[ks][1], accn[1]);
            }
        }
#pragma unroll
        for (int e = 0; e < 2; ++e)
#pragma unroll
            for (int d = 0; d < 2; ++d)
#pragma unroll
                for (int j = 0; j < 4; ++j) CTw[(e * 16 + fq * 4 + j) * 264 + 32 * wave + d * 16 + fr] = (bf16_t)f2bf(acc[e][d][j]);
        {
            const float k0 = SK[sd0] * s_wkk, k1 = SK[sd1] * s_wkk, q0 = SQ[sd0], q1 = SQ[sd1];
            const f32x4 cn0 = sc0 * s_dec + s_v4 * k0, cn1 = sc1 * s_dec + s_v4 * k1;
            *(f32x4*)(sC1 + (size_t)sd0 * 256) = cn0; *(f32x4*)(sC1 + (size_t)sd1 * 256) = cn1;
            sacc += cn0 * q0 + cn1 * q1;
        }
        LBAR();
        cur = nxt;
    }
#pragma unroll
    for (int e = 0; e < 2; ++e)
#pragma unroll
        for (int d = 0; d < 2; ++d) *(f32x4*)(a.out + O_PC + ((size_t)bh * 256 + 32 * wave + d * 16 + fr) * 256 + es * 32 + e * 16 + fq * 4) = acc[e][d];
    if (es == 0 && fq == 0) { a.out[O_PN + bh * 256 + 32 * wave + fr] = accn[0][0]; a.out[O_PN + bh * 256 + 32 * wave + 16 + fr] = accn[1][0]; }
    *(LAS f32x4*)(SRED + s_r * 256 + s_e4) = sacc;
    const float nn = s_dec * INP(6)[ssh * 256 + q_] + s_wkk * SK[q_];
    a.out[O_SN + ssh * 256 + q_] = nn;
    const float dn = wave_sum(SQ[q_] * nn);
    if (lane == 0) SR2[wave & 3] = dn;
    __syncthreads();
    const float den = (SR2[0] + SR2[1]) + (SR2[2] + SR2[3]);
    const float num = (SRED[q_] + SRED[256 + q_]) + (SRED[512 + q_] + SRED[768 + q_]);
    const float hv = num / fmaxf(fabsf(den), fexp_(-s_mn));
    const float hq = wave_sum(hv * hv);
    if (lane == 0) SR2[4 + (wave & 3)] = hq;
    __syncthreads();
    {
        const float rs = 1.0f / sqrtf(((SR2[4] + SR2[5]) + (SR2[6] + SR2[7])) * (1.f / 256.f) + EPS);
        const bf16_t* Z = (const bf16_t*)(ws + WS_Z);
        const int ch = shh * 256 + q_, blk = ch >> 7, dd = ch & 127;
        const float ym = hv * rs * INP(25)[ch] * sigmoidf_(bf2f(Z[(size_t)srow * NZ + 2048 + ch]));
        const float* xl = sm + SM_XLS + ssb * D + blk * 128; const float* wa = INP(15) + (size_t)blk * 16384 + dd; const float* wx = INP(17) + (size_t)blk * 16384 + dd;
        float rp = INP(16)[ch], ip = INP(18)[ch];
#pragma unroll 16
        for (int c = 0; c < 128; ++c) { const float xv = xl[c]; rp += xv * wa[c * 128]; ip += xv * wx[c * 128]; }
        const float lam = INP(19)[ch], sp = fmaxf(-lam, 0.f) + log1pf(__expf(-fabsf(lam)));
        const float r = sigmoidf_(rp), ig = sigmoidf_(ip), la = -8.0f * r * sp, av = fexp_(la);
        const float uv = __builtin_amdgcn_sqrtf(fmaxf(1.f - av * av, 0.f)) * ig * sm[SM_XLS + ssb * D + ch];
        const float hn = av * INP(3)[ssb * D + ch] + uv;
        a.out[O_SLH + ssb * D + ch] = hn;
        const float mg = sigmoidf_(bf2f(Z[(size_t)srow * NZ + 3072 + ch])) * hn + sigmoidf_(bf2f(Z[(size_t)srow * NZ + 4096 + ch])) * ym;
        ((bf16_t*)(ws + WS_XB))[(size_t)srow * D + ch] = (bf16_t)f2bf(mg);
        if (q_ == 0) a.out[O_SM + ssh] = s_mn;
    }
    __syncthreads();
}
__device__ __forceinline__ void carry_scan(const Args& a, int G) {
    int tid = threadIdx.x; asm volatile("" : "+v"(tid));
    float* sm = (float*)(a.ws + opq0() + WS_SMALL);
    const int per = (NB * D + G - 1) / G;
    if (tid < per) { const int i = blockIdx.x * per + tid;
        if (i < NB * D) { const int b = i >> 10, ch = i & 1023; float la[NCH], lh[NCH];
#pragma unroll
            for (int j = 0; j < NCH; ++j) { la[j] = sm[SM_LRA + (b * 32 + j) * D + ch]; lh[j] = sm[SM_LRH + (b * 32 + j) * D + ch]; }
            float cr = 0.f;
#pragma unroll
            for (int j = 0; j < NCH; ++j) { sm[SM_CARRY + (b * 32 + j) * D + ch] = cr; cr = la[j] * cr + lh[j]; }
            a.out[O_PLH + b * D + ch] = cr; } }
}

__device__ __forceinline__ void sample_item(const Args& a, LAS unsigned char* lds, int idx) {
    int tid = threadIdx.x; asm volatile("" : "+v"(tid)); const int lane = tid & 63, wave = tid >> 6;
    unsigned char* ws = a.ws + opq0(); float* sm = (float*)(ws + WS_SMALL);
    const int sb = idx >> 2, h = idx & 3, row = MP + sb, sh = sb * 4 + h;
    const bf16_t* Q = (const bf16_t*)(ws + WS_Q); const bf16_t* Kb = (const bf16_t*)(ws + WS_K); const bf16_t* VT = (const bf16_t*)(ws + WS_VT); const bf16_t* Z = (const bf16_t*)(ws + WS_Z);
    LAS float* qs = (LAS float*)lds; LAS float* ks = qs + 256; LAS float* vs = ks + 256; LAS float* red = vs + 256  ; LAS float* r2 = red + 2048  ;
    if (tid < 256) { qs[tid] = bf2f(Q[(size_t)row * D + h * 256 + tid]); ks[tid] = bf2f(Kb[(size_t)row * D + h * 256 + tid]); vs[tid] = bf2f(VT[(size_t)(h * 256 + tid) * M + row]); }
    const float fpre = sm[SM_GF + row * 4 + h], ipre = sm[SM_GI + row * 4 + h], lf = log_sigmoid_(fpre), m0 = INP(7)[sh];
    const float mn = fmaxf(lf + m0, ipre), dec = __expf(lf + m0 - mn), wkk = __expf(ipre - mn);
    __syncthreads();
    {
        const int e4 = (tid & 63) * 4, dr = tid >> 6;
        const f32x4 v4 = *(const LAS f32x4*)(vs + e4);
        f32x4 ac = (f32x4){0.f, 0.f, 0.f, 0.f};
        const float* C0 = INP(5) + (size_t)sh * 65536; float* C1 = a.out + O_SC + (size_t)sh * 65536;
#pragma unroll 4
        for (int d = dr; d < 256; d += 8) { const f32x4 c0 = *(const f32x4*)(C0 + (size_t)d * 256 + e4); const float kd = ks[d] * wkk;
            const f32x4 cn = c0 * dec + v4 * kd; *(f32x4*)(C1 + (size_t)d * 256 + e4) = cn; ac += cn * qs[d]; }
        *(LAS f32x4*)(red + dr * 256 + e4) = ac;
    }
    float dn = 0.f;
    if (tid < 256) { const float nn = dec * INP(6)[sh * 256 + tid] + wkk * ks[tid]; a.out[O_SN + sh * 256 + tid] = nn; dn = qs[tid] * nn; }
    dn = wave_sum(dn);
    if (lane == 0) r2[wave] = dn;
    __syncthreads();
    const float den = (r2[0] + r2[1]) + (r2[2] + r2[3]);
    float hv = 0.f;
    if (tid < 256) { float num = 0.f;
#pragma unroll
        for (int r = 0; r < 8; ++r) num += red[r * 256 + tid];
        hv = num / fmaxf(fabsf(den), __expf(-mn)); }
    const float hq = wave_sum(hv * hv);
    if (lane == 0) r2[8 + wave] = hq;
    __syncthreads();
    if (tid < 256) {
        const float rs = 1.0f / sqrtf(((r2[8] + r2[9]) + (r2[10] + r2[11])) * (1.f / 256.f) + EPS);
        const int ch = h * 256 + tid, blk = ch >> 7, dd = ch & 127;
        const float ym = hv * rs * INP(25)[ch] * sigmoidf_(bf2f(Z[(size_t)row * NZ + 2048 + ch]));
        const float* xl = sm + SM_XLS + sb * D + blk * 128; const float* wa = INP(15) + (size_t)blk * 16384 + dd; const float* wx = INP(17) + (size_t)blk * 16384 + dd;
        float rp = INP(16)[ch], ip = INP(18)[ch];
#pragma unroll 8
        for (int c = 0; c < 128; ++c) { const float xv = xl[c]; rp += xv * wa[c * 128]; ip += xv * wx[c * 128]; }
        const float lam = INP(19)[ch], sp = fmaxf(-lam, 0.f) + log1pf(__expf(-fabsf(lam)));
        const float r = sigmoidf_(rp), ig = sigmoidf_(ip), la = -8.0f * r * sp, av = __expf(la);
        const float uv = sqrtf(-expm1f(2.f * la)) * ig * sm[SM_XLS + sb * D + ch];
        const float hn = av * INP(3)[sb * D + ch] + uv;
        a.out[O_SLH + sb * D + ch] = hn;
        const float mg = sigmoidf_(bf2f(Z[(size_t)row * NZ + 3072 + ch])) * hn + sigmoidf_(bf2f(Z[(size_t)row * NZ + 4096 + ch])) * ym;
        ((bf16_t*)(ws + WS_XB))[(size_t)row * D + ch] = (bf16_t)f2bf(mg);
        if (tid == 0) a.out[O_SM + sh] = mn;
    }
    __syncthreads();
}

__device__ __forceinline__ void p4w_item(const Args& a, LAS unsigned char* lds, int it) {
    int tid = threadIdx.x; asm volatile("" : "+v"(tid)); const int lane = tid & 63, wave = tid >> 6, fr = lane & 15, fq = lane >> 4;
    unsigned char* ws = a.ws + opq0(); float* sm = (float*)(ws + WS_SMALL);
    it = __builtin_amdgcn_readfirstlane(it);
    const int tt = it & 3, bch = it >> 2, h = bch & 3, c = (bch >> 2) & 31, b = bch >> 7, bh = b * 4 + h, tok0 = b * T + c * 64, gb = bh * T + c * 64;
    const bf16_t* Q = (const bf16_t*)(ws + WS_Q); const bf16_t* Kb = (const bf16_t*)(ws + WS_K); const bf16_t* VT = (const bf16_t*)(ws + WS_VT); const bf16_t* Z = (const bf16_t*)(ws + WS_Z);
    const bf16_t* NUMI = (const bf16_t*)(ws + WS_XC); const bf16_t* HL = (const bf16_t*)(ws + WS_HLOC); const bf16_t* CA = (const bf16_t*)(ws + WS_CUMA);
    bf16_t* MG = (bf16_t*)(ws + WS_XB);
    LAS bf16_t* Sl = (LAS bf16_t*)(lds + wave * 2304);
    const int t = tt * 16 + fr; const size_t tok = (size_t)(tok0 + t);
    bf16x8 qf[8];
#pragma unroll
    for (int ks = 0; ks < 8; ++ks) qf[ks] = *(const bf16x8*)(Q + tok * D + h * 256 + ks * 32 + fq * 8);
    float di = 0.f;
#pragma unroll
    for (int ks = 0; ks < 8; ++ks) { float qq[8]; unpack8(__builtin_bit_cast(u32x4, qf[ks]), qq);
        const f32x4 n0 = *(const f32x4*)(sm + SM_NST + (bh * 32 + c) * 256 + ks * 32 + fq * 8), n1 = *(const f32x4*)(sm + SM_NST + (bh * 32 + c) * 256 + ks * 32 + fq * 8 + 4);
        di += (qq[0] * n0[0] + qq[1] * n0[1]) + (qq[2] * n0[2] + qq[3] * n0[3]) + (qq[4] * n1[0] + qq[5] * n1[1]) + (qq[6] * n1[2] + qq[7] * n1[3]); }
    di += __shfl_xor(di, 16); di += __shfl_xor(di, 32);
    di *= sm[SM_SC + gb + t];
    const float bm = sm[SM_BM + gb + t];
    float ds = 0.f;
    for (int st = 0; st <= tt; ++st) {
        f32x4 sa = (f32x4){0.f, 0.f, 0.f, 0.f};
#pragma unroll
        for (int ks = 0; ks < 8; ++ks) { const bf16x8 kf = *(const bf16x8*)(Kb + (size_t)(tok0 + st * 16 + fr) * D + h * 256 + ks * 32 + fq * 8); sa = MFMA16(kf, qf[ks], sa); }
        const f32x4 gib = *(const f32x4*)(sm + SM_GIB + gb + st * 16 + fq * 4);
        float vv[4];
#pragma unroll
        for (int j = 0; j < 4; ++j) { const int s_ = st * 16 + fq * 4 + j; vv[j] = (s_ <= t) ? sa[j] * fexp_(bm + gib[j]) : 0.f; ds += vv[j]; }
        u32x2 w; w.x = pk2(vv[0], vv[1]); w.y = pk2(vv[2], vv[3]);
        *(LAS u32x2*)(Sl + fr * 72 + st * 16 + fq * 4) = w;
    }
    if ((tt & 1) == 0) { unsigned z0 = 0u; asm volatile("" : "+v"(z0)); *(LAS u32x2*)(Sl + fr * 72 + (tt + 1) * 16 + fq * 4) = (u32x2){z0, z0}; }
    ds += __shfl_xor(ds, 16); ds += __shfl_xor(ds, 32);
    const float den = ds + di;
    const float inv = 1.0f / fmaxf(fabsf(den), fexp_(-sm[SM_MM + gb + t]));
    asm volatile("s_waitcnt lgkmcnt(0)" ::: "memory");
    f32x4 acc[16];
#pragma unroll
    for (int e = 0; e < 16; ++e) acc[e] = (f32x4){0.f, 0.f, 0.f, 0.f};
    const int nks = tt < 2 ? 1 : 2;
    for (int ks = 0; ks < nks; ++ks) { const bf16x8 sf = *(const LAS bf16x8*)(Sl + fr * 72 + ks * 32 + fq * 8);
#pragma unroll
        for (int e = 0; e < 16; ++e) { const bf16x8 vf = *(const bf16x8*)(VT + (size_t)(h * 256 + e * 16 + fr) * M + tok0 + ks * 32 + fq * 8); acc[e] = MFMA16(vf, sf, acc[e]); } }
    asm volatile("s_waitcnt lgkmcnt(0)" ::: "memory");
    float hq = 0.f;
#pragma unroll
    for (int e = 0; e < 16; ++e) { float ni[4] = {0.f, 0.f, 0.f, 0.f};
        if (c > 0) { const u32x2 w = *(const u32x2*)(NUMI + tok * D + h * 256 + e * 16 + fq * 4); ni[0] = bflo(w.x); ni[1] = bfhi(w.x); ni[2] = bflo(w.y); ni[3] = bfhi(w.y); }
#pragma unroll
        for (int j = 0; j < 4; ++j) { const float hv = (acc[e][j] + ni[j]) * inv; acc[e][j] = hv; hq += hv * hv; } }
    hq += __shfl_xor(hq, 16); hq += __shfl_xor(hq, 32);
    const float rs = __builtin_amdgcn_rsqf(hq * (1.f / 256.f) + EPS);
#pragma unroll
    for (int e = 0; e < 16; ++e) { const int ch = h * 256 + e * 16 + fq * 4;
        const f32x4 mg = *(const f32x4*)(INP(25) + ch); const f32x4 cr = *(const f32x4*)(sm + SM_CARRY + (b * 32 + c) * D + ch);
        const u32x2 ow = *(const u32x2*)(Z + tok * NZ + 2048 + ch), glw = *(const u32x2*)(Z + tok * NZ + 3072 + ch), gmw = *(const u32x2*)(Z + tok * NZ + 4096 + ch);
        const u32x2 hlw = *(const u32x2*)(HL + tok * D + ch), caw = *(const u32x2*)(CA + tok * D + ch);
        const float ov[4] = {bflo(ow.x), bfhi(ow.x), bflo(ow.y), bfhi(ow.y)}, gl[4] = {bflo(glw.x), bfhi(glw.x), bflo(glw.y), bfhi(glw.y)}, gm[4] = {bflo(gmw.x), bfhi(gmw.x), bflo(gmw.y), bfhi(gmw.y)};
        const float hl[4] = {bflo(hlw.x), bfhi(hlw.x), bflo(hlw.y), bfhi(hlw.y)}, ca[4] = {bflo(caw.x), bfhi(caw.x), bflo(caw.y), bfhi(caw.y)};
        float o[4];
#pragma unroll
        for (int j = 0; j < 4; ++j) { const float ym = acc[e][j] * rs * mg[j] * sigmoidf_(ov[j]); const float yl = hl[j] + ca[j] * cr[j];
            o[j] = sigmoidf_(gl[j]) * yl + sigmoidf_(gm[j]) * ym; }
        u32x2 w; w.x = pk2(o[0], o[1]); w.y = pk2(o[2], o[3]);
        *(u32x2*)(MG + tok * D + ch) = w; }
}

__device__ __forceinline__ void p9_final(const Args& a, int G) {
    int tid = threadIdx.x; asm volatile("" : "+v"(tid)); const int lane = tid & 63, wave = tid >> 6;
    const float* sm = (const float*)(a.ws + WS_SMALL); const bf16_t* X = (const bf16_t*)(a.ws + WS_X1B);
    const int gw = blockIdx.x * 8 + wave, NGW = G * 8;
    f32x4 g4[4];
#pragma unroll
    for (int j = 0; j < 4; ++j) g4[j] = *((const f32x4*)INP(34) + lane + 64 * j);
    for (int row = gw; row < MR; row += NGW) {
        const float rs = 1.0f / sqrtf(sm[SM_SS3 + row] * (1.f / D) + EPS);
        const u32x2* xr = (const u32x2*)(X + (size_t)row * D) + lane;
        f32x4* o = (f32x4*)(a.out + (row < MP ? O_YP + (size_t)row * D : O_YS + (size_t)(row - MP) * D)) + lane;
#pragma unroll
        for (int j = 0; j < 4; ++j) { const u32x2 w = xr[64 * j]; const f32x4 v = (f32x4){bflo(w.x), bfhi(w.x), bflo(w.y), bfhi(w.y)}; o[64 * j] = v * rs * g4[j]; }
    }
}

template <int KS>
__device__ __forceinline__ void skinny_job(const Args& a, LAS unsigned char* lds, int kind, int G) {
    int tid = threadIdx.x; asm volatile("" : "+v"(tid)); const int lane = tid & 63, wave = tid >> 6, fr = lane & 15, fq = lane >> 4;
    unsigned char* ws = a.ws + opq0(); float* sm = (float*)(ws + WS_SMALL);
    const bf16_t* A; const bf16_t* Bt; int lda, ldb, K, nunits;
    switch (kind) {
    case 0: A = (const bf16_t*)(ws + WS_XB); lda = D; Bt = (const bf16_t*)(ws + WS_W1T); ldb = D; K = D; nunits = NZ / 16; break;
    case 1: A = (const bf16_t*)(ws + WS_XC); lda = D; Bt = (const bf16_t*)(ws + WS_WQKT); ldb = HD; K = HD; nunits = NH * 32; break;
    case 3: A = (const bf16_t*)(ws + WS_Z) + 1024; lda = NZ; Bt = (const bf16_t*)(ws + WS_WVT); ldb = HD; K = HD; nunits = NH * 16; break;
    case 4: A = (const bf16_t*)(ws + WS_XB); lda = D; Bt = (const bf16_t*)(ws + WS_WOT); ldb = D; K = D; nunits = D / 16; break;
    case 5: A = (const bf16_t*)(ws + WS_X1B); lda = D; Bt = (const bf16_t*)(ws + WS_WGUT); ldb = D; K = D; nunits = (DFF / 128) * 8; break;
    case 6: A = (const bf16_t*)(ws + WS_Z); lda = DFF; Bt = (const bf16_t*)(ws + WS_WDT); ldb = DFF; K = DFF; nunits = D / 16; break;
    case 7: A = (const bf16_t*)(ws + WS_PB); lda = PD; Bt = (const bf16_t*)(ws + WS_WPT); ldb = PD; K = PD; nunits = D / 16; break;
    default: A = (const bf16_t*)(ws + WS_X2B); lda = D; Bt = (const bf16_t*)(ws + WS_WPGT); ldb = D; K = D; nunits = D / 16; break;
    }
    const int row = MP + 16 * wave + fr, nksw = K / 256, kw = wave * (K / 8);
    LAS f32x4* red0 = (LAS f32x4*)lds; LAS f32x4* red1 = (LAS f32x4*)(lds + 65536);
    for (int u = blockIdx.x; u < nunits; u += G) {
        int acol = 0, brow0 = u * 16, brow1 = u * 16, z = 0; size_t boff = 0;
        if (kind == 1) { z = u >> 5; acol = z * 256; brow0 = (u & 31) * 16; brow1 = brow0; boff = (size_t)z * 512 * 256; }
        if (kind == 3) { z = u >> 4; acol = z * 256; brow0 = (u & 15) * 16; brow1 = brow0; boff = (size_t)z * 65536; }
        if (kind == 5) { brow0 = (u >> 3) * 256 + (u & 7) * 16; brow1 = brow0 + 128; }
        const bf16_t* Ap = A + (size_t)(MP + fr) * lda + acol + kw + fq * 8;
        const bf16_t* B0p = Bt + boff + (size_t)(brow0 + fr) * ldb + kw + fq * 8;
        const bf16_t* B1p = Bt + boff + (size_t)(brow1 + fr) * ldb + kw + fq * 8;
        bf16x8 b0[KS], b1[KS];
#pragma unroll
        for (int i = 0; i < KS; ++i) if (i < nksw) { b0[i] = *(const bf16x8*)(B0p + i * 32); if (kind == 5) b1[i] = *(const bf16x8*)(B1p + i * 32); }
        f32x4 p0[8], p1[8];
#pragma unroll
        for (int m = 0; m < 8; ++m) { p0[m] = (f32x4){0.f, 0.f, 0.f, 0.f}; p1[m] = (f32x4){0.f, 0.f, 0.f, 0.f}; }
        bf16x8 af[8];
#pragma unroll
        for (int m = 0; m < 8; ++m) af[m] = *(const bf16x8*)(Ap + (size_t)m * 16 * lda);
#pragma unroll
        for (int i = 0; i < KS; ++i) if (i < nksw) {
            bf16x8 an[8];
            const int inx = (i + 1 < nksw) ? i + 1 : i;
#pragma unroll
            for (int m = 0; m < 8; ++m) an[m] = *(const bf16x8*)(Ap + (size_t)m * 16 * lda + inx * 32);
#pragma unroll
            for (int m = 0; m < 8; ++m) { p0[m] = MFMA16(b0[i], af[m], p0[m]); if (kind == 5) p1[m] = MFMA16(b1[i], af[m], p1[m]); }
#pragma unroll
            for (int m = 0; m < 8; ++m) af[m] = an[m];
        }
#pragma unroll
        for (int m = 0; m < 8; ++m) { red0[(wave * 8 + m) * 64 + lane] = p0[m]; if (kind == 5) red1[(wave * 8 + m) * 64 + lane] = p1[m]; }
        __syncthreads();
        f32x4 acc0 = (f32x4){0.f, 0.f, 0.f, 0.f}, acc1 = (f32x4){0.f, 0.f, 0.f, 0.f};
#pragma unroll
        for (int w = 0; w < 8; ++w) { acc0 += red0[(w * 8 + wave) * 64 + lane]; if (kind == 5) acc1 += red1[(w * 8 + wave) * 64 + lane]; }
        __syncthreads();
        switch (kind) {
        case 0: { const float s = sm[SM_RSTD0 + row]; u32x2 w; w.x = pk2(acc0[0] * s, acc0[1] * s); w.y = pk2(acc0[2] * s, acc0[3] * s);
                  *(u32x2*)((bf16_t*)(ws + WS_Z) + (size_t)row * NZ + u * 16 + fq * 4) = w; } break;
        case 1: { const int col = brow0 + fq * 4; bf16_t* dst = (col < 256 ? (bf16_t*)(ws + WS_Q) + col : (bf16_t*)(ws + WS_K) + col - 256) + (size_t)row * D + z * 256;
                  u32x2 w; w.x = pk2(acc0[0], acc0[1]); w.y = pk2(acc0[2], acc0[3]); *(u32x2*)dst = w; } break;
        case 3: { bf16_t* VT = (bf16_t*)(ws + WS_VT);
#pragma unroll
                  for (int j = 0; j < 4; ++j) VT[(size_t)(z * 256 + brow0 + fq * 4 + j) * M + row] = (bf16_t)f2bf(acc0[j]); } break;
        case 4: case 6: { const int col = u * 16 + fq * 4; f32x4 b;
                  if (kind == 4) b = *(const f32x4*)(INP(1) + (size_t)(row - MP) * D + col);
                  else { const u32x2 w = *(const u32x2*)((const bf16_t*)(ws + WS_X1B) + (size_t)row * D + col); b = (f32x4){bflo(w.x), bfhi(w.x), bflo(w.y), bfhi(w.y)}; }
                  const f32x4 v = acc0 + b; u32x2 w; w.x = pk2(v[0], v[1]); w.y = pk2(v[2], v[3]);
                  *(u32x2*)((bf16_t*)(ws + (kind == 4 ? WS_X1B : WS_X2B)) + (size_t)row * D + col) = w;
                  float q = (v[0] * v[0] + v[1] * v[1]) + (v[2] * v[2] + v[3] * v[3]); q += __shfl_xor(q, 16); q += __shfl_xor(q, 32);
                  if (fq == 0) atomicAdd(sm + (kind == 4 ? SM_SS1 : SM_SS2) + row, q); } break;
        case 5: { const float s = __builtin_amdgcn_rsqf(sm[SM_SS1 + row] * (1.f / D) + EPS); float o[4];
#pragma unroll
                  for (int j = 0; j < 4; ++j) { const float gv = acc0[j] * s, uv = acc1[j] * s; o[j] = gv * sigmoidf_(gv) * uv; }
                  u32x2 w; w.x = pk2(o[0], o[1]); w.y = pk2(o[2], o[3]);
                  *(u32x2*)((bf16_t*)(ws + WS_Z) + (size_t)row * DFF + (u >> 3) * 128 + (u & 7) * 16 + fq * 4) = w; } break;
        case 7: { u32x2 w; w.x = pk2(acc0[0], acc0[1]); w.y = pk2(acc0[2], acc0[3]); *(u32x2*)((bf16_t*)(ws + WS_PE) + (size_t)row * D + u * 16 + fq * 4) = w; } break;
        default: { const int col = u * 16 + fq * 4; const float s = __builtin_amdgcn_rsqf(sm[SM_SS2 + row] * (1.f / D) + EPS);
                  const u32x2 xw = *(const u32x2*)((const bf16_t*)(ws + WS_X2B) + (size_t)row * D + col), pw = *(const u32x2*)((const bf16_t*)(ws + WS_PE) + (size_t)row * D + col);
                  const float xb[4] = {bflo(xw.x), bfhi(xw.x), bflo(xw.y), bfhi(xw.y)}, pe[4] = {bflo(pw.x), bfhi(pw.x), bflo(pw.y), bfhi(pw.y)};
                  float v[4], q = 0.f;
#pragma unroll
                  for (int j = 0; j < 4; ++j) { v[j] = xb[j] + sigmoidf_(acc0[j] * s) * pe[j]; q += v[j] * v[j]; }
                  u32x2 w; w.x = pk2(v[0], v[1]); w.y = pk2(v[2], v[3]); *(u32x2*)((bf16_t*)(ws + WS_X1B) + (size_t)row * D + col) = w;
                  q += __shfl_xor(q, 16); q += __shfl_xor(q, 32);
                  if (fq == 0) atomicAdd(sm + SM_SS3 + row, q); } break;
        }
    }
}
__device__ __forceinline__ int skinny_kind(int ph, int j) {
    if (ph == 1) return j == 0 ? 0 : -1;
    if (ph == 3) return j == 0 ? 1 : (j == 1 ? 3 : -1);
    if (ph == 6) return j == 0 ? 4 : -1;
    if (ph == 7) return j == 0 ? 5 : -1;
    if (ph == 8) return j == 0 ? 6 : -1;
    if (ph == 9) return j == 0 ? 7 : (j == 1 ? 8 : -1);
    return -1;
}

#define XB_TMO      128
#define XB_XCNT(j)  (256  + 64 * (j))
#define XB_XSUB(j)  (1280 + 64 * (j))
#define XB_XGEN(j)  (2304 + 64 * (j))
#define XB_TOP      3328
#define XB_TOPGEN   3392
#define XCD_BAR_WORDS 3456
#define XB_SPIN_CAP (1u << 18)
__device__ __forceinline__ unsigned xb_ld(unsigned* p)              { return __hip_atomic_load(p, __ATOMIC_RELAXED, __HIP_MEMORY_SCOPE_AGENT); }
__device__ __forceinline__ unsigned xb_add(unsigned* p, unsigned v) { return __hip_atomic_fetch_add(p, v, __ATOMIC_RELAXED, __HIP_MEMORY_SCOPE_AGENT); }
__device__ __forceinline__ unsigned xb_xcc_id() { return (unsigned)__builtin_amdgcn_s_getreg((3 << 11) | 20) & 0xFu; }
#define XB_SPIN(cond, bar) do { unsigned _sp = 0; while (cond) { __builtin_amdgcn_s_sleep(1); \
    if ((++_sp & 255u) == 0u) { if (xb_ld(&(bar)[XB_TMO])) break; if (_sp > XB_SPIN_CAP) { atomicAdd(&(bar)[XB_TMO], 1u); break; } } } } while (0)
struct XcdBarrier { unsigned* bar; unsigned x; volatile LAS unsigned* st; };
__device__ __forceinline__ XcdBarrier xcd_barrier_post(unsigned* bar, volatile LAS unsigned* st) {
    XcdBarrier b; b.bar = bar; b.x = xb_xcc_id(); b.st = st;
    if (threadIdx.x == 0) (void)xb_add(&bar[XB_XCNT(b.x)], 1u);
    return b;
}
__device__ __forceinline__ void xcd_barrier_complete(unsigned* bar, unsigned x, unsigned& nloc, unsigned& nx) {
    const unsigned G = gridDim.x * gridDim.y * gridDim.z;
    unsigned sum, cnt, mine, sp = 0u;
    for (;;) {
        sum = 0u; cnt = 0u; mine = 0u;
#pragma unroll
        for (unsigned j = 0; j < 16; ++j) { const unsigned c = xb_ld(&bar[XB_XCNT(j)]); sum += c; cnt += (c > 0u) ? 1u : 0u; mine = (j == x) ? c : mine; }
        if (sum == G) break;
        __builtin_amdgcn_s_sleep(1);
        if ((++sp & 255u) == 0u) { if (xb_ld(&bar[XB_TMO])) break; if (sp > XB_SPIN_CAP) { atomicAdd(&bar[XB_TMO], 1u); break; } }
    }
    nloc = mine > 0u ? mine : 1u; nx = cnt > 0u ? cnt : 1u;
}
__device__ __forceinline__ void xcd_barrier(const XcdBarrier& b) {
    asm volatile("s_waitcnt vmcnt(0)" ::: "memory");
    __syncthreads();
    if (threadIdx.x == 0) {
        unsigned* bar = b.bar;
        __builtin_amdgcn_s_waitcnt(0);
        unsigned nloc = b.st[0], nx = b.st[1];
        if (nloc == 0u) { xcd_barrier_complete(bar, b.x, nloc, nx); b.st[0] = nloc; b.st[1] = nx; }
        const unsigned old = xb_add(&bar[XB_XSUB(b.x)], 1u);
        const unsigned gen = old / nloc;
        if (old + 1u == (gen + 1u) * nloc) {
            __builtin_amdgcn_fence(__ATOMIC_RELEASE, "agent");
            asm volatile("s_waitcnt vmcnt(0)" ::: "memory");
            const unsigned og = xb_add(&bar[XB_TOP], 1u);
            const unsigned tg = og / nx;
            if (og + 1u == (tg + 1u) * nx) xb_add(&bar[XB_TOPGEN], 1u);
            else XB_SPIN(xb_ld(&bar[XB_TOPGEN]) == tg, bar);
            __builtin_amdgcn_fence(__ATOMIC_ACQUIRE, "agent");
            xb_add(&bar[XB_XGEN(b.x)], 1u);
            asm volatile("s_waitcnt vmcnt(0)" ::: "memory");
        } else {
            XB_SPIN(xb_ld(&bar[XB_XGEN(b.x)]) == gen, bar);
            __builtin_amdgcn_fence(__ATOMIC_ACQUIRE, "agent");
            asm volatile("s_waitcnt vmcnt(0)" ::: "memory");
        }
    }
    __syncthreads();
}

namespace pg8 {
struct EpiAny {
    int kind; unsigned char* ws; const float* xp; const float* xs;
    __device__ __forceinline__ void operator()(const f32x4 (&acc)[2][2][4][2], const Unit& u, int wr, int wc, int fr, int fq) const {
        float* sm = (float*)(ws + WS_SMALL);
        switch (kind) {
        case 0: { EpiZ E{(bf16_t*)(ws + WS_Z), sm + SM_RSTD0}; E(acc, u, wr, wc, fr, fq); } break;
        case 1: { EpiQK E{(bf16_t*)(ws + WS_Q), (bf16_t*)(ws + WS_K)}; E(acc, u, wr, wc, fr, fq); } break;
        case 2: { EpiT E{(bf16_t*)(ws + WS_KT)}; E(acc, u, wr, wc, fr, fq); } break;
        case 3: { EpiT E{(bf16_t*)(ws + WS_VT)}; E(acc, u, wr, wc, fr, fq); } break;
        case 4: { EpiRes<0> E{xp, xs, nullptr, (bf16_t*)(ws + WS_X1B), sm + SM_SS1}; E(acc, u, wr, wc, fr, fq); } break;
        case 5: { EpiGU E{(bf16_t*)(ws + WS_Z), sm + SM_SS1}; E(acc, u, wr, wc, fr, fq); } break;
        case 6: { EpiRes<1> E{nullptr, nullptr, (const bf16_t*)(ws + WS_X1B), (bf16_t*)(ws + WS_X2B), sm + SM_SS2}; E(acc, u, wr, wc, fr, fq); } break;
        case 7: { EpiPlain E{(bf16_t*)(ws + WS_PE), D}; E(acc, u, wr, wc, fr, fq); } break;
        default: { EpiPle E{(const bf16_t*)(ws + WS_X2B), (bf16_t*)(ws + WS_X1B), (const bf16_t*)(ws + WS_PE), sm + SM_SS2, sm + SM_SS3}; E(acc, u, wr, wc, fr, fq); } break;
        }
    }
};
}

__device__ __forceinline__ bool gemm_job(unsigned char* ws, int ph, int j, pg8::Gemm& g, int& nM, int& nN, int& nZ, int& kind) {
    using namespace pg8;
    const bf16_t* w = (const bf16_t*)ws;
#define WSB(off) ((const bf16_t*)(ws + (off)))
    if (ph == 1 && j == 0) { g = Gemm{WSB(WS_XB), WSB(WS_W1T), D, D, D, 0, 0}; nM = MP / 256; nN = NZ / 256; nZ = 1; kind = 0; return true; }
    if (ph == 3 && j == 0) { g = Gemm{WSB(WS_XC), WSB(WS_WQKT), D, HD, HD, 512, (size_t)512 * 256 * 2}; nM = MP / 256; nN = 2; nZ = NH; kind = 1; return true; }
    if (ph == 3 && j == 1) { g = Gemm{WSB(WS_WQKT) + 65536, WSB(WS_XC), HD, D, HD, (size_t)512 * 256 * 2, 512}; nM = 1; nN = MP / 256; nZ = NH; kind = 2; return true; }
    if (ph == 3 && j == 2) { g = Gemm{WSB(WS_WVT), WSB(WS_Z) + 1024, HD, NZ, HD, (size_t)65536 * 2, 512}; nM = 1; nN = MP / 256; nZ = NH; kind = 3; return true; }
    if (ph == 6 && j == 0) { g = Gemm{WSB(WS_XB), WSB(WS_WOT), D, D, D, 0, 0}; nM = MP / 256; nN = D / 256; nZ = 1; kind = 4; return true; }
    if (ph == 7 && j == 0) { g = Gemm{WSB(WS_X1B), WSB(WS_WGUT), D, D, D, 0, 0}; nM = MP / 256; nN = NGU / 256; nZ = 1; kind = 5; return true; }
    if (ph == 8 && j == 0) { g = Gemm{WSB(WS_Z), WSB(WS_WDT), DFF, DFF, DFF, 0, 0}; nM = MP / 256; nN = D / 256; nZ = 1; kind = 6; return true; }
    if (ph == 9 && j == 0) { g = Gemm{WSB(WS_PB), WSB(WS_WPT), PD, PD, PD, 0, 0}; nM = MP / 256; nN = D / 256; nZ = 1; kind = 7; return true; }
    if (ph == 9 && j == 1) { g = Gemm{WSB(WS_X2B), WSB(WS_WPGT), D, D, D, 0, 0}; nM = MP / 256; nN = D / 256; nZ = 1; kind = 8; return true; }
#undef WSB
    (void)w; return false;
}

#ifndef REPMASK
#define REPMASK 0
#endif
constexpr int NPHASE = 11;
__global__ void __launch_bounds__(NT, 2) hawk_fwd(Args a) {
    extern __shared__ __attribute__((aligned(16))) unsigned char lds_raw[];
    LAS unsigned char* lds = (LAS unsigned char*)lds_raw;
    cg::grid_group grid = cg::this_grid();
    const int G = gridDim.x, bx = blockIdx.x;
    volatile LAS unsigned* bst = (volatile LAS unsigned*)(lds + LDS_BYTES - 64);
    if (threadIdx.x == 0) { bst[0] = 0u; bst[1] = 0u; }
    __syncthreads();
    const XcdBarrier xbar = xcd_barrier_post((unsigned*)(a.ws + WS_BAR), bst);
    if (a.ph_hi < 0) grid.sync();
    for (int ph = a.ph_lo; ph < a.ph_hi; ++ph) {
        for (int rep = 0; rep < 1 + ((REPMASK >> ph) & 1); ++rep) {
            if (rep) xcd_barrier(xbar);
            switch (ph) {
            case 0: p0_prologue(a, lds, G); break;
            case 2: for (int it = bx; it < 2048 + MS; it += G) p2a_item(a, lds, it); break;
            case 3: for (int bh = bx; bh < 32; bh += G) gate_scan(a, lds, bh); break;
            case 4: carry_scan(a, G);
                    for (int it = bx; it < 256; it += G) p3_item(a, lds, ((it & 7) << 5) | (it >> 3)); break;
            case 5: { int tw = threadIdx.x; asm volatile("" : "+v"(tw)); for (int it = bx * 8 + (tw >> 6); it < 4096; it += G * 8) p4w_item(a, lds, it); } break;
            case 10: p9_final(a, G); break;
            default: break;
            }
            for (int sj = 0; sj < 2; ++sj) { const int sk = skinny_kind(ph, sj); if (sk < 0) break; if (sk == 6) skinny_job<11>(a, lds, sk, G); else skinny_job<4>(a, lds, sk, G); __syncthreads(); }
            __syncthreads();
            for (int j = 0; j < 3; ++j) {
                pg8::Gemm g; int nM, nN, nZ, kind;
                if (!gemm_job(a.ws, ph, j, g, nM, nN, nZ, kind)) break;
                pg8::Order S; S.init(nM, nN, nZ, G, bx);
                pg8::EpiAny E{kind, a.ws, a.in[0], a.in[1]};
                pg8::gemm_phase(lds, g, S, E);
            }
        }
        if (ph + 1 < a.ph_hi) xcd_barrier(xbar);
    }
}

#ifndef N_LAUNCH_SPLIT
#define N_LAUNCH_SPLIT 0
#endif
extern "C" void kernel_launch(void* const* d_in, const int* in_sizes, int n_in, void* d_out, int out_size, void* d_ws, size_t ws_size, hipStream_t stream) {
    static int grid = 0;
    if (grid == 0) {
        int dev = 0, cus = 0, per_cu = 0;
        hipGetDevice(&dev);
        hipDeviceGetAttribute(&cus, hipDeviceAttributeMultiprocessorCount, dev);
        hipFuncSetAttribute((const void*)hawk_fwd, hipFuncAttributeMaxDynamicSharedMemorySize, LDS_BYTES);
        hipOccupancyMaxActiveBlocksPerMultiprocessor(&per_cu, (const void*)hawk_fwd, NT, LDS_BYTES);
        if (per_cu < 1) { fprintf(stderr, "kernel_launch: occupancy query says %d blocks per CU\n", per_cu); per_cu = 1; }
        grid = cus * per_cu;
        if (n_in != 35 || ws_size < WS_END || (size_t)out_size != O_END) fprintf(stderr, "kernel_launch: unexpected sizes n_in %d ws %zu out %d\n", n_in, ws_size, out_size);
    }
    Args a{};
    for (int i = 0; i < 35; ++i) a.in[i] = (const float*)d_in[i];
    a.out = (float*)d_out; a.ws = (unsigned char*)d_ws;
#if N_LAUNCH_SPLIT
    for (int p = 0; p < NPHASE; ++p) { a.ph_lo = p; a.ph_hi = p + 1; hipLaunchKernelGGL(hawk_fwd, dim3(grid), dim3(NT), LDS_BYTES, stream, a); }
#else
    a.ph_lo = 0; a.ph_hi = NPHASE;
    hipMemsetAsync((char*)d_ws + WS_BAR, 0, 16384, stream);
    void* args[] = {&a};
    hipError_t e = hipLaunchCooperativeKernel((const void*)hawk_fwd, dim3(grid), dim3(NT), args, LDS_BYTES, stream);
    if (e != hipSuccess) fprintf(stderr, "cooperative launch failed: %s (grid %d)\n", hipGetErrorString(e), grid);
#endif
}
```

```cpp
#include <hip/hip_runtime.h>
#include <hip/hip_cooperative_groups.h>
#include <cstdio>
#include <cstdint>
namespace cg = cooperative_groups;

#define LAS __attribute__((address_space(3)))
typedef unsigned short bf16_t;
typedef short bf16x8 __attribute__((ext_vector_type(8)));
typedef float f32x4 __attribute__((ext_vector_type(4)));
typedef float f32x2 __attribute__((ext_vector_type(2)));
typedef unsigned u32x4 __attribute__((ext_vector_type(4)));
typedef unsigned u32x2 __attribute__((ext_vector_type(2)));

constexpr int D = 1024, NB = 8, T = 2048, MP = NB * T, MS = 128, MR = MP + MS, M = 16640  ;
constexpr int NZ = 5120, DFF = 2816, NGU = 2 * DFF, PD = 256, NIN = 5128, NH = 4, HD = 256, NCH = T / 64;
constexpr float EPS = 1e-6f;
constexpr float M_INIT = -1e30f;

constexpr size_t MiB = 1u << 20;
constexpr size_t WS_W1T = 0;
constexpr size_t WS_WOT = 10 * MiB;
constexpr size_t WS_WGUT = 12 * MiB;
constexpr size_t WS_WDT = 23 * MiB;
constexpr size_t WS_WPGT = 57 * MiB / 2;
constexpr size_t WS_WPT = 61 * MiB / 2;
constexpr size_t WS_WQKT = 31 * MiB;
constexpr size_t WS_WVT = 32 * MiB;
constexpr size_t WS_WLRUT = 65 * MiB / 2;
constexpr size_t WS_BAR = 40 * MiB - 16384;
constexpr size_t WS_SMALL = 33 * MiB;
constexpr size_t WS_XB = 40 * MiB;
constexpr size_t WS_PB = 73 * MiB;
constexpr size_t WS_Z = 82 * MiB;
constexpr size_t WS_XC = 245 * MiB;
constexpr size_t WS_Q = 278 * MiB;
constexpr size_t WS_K = 311 * MiB;
constexpr size_t WS_KT = 344 * MiB;
constexpr size_t WS_VT = 377 * MiB;
constexpr size_t WS_HLOC = 410 * MiB;
constexpr size_t WS_CUMA = 443 * MiB;
constexpr size_t WS_VS = 476 * MiB;
constexpr size_t WS_END = 477 * MiB;
constexpr size_t WS_X1 = WS_Q;
constexpr size_t WS_X1B = WS_KT;
constexpr size_t WS_X2B = WS_VT;
constexpr size_t WS_PE = WS_HLOC;
constexpr int SM_RSTD0 = 0;
constexpr int SM_SS1 = SM_RSTD0 + M;
constexpr int SM_SS2 = SM_SS1 + M;
constexpr int SM_SS3 = SM_SS2 + M;
constexpr int SM_GI = SM_SS3 + M;
constexpr int SM_GF = SM_GI + 4 * M;
constexpr int SM_BM = SM_GF + 4 * M;
constexpr int SM_GIB = SM_BM + 32 * T;
constexpr int SM_SC = SM_GIB + 32 * T;
constexpr int SM_WK = SM_SC + 32 * T;
constexpr int SM_MM = SM_WK + 32 * T;
constexpr int SM_DEC = SM_MM + 32 * T;
constexpr int SM_NST = SM_DEC + 1024;
constexpr int SM_LRA = SM_NST + 32 * 32 * 256;
constexpr int SM_LRH = SM_LRA + 8 * 32 * 1024;
constexpr int SM_XLS = SM_LRH + 8 * 32 * 1024;
constexpr int SM_CARRY = SM_XLS + 128 * 1024;
constexpr int SM_END = SM_CARRY + 8 * 32 * 1024;
static_assert((size_t)SM_END * 4 <= 7 * MiB - 16384, "small arrays");
static_assert(WS_END <= 512 * MiB, "workspace");

constexpr size_t O_YP = 0, O_YS = O_YP + (size_t)MP * D, O_PLC = O_YS + (size_t)MS * D, O_PLH = O_PLC + 8 * 3 * 1024, O_PMC = O_PLH + 8 * 1024,
                 O_PC = O_PMC + 8 * 3 * 1024, O_PN = O_PC + (size_t)8 * 4 * 65536, O_PM = O_PN + 8 * 4 * 256, O_SLC = O_PM + 32, O_SLH = O_SLC + (size_t)128 * 3 * 1024,
                 O_SMC = O_SLH + 128 * 1024, O_SC = O_SMC + (size_t)128 * 3 * 1024, O_SN = O_SC + (size_t)128 * 4 * 65536, O_SM = O_SN + 128 * 4 * 256, O_END = O_SM + 512;

constexpr int LDS_BYTES = 147456;
constexpr int NT = 512;

struct Args {
    const float* in[35];
    float* out;
    unsigned char* ws;
    int ph_lo, ph_hi;
};

__device__ __forceinline__ size_t opq0() { size_t z = 0; asm volatile("" : "+s"(z)); return z; }
#define INP(k) (a.in[k] + opq0())
__device__ __forceinline__ unsigned f2bf(float f) { unsigned u = __builtin_bit_cast(unsigned, f); return (u + 0x7fffu + ((u >> 16) & 1u)) >> 16; }
__device__ __forceinline__ unsigned pk2(float lo, float hi) { return f2bf(lo) | (f2bf(hi) << 16); }
__device__ __forceinline__ float bf2f(unsigned short h) { return __builtin_bit_cast(float, (unsigned)h << 16); }
__device__ __forceinline__ float bflo(unsigned w) { return __builtin_bit_cast(float, w << 16); }
__device__ __forceinline__ float bfhi(unsigned w) { return __builtin_bit_cast(float, w & 0xffff0000u); }
__device__ __forceinline__ float sigmoidf_(float x) { return __builtin_amdgcn_rcpf(1.f + __builtin_amdgcn_exp2f(-1.4426950408889634f * x)); }
__device__ __forceinline__ float fexp_(float x) { return __builtin_amdgcn_exp2f(1.4426950408889634f * x); }
__device__ __forceinline__ void unpack8x(const u32x4 w, float (&o)[8]) { o[0] = bflo(w.x); o[1] = bfhi(w.x); o[2] = bflo(w.y); o[3] = bfhi(w.y); o[4] = bflo(w.z); o[5] = bfhi(w.z); o[6] = bflo(w.w); o[7] = bfhi(w.w); }
__device__ __forceinline__ float wave_sum(float v) {
#pragma unroll
    for (int o = 1; o < 64; o <<= 1) v += __shfl_xor(v, o);
    return v;
}
__device__ __forceinline__ const float* xrow_ptr(const Args& a, int row) {
    return row < MP ? INP(0) + (size_t)row * D : INP(1) + (size_t)(row - MP) * D;
}

namespace pg8 {
constexpr int BM = 256, BK = 64, HALF = 128, HTB = HALF * BK * 2, STAGE_BYTES = 8 * HTB, NXCD = 8, WGM = 8;
__device__ __forceinline__ int lds_byte(int r, int c) { const int st = (r >> 4) * 2 + (c >> 5), rr = r & 15, cc = c & 31, ob = rr * 64 + cc * 2; return st * 1024 + (ob ^ (((ob >> 9) & 1) << 5)); }
__device__ __forceinline__ void stage_rc(int b, int& R, int& C) { const int st = b / 1024, sb = b % 1024, swz = sb ^ (((sb >> 9) & 1) << 5); R = (st >> 1) * 16 + swz / 64; C = (st & 1) * 32 + (swz % 64) / 2; }
__device__ __forceinline__ int perm32(int rho) { const int n = rho >> 4, i = rho & 15; return 8 * (i >> 2) + 4 * n + (i & 3); }

struct Unit { int pm, pn, z; };
struct Gemm { const bf16_t* A; const bf16_t* Bt; int lda, ldb, K; size_t zA, zB; };

struct Order {
    int nM, nN, nwg, total, G, c;
    __device__ void init(int nM_, int nN_, int nZ_, int G_, int c_) { nM = nM_; nN = nN_; nwg = nM * nN; total = nwg * nZ_; G = G_; c = c_; }
    __device__ bool next(int i, Unit& u) const {
        const long L = (long)i * G + c; if (L >= total) return false;
        u.z = (int)(L / nwg); int wgid = (int)(L % nwg);
        { const int q = nwg / NXCD, r = nwg % NXCD, xcd = wgid % NXCD, off = wgid / NXCD; wgid = (xcd < r ? xcd * (q + 1) : r * (q + 1) + (xcd - r) * q) + off; }
        const int nig = WGM * nN, gid = wgid / nig, fm = gid * WGM, gsz = (nM - fm) < WGM ? (nM - fm) : WGM;
        u.pm = fm + ((wgid % nig) % gsz); u.pn = (wgid % nig) / gsz; return true;
    }
};

__device__ __forceinline__ unsigned cvt_pk_bf16(float lo, float hi) { unsigned r; asm volatile("v_cvt_pk_bf16_f32 %0, %1, %2" : "=v"(r) : "v"(lo), "v"(hi)); return r; }

template <class Epi>
__device__ __forceinline__ void gemm_phase(LAS unsigned char* lds, const Gemm g, const Order& S, const Epi& E) {
    int tid = threadIdx.x; asm volatile("" : "+v"(tid));
    const int wid = __builtin_amdgcn_readfirstlane(tid >> 6), lane = tid & 63, wr = wid >> 2, wc = wid & 3, fr = lane & 15, fq = lane >> 4;
    const int K = g.K, nt = K / BK;
    unsigned voffA[2], voffB[2];
#pragma unroll
    for (int i = 0; i < 2; ++i) { int R, C; stage_rc(tid * 16 + i * 8192, R, C); const int Rb = (R & ~31) + perm32(R & 31);
        voffA[i] = (unsigned)(R * g.lda + C) * 2u; voffB[i] = (unsigned)(Rb * g.ldb + C) * 2u; }
    const size_t kstep = (size_t)(BK * 2);
    const size_t hstepA = (size_t)HALF * g.lda * 2, hstepB = (size_t)HALF * g.ldb * 2;
    const size_t tstepA = 2 * hstepA, tstepB = 2 * hstepB;
    const unsigned ldsw = (unsigned)wid * 1024u;
    const int aoff = lds_byte(wr * 64 + fr, fq * 8), boff = lds_byte(wc * 32 + fr, fq * 8);
#define PG8_SA(b, h) (((b) * 2 + (h)) * HTB)
#define PG8_SB(b, h) ((4 + (b) * 2 + (h)) * HTB)
#define PG8_STAGE(bufoff, gbase, voff) do { _Pragma("unroll") for (int _i = 0; _i < 2; ++_i) \
        __builtin_amdgcn_global_load_lds((const unsigned*)((const char*)(gbase) + (voff)[_i]), (LAS unsigned*)(lds + (bufoff) + ldsw + _i * 8192), 16, 0, 0); } while (0)
#define PG8_LDA(dst, b, h) do { _Pragma("unroll") for (int m = 0; m < 4; ++m) _Pragma("unroll") for (int k = 0; k < 2; ++k) dst[m][k] = *(const LAS bf16x8*)(lds + PG8_SA(b, h) + aoff + m * 2048 + k * 1024); } while (0)
#define PG8_LDB(dst, b, h) do { _Pragma("unroll") for (int n = 0; n < 2; ++n) _Pragma("unroll") for (int k = 0; k < 2; ++k) dst[n][k] = *(const LAS bf16x8*)(lds + PG8_SB(b, h) + boff + n * 2048 + k * 1024); } while (0)
#define PG8_MMA(ai, bj, At, Bt) do { __builtin_amdgcn_s_setprio(1); _Pragma("unroll") for (int m = 0; m < 4; ++m) _Pragma("unroll") for (int n = 0; n < 2; ++n) _Pragma("unroll") for (int k = 0; k < 2; ++k) \
        acc[ai][bj][m][n] = __builtin_amdgcn_mfma_f32_16x16x32_bf16(Bt[n][k], At[m][k], acc[ai][bj][m][n], 0, 0, 0); __builtin_amdgcn_s_setprio(0); } while (0)
#define PG8_WAIT_V(n) asm volatile("s_waitcnt vmcnt(" #n ")" ::: "memory")
#define PG8_WAIT_L(n) asm volatile("s_waitcnt lgkmcnt(" #n ")" ::: "memory")
#define PG8_BAR __builtin_amdgcn_s_barrier()
#define PG8_SCHED __builtin_amdgcn_sched_barrier(0)
    Unit cur, nxt; int ui = 0;
    if (!S.next(0, cur)) return;
    f32x4 acc[2][2][4][2];
#pragma unroll
    for (int a = 0; a < 2; ++a)
#pragma unroll
        for (int b = 0; b < 2; ++b)
#pragma unroll
            for (int m = 0; m < 4; ++m)
#pragma unroll
                for (int n = 0; n < 2; ++n) acc[a][b][m][n] = (f32x4){0.f, 0.f, 0.f, 0.f};
    bf16x8 At[4][2], B0[2][2], B1[2][2];
    const char* cA = (const char*)g.A + (size_t)cur.pm * tstepA + (size_t)cur.z * g.zA; const char* cB = (const char*)g.Bt + (size_t)cur.pn * tstepB + (size_t)cur.z * g.zB;
    PG8_STAGE(PG8_SB(0, 0), cB, voffB); PG8_STAGE(PG8_SB(0, 1), cB + hstepB, voffB); PG8_STAGE(PG8_SA(0, 0), cA, voffA); PG8_STAGE(PG8_SA(0, 1), cA + hstepA, voffA);
    if (wr == 1) PG8_BAR;
    PG8_WAIT_V(2); PG8_BAR;
    PG8_STAGE(PG8_SB(1, 0), cB + kstep, voffB); PG8_STAGE(PG8_SA(1, 0), cA + kstep, voffA); PG8_STAGE(PG8_SB(1, 1), cB + hstepB + kstep, voffB);
    PG8_WAIT_V(6); PG8_BAR;
    for (;;) {
        const bool has_next = S.next(ui + 1, nxt);
        const char* nA = has_next ? (const char*)g.A + (size_t)nxt.pm * tstepA + (size_t)nxt.z * g.zA : cA;
        const char* nB = has_next ? (const char*)g.Bt + (size_t)nxt.pn * tstepB + (size_t)nxt.z * g.zB : cB;
        for (int t = 0; t < nt; t += 2) {
            const bool last = (t == nt - 2);
            const char* a1 = cA + (size_t)(t + 1) * kstep;
            const char* a2 = last ? nA : cA + (size_t)(t + 2) * kstep; const char* b2 = last ? nB : cB + (size_t)(t + 2) * kstep;
            const char* a3 = a2 + kstep; const char* b3 = b2 + kstep;
            PG8_LDB(B0, 0, 0); PG8_LDB(B1, 0, 1); PG8_SCHED; PG8_LDA(At, 0, 0); PG8_STAGE(PG8_SA(1, 1), a1 + hstepA, voffA);
            PG8_WAIT_V(8); PG8_WAIT_L(0); PG8_BAR; PG8_MMA(0, 0, At, B0); PG8_MMA(0, 1, At, B1); PG8_BAR; PG8_SCHED;
            PG8_LDA(At, 0, 1); PG8_STAGE(PG8_SB(0, 0), b2, voffB); PG8_STAGE(PG8_SB(0, 1), b2 + hstepB, voffB); PG8_STAGE(PG8_SA(0, 0), a2, voffA);
            PG8_WAIT_V(8); PG8_WAIT_L(0); PG8_BAR; PG8_MMA(1, 0, At, B0); PG8_MMA(1, 1, At, B1); PG8_BAR; PG8_SCHED;
            PG8_LDB(B0, 1, 0); PG8_LDB(B1, 1, 1); PG8_SCHED; PG8_LDA(At, 1, 0); PG8_STAGE(PG8_SA(0, 1), a2 + hstepA, voffA);
            PG8_WAIT_V(8); PG8_WAIT_L(0); PG8_BAR; PG8_MMA(0, 0, At, B0); PG8_MMA(0, 1, At, B1); PG8_BAR; PG8_SCHED;
            PG8_LDA(At, 1, 1); PG8_STAGE(PG8_SB(1, 0), b3, voffB); PG8_STAGE(PG8_SB(1, 1), b3 + hstepB, voffB); PG8_STAGE(PG8_SA(1, 0), a3, voffA);
            PG8_WAIT_V(8); PG8_WAIT_L(0); PG8_BAR; PG8_MMA(1, 0, At, B0); PG8_MMA(1, 1, At, B1); PG8_BAR; PG8_SCHED;
        }
        if (wr == 0) PG8_BAR;
        E(acc, cur, wr, wc, fr, fq);
        if (!has_next) break;
#pragma unroll
        for (int a = 0; a < 2; ++a)
#pragma unroll
            for (int b = 0; b < 2; ++b)
#pragma unroll
                for (int m = 0; m < 4; ++m)
#pragma unroll
                    for (int n = 0; n < 2; ++n) acc[a][b][m][n] = (f32x4){0.f, 0.f, 0.f, 0.f};
        cur = nxt; cA = nA; cB = nB; ++ui;
        if (wr == 1) PG8_BAR;
    }
    PG8_WAIT_V(0);
    PG8_BAR;
#undef PG8_SA
#undef PG8_SB
#undef PG8_STAGE
#undef PG8_LDA
#undef PG8_LDB
#undef PG8_MMA
#undef PG8_WAIT_V
#undef PG8_WAIT_L
#undef PG8_BAR
#undef PG8_SCHED
}

#define EPI_ROW0(u) ((u).pm * BM + wr * 64 + fr)
#define EPI_COL0(u) ((u).pn * BM + wc * 32 + 8 * fq)

struct EpiZ {
    bf16_t* Zp; const float* rstd;
    __device__ __forceinline__ void operator()(const f32x4 (&acc)[2][2][4][2], const Unit& u, int wr, int wc, int fr, int fq) const {
        const int row0 = EPI_ROW0(u), col0 = EPI_COL0(u);
#pragma unroll
        for (int ai = 0; ai < 2; ++ai)
#pragma unroll
            for (int m = 0; m < 4; ++m) { const int row = row0 + ai * HALF + m * 16; const float s = rstd[row]; bf16_t* rp = Zp + (size_t)row * NZ + col0;
#pragma unroll
                for (int bj = 0; bj < 2; ++bj) { const f32x4 v0 = acc[ai][bj][m][0] * s, v1 = acc[ai][bj][m][1] * s; u32x4 w;
                    w.x = cvt_pk_bf16(v0[0], v0[1]); w.y = cvt_pk_bf16(v0[2], v0[3]); w.z = cvt_pk_bf16(v1[0], v1[1]); w.w = cvt_pk_bf16(v1[2], v1[3]);
                    *(u32x4*)(rp + bj * HALF) = w; } }
    }
};
struct EpiQK {
    bf16_t* Qp; bf16_t* Kp;
    __device__ __forceinline__ void operator()(const f32x4 (&acc)[2][2][4][2], const Unit& u, int wr, int wc, int fr, int fq) const {
        const int row0 = EPI_ROW0(u), col0 = wc * 32 + 8 * fq; bf16_t* base = (u.pn ? Kp : Qp) + (size_t)u.z * M * 256;
#pragma unroll
        for (int ai = 0; ai < 2; ++ai)
#pragma unroll
            for (int m = 0; m < 4; ++m) { const int row = row0 + ai * HALF + m * 16; bf16_t* rp = base + (size_t)row * 256 + col0;
#pragma unroll
                for (int bj = 0; bj < 2; ++bj) { const f32x4 v0 = acc[ai][bj][m][0], v1 = acc[ai][bj][m][1]; u32x4 w;
                    w.x = cvt_pk_bf16(v0[0], v0[1]); w.y = cvt_pk_bf16(v0[2], v0[3]); w.z = cvt_pk_bf16(v1[0], v1[1]); w.w = cvt_pk_bf16(v1[2], v1[3]);
                    *(u32x4*)(rp + bj * HALF) = w; } }
    }
};
struct EpiT {
    bf16_t* Op; const float* wk;
    __device__ __forceinline__ void operator()(const f32x4 (&acc)[2][2][4][2], const Unit& u, int wr, int wc, int fr, int fq) const {
        const int row0 = wr * 64 + fr, col0 = EPI_COL0(u);
#pragma unroll
        for (int ai = 0; ai < 2; ++ai)
#pragma unroll
            for (int m = 0; m < 4; ++m) { const int row = row0 + ai * HALF + m * 16;
#pragma unroll
                for (int bj = 0; bj < 2; ++bj) { const int tok = col0 + bj * HALF, b = tok >> 11, c = (tok >> 6) & 31, s_ = tok & 63;
                    bf16_t* rp = Op + ((((size_t)(b * 4 + u.z) * 32 + c) * 256 + row) * 64 + s_);
                    f32x4 v0 = acc[ai][bj][m][0], v1 = acc[ai][bj][m][1]; u32x4 w;
                    if (wk) { const float* wp = wk + (size_t)(b * 4 + u.z) * T + (tok & (T - 1)); v0 = v0 * *(const f32x4*)wp; v1 = v1 * *(const f32x4*)(wp + 4); }
                    w.x = cvt_pk_bf16(v0[0], v0[1]); w.y = cvt_pk_bf16(v0[2], v0[3]); w.z = cvt_pk_bf16(v1[0], v1[1]); w.w = cvt_pk_bf16(v1[2], v1[3]);
                    *(u32x4*)rp = w; } }
    }
};
struct EpiPlain {
    bf16_t* Op; int ldc;
    __device__ __forceinline__ void operator()(const f32x4 (&acc)[2][2][4][2], const Unit& u, int wr, int wc, int fr, int fq) const {
        const int row0 = EPI_ROW0(u), col0 = EPI_COL0(u);
#pragma unroll
        for (int ai = 0; ai < 2; ++ai)
#pragma unroll
            for (int m = 0; m < 4; ++m) { const int row = row0 + ai * HALF + m * 16; bf16_t* rp = Op + (size_t)row * ldc + col0;
#pragma unroll
                for (int bj = 0; bj < 2; ++bj) { const f32x4 v0 = acc[ai][bj][m][0], v1 = acc[ai][bj][m][1]; u32x4 w;
                    w.x = cvt_pk_bf16(v0[0], v0[1]); w.y = cvt_pk_bf16(v0[2], v0[3]); w.z = cvt_pk_bf16(v1[0], v1[1]); w.w = cvt_pk_bf16(v1[2], v1[3]);
                    *(u32x4*)(rp + bj * HALF) = w; } }
    }
};
template <int MODE> struct EpiRes {
    const float* xp; const float* xs; const bf16_t* XI; bf16_t* XO; float* ss;
    __device__ __forceinline__ void operator()(const f32x4 (&acc)[2][2][4][2], const Unit& u, int wr, int wc, int fr, int fq) const {
        const int row0 = EPI_ROW0(u), col0 = EPI_COL0(u);
#pragma unroll
        for (int ai = 0; ai < 2; ++ai)
#pragma unroll
            for (int m = 0; m < 4; ++m) { const int row = row0 + ai * HALF + m * 16;
                float q = 0.f;
                if (row < MR) {
#pragma unroll
                    for (int bj = 0; bj < 2; ++bj) { const int c = col0 + bj * HALF;
                        f32x4 b0, b1;
                        if (MODE == 0) { const float* bp = row < MP ? xp + (size_t)row * D : xs + (size_t)(row - MP) * D; b0 = *(const f32x4*)(bp + c); b1 = *(const f32x4*)(bp + c + 4); }
                        else { const u32x4 w = *(const u32x4*)(XI + (size_t)row * D + c); b0 = (f32x4){bflo(w.x), bfhi(w.x), bflo(w.y), bfhi(w.y)}; b1 = (f32x4){bflo(w.z), bfhi(w.z), bflo(w.w), bfhi(w.w)}; }
                        const f32x4 v0 = acc[ai][bj][m][0] + b0, v1 = acc[ai][bj][m][1] + b1;
                        u32x4 w; w.x = cvt_pk_bf16(v0[0], v0[1]); w.y = cvt_pk_bf16(v0[2], v0[3]); w.z = cvt_pk_bf16(v1[0], v1[1]); w.w = cvt_pk_bf16(v1[2], v1[3]);
                        *(u32x4*)(XO + (size_t)row * D + c) = w;
                        q += (v0[0] * v0[0] + v0[1] * v0[1]) + (v0[2] * v0[2] + v0[3] * v0[3]) + (v1[0] * v1[0] + v1[1] * v1[1]) + (v1[2] * v1[2] + v1[3] * v1[3]); }
                }
                q += __shfl_xor(q, 16); q += __shfl_xor(q, 32);
                if (fq == 0 && row < MR) atomicAdd(ss + row, q);
            }
    }
};
struct EpiGU {
    bf16_t* Hp; const float* ss;
    __device__ __forceinline__ void operator()(const f32x4 (&acc)[2][2][4][2], const Unit& u, int wr, int wc, int fr, int fq) const {
        const int row0 = EPI_ROW0(u), col0 = u.pn * HALF + wc * 32 + 8 * fq;
#pragma unroll
        for (int ai = 0; ai < 2; ++ai)
#pragma unroll
            for (int m = 0; m < 4; ++m) { const int row = row0 + ai * HALF + m * 16; const float s = __builtin_amdgcn_rsqf(ss[row] * (1.f / D) + EPS);
                float o[8];
#pragma unroll
                for (int n = 0; n < 2; ++n)
#pragma unroll
                    for (int i = 0; i < 4; ++i) { const float gv = acc[ai][0][m][n][i] * s, uv = acc[ai][1][m][n][i] * s; o[n * 4 + i] = gv * sigmoidf_(gv) * uv; }
                u32x4 w; w.x = cvt_pk_bf16(o[0], o[1]); w.y = cvt_pk_bf16(o[2], o[3]); w.z = cvt_pk_bf16(o[4], o[5]); w.w = cvt_pk_bf16(o[6], o[7]);
                *(u32x4*)(Hp + (size_t)row * DFF + col0) = w; }
    }
};
struct EpiPle {
    const bf16_t* XI; bf16_t* XO; const bf16_t* PEp; const float* ss2; float* ss3;
    __device__ __forceinline__ void operator()(const f32x4 (&acc)[2][2][4][2], const Unit& u, int wr, int wc, int fr, int fq) const {
        const int row0 = EPI_ROW0(u), col0 = EPI_COL0(u);
#pragma unroll
        for (int ai = 0; ai < 2; ++ai)
#pragma unroll
            for (int m = 0; m < 4; ++m) { const int row = row0 + ai * HALF + m * 16;
                float q = 0.f;
                if (row < MR) {
                    const float s = __builtin_amdgcn_rsqf(ss2[row] * (1.f / D) + EPS);
#pragma unroll
                    for (int bj = 0; bj < 2; ++bj) { const int c = col0 + bj * HALF;
                        float xb[8], pe[8];
                        unpack8x(*(const u32x4*)(XI + (size_t)row * D + c), xb); unpack8x(*(const u32x4*)(PEp + (size_t)row * D + c), pe);
                        float v[8];
#pragma unroll
                        for (int i = 0; i < 4; ++i) { v[i] = xb[i] + sigmoidf_(acc[ai][bj][m][0][i] * s) * pe[i]; v[4 + i] = xb[4 + i] + sigmoidf_(acc[ai][bj][m][1][i] * s) * pe[4 + i]; }
                        u32x4 w; w.x = cvt_pk_bf16(v[0], v[1]); w.y = cvt_pk_bf16(v[2], v[3]); w.z = cvt_pk_bf16(v[4], v[5]); w.w = cvt_pk_bf16(v[6], v[7]);
                        *(u32x4*)(XO + (size_t)row * D + c) = w;
#pragma unroll
                        for (int i = 0; i < 8; ++i) q += v[i] * v[i]; }
                }
                q += __shfl_xor(q, 16); q += __shfl_xor(q, 32);
                if (fq == 0 && row < MR) atomicAdd(ss3 + row, q);
            }
    }
};
}

#define MFMA16(a, b, c) __builtin_amdgcn_mfma_f32_16x16x32_bf16((a), (b), (c), 0, 0, 0)
__device__ __forceinline__ float log_sigmoid_(float f) { return fminf(f, 0.f) - log1pf(__expf(-fabsf(f))); }
__device__ __forceinline__ void unpack8(const u32x4 w, float (&o)[8]) { o[0] = bflo(w.x); o[1] = bfhi(w.x); o[2] = bflo(w.y); o[3] = bfhi(w.y); o[4] = bflo(w.z); o[5] = bfhi(w.z); o[6] = bflo(w.w); o[7] = bfhi(w.w); }
__device__ __forceinline__ u32x4 pack8(const float (&o)[8]) { u32x4 w; w.x = pk2(o[0], o[1]); w.y = pk2(o[2], o[3]); w.z = pk2(o[4], o[5]); w.w = pk2(o[6], o[7]); return w; }

__device__ __forceinline__ void transpose_item(const float* W, int ldw, int col0, bf16_t* WT, int drow0, int ldt, const float* gk, float scal, LAS float* scr, int k0, int lane) {
    float wv[32];
#pragma unroll
    for (int i = 0; i < 32; ++i) { const int kk = 2 * i + (lane >> 5); wv[i] = W[(size_t)(k0 + kk) * ldw + col0 + (lane & 31)]; }
    const float g0 = gk ? gk[k0 + (lane >> 5) + 2 * (lane & 31)] : 1.f;
#pragma unroll
    for (int i = 0; i < 32; ++i) { const int kk = 2 * i + (lane >> 5); const float gg = __shfl(g0, (lane & 32) + i) * scal;
        scr[kk * 33 + (lane & 31)] = wv[i] * gg; }
    asm volatile("s_waitcnt lgkmcnt(0)" ::: "memory");
    const int c = lane & 7;
#pragma unroll
    for (int j = 0; j < 4; ++j) { const int n = (lane >> 3) + 8 * j; const LAS float* s = scr + (8 * c) * 33 + n;
        u32x4 o; o.x = pk2(s[0 * 33], s[1 * 33]); o.y = pk2(s[2 * 33], s[3 * 33]); o.z = pk2(s[4 * 33], s[5 * 33]); o.w = pk2(s[6 * 33], s[7 * 33]);
        *(u32x4*)(WT + (size_t)(drow0 + n) * ldt + k0 + 8 * c) = o; }
    asm volatile("s_waitcnt lgkmcnt(0)" ::: "memory");
}

__device__ __forceinline__ void p0_prologue(const Args& a, LAS unsigned char* lds, int G) {
    int tid = threadIdx.x; asm volatile("" : "+v"(tid)); const int lane = tid & 63, wave = tid >> 6;
    unsigned char* ws = a.ws + opq0();
    float* sm = (float*)(ws + WS_SMALL);
    const int gw = blockIdx.x * 8 + wave, NGW = G * 8;
    LAS float* scr = (LAS float*)(lds + wave * 16384);
    constexpr int I0 = 16 * 96, I1 = 16 * 64, I2 = 16 * 32, I3 = 16 * 88, I4 = I3, I5 = 44 * 32, I6 = 16 * 32, I7 = 4 * 32, I8 = 4 * 32, I9 = I8, I10 = I8, I11 = 8 * 8, I12 = I11;
    constexpr int NIT = I0 + I1 + I2 + I3 + I4 + I5 + I6 + I7 + I8 + I9 + I10 + I11 + I12;
    for (int it = gw; it < NIT; it += NGW) {
        int r = it;
        if (r < I0) { const int kb = r / 96, nb = r % 96; transpose_item(INP(11), NIN, nb * 32, (bf16_t*)(ws + WS_W1T), nb * 32, D, INP(10), 1.f, scr, kb * 64, lane); continue; } r -= I0;
        if (r < I1) { const int kb = r / 64, nb = r % 64; transpose_item(INP(11), NIN, 3080 + nb * 32, (bf16_t*)(ws + WS_W1T), 3072 + nb * 32, D, INP(10), 1.f, scr, kb * 64, lane); continue; } r -= I1;
        if (r < I2) { const int kb = r / 32, nb = r % 32; transpose_item(INP(26), D, nb * 32, (bf16_t*)(ws + WS_WOT), nb * 32, D, nullptr, 1.f, scr, kb * 64, lane); continue; } r -= I2;
        if (r < I3) { const int kb = r / 88, nb = r % 88, n0 = nb * 32; transpose_item(INP(28), DFF, n0, (bf16_t*)(ws + WS_WGUT), (n0 / 128) * 256 + (n0 % 128), D, INP(27), 1.f, scr, kb * 64, lane); continue; } r -= I3;
        if (r < I4) { const int kb = r / 88, nb = r % 88, n0 = nb * 32; transpose_item(INP(29), DFF, n0, (bf16_t*)(ws + WS_WGUT), (n0 / 128) * 256 + 128 + (n0 % 128), D, INP(27), 1.f, scr, kb * 64, lane); continue; } r -= I4;
        if (r < I5) { const int kb = r / 32, nb = r % 32; transpose_item(INP(30), D, nb * 32, (bf16_t*)(ws + WS_WDT), nb * 32, DFF, nullptr, 1.f, scr, kb * 64, lane); continue; } r -= I5;
        if (r < I6) { const int kb = r / 32, nb = r % 32; transpose_item(INP(32), D, nb * 32, (bf16_t*)(ws + WS_WPGT), nb * 32, D, INP(31), 1.f, scr, kb * 64, lane); continue; } r -= I6;
        if (r < I7) { const int kb = r / 32, nb = r % 32; transpose_item(INP(33), D, nb * 32, (bf16_t*)(ws + WS_WPT), nb * 32, PD, nullptr, 1.f, scr, kb * 64, lane); continue; } r -= I7;
        if (r < I8) { const int h = r / 32, q = r % 32, kb = q / 8, nb = q % 8; transpose_item(INP(22) + (size_t)h * 65536, HD, nb * 32, (bf16_t*)(ws + WS_WQKT) + (size_t)h * 512 * 256, nb * 32, HD, nullptr, 0.0625f, scr, kb * 64, lane); continue; } r -= I8;
        if (r < I9) { const int h = r / 32, q = r % 32, kb = q / 8, nb = q % 8; transpose_item(INP(23) + (size_t)h * 65536, HD, nb * 32, (bf16_t*)(ws + WS_WQKT) + (size_t)h * 512 * 256, 256 + nb * 32, HD, nullptr, 1.f, scr, kb * 64, lane); continue; } r -= I9;
        if (r < I10) { const int h = r / 32, q = r % 32, kb = q / 8, nb = q % 8; transpose_item(INP(24) + (size_t)h * 65536, HD, nb * 32, (bf16_t*)(ws + WS_WVT) + (size_t)h * 65536, nb * 32, HD, nullptr, 1.f, scr, kb * 64, lane); continue; } r -= I10;
        if (r < I11) { const int bl = r / 8, q = r % 8, kb = q / 4, nb = q % 4; transpose_item(INP(15) + (size_t)bl * 16384, 128, nb * 32, (bf16_t*)(ws + WS_WLRUT) + (size_t)bl * 256 * 128, nb * 32, 128, nullptr, 1.f, scr, kb * 64, lane); continue; } r -= I11;
        { const int bl = r / 8, q = r % 8, kb = q / 4, nb = q % 4; transpose_item(INP(17) + (size_t)bl * 16384, 128, nb * 32, (bf16_t*)(ws + WS_WLRUT) + (size_t)bl * 256 * 128, 128 + nb * 32, 128, nullptr, 1.f, scr, kb * 64, lane); }
    }
    __syncthreads();
    LAS float* gwL = (LAS float*)lds;
    for (int i = tid; i < 8192; i += NT) { const int j = i >> 10, k = i & 1023; gwL[i] = INP(10)[k] * INP(11)[(size_t)k * NIN + 3072 + j]; }
    __syncthreads();
    bf16_t* XB = (bf16_t*)(ws + WS_XB);
    {
        f32x4 v[4], vn[4];
        if (gw < MR) { const f32x4* xr = (const f32x4*)xrow_ptr(a, gw) + lane;
#pragma unroll
            for (int j = 0; j < 4; ++j) v[j] = xr[64 * j]; }
        for (int row = gw; row < M; row += NGW) {
            unsigned long long* o8 = (unsigned long long*)(XB + (size_t)row * D) + lane;
            const int rn = row + NGW;
            if (rn < MR) { const f32x4* xr = (const f32x4*)xrow_ptr(a, rn) + lane;
#pragma unroll
                for (int j = 0; j < 4; ++j) vn[j] = xr[64 * j]; }
            if (row >= MR) {
#pragma unroll
                for (int j = 0; j < 4; ++j) o8[64 * j] = 0ull;
                if (lane == 0) sm[SM_RSTD0 + row] = 0.f;
            } else {
                float s = 0.f;
#pragma unroll
                for (int j = 0; j < 4; ++j) s += (v[j].x * v[j].x + v[j].y * v[j].y) + (v[j].z * v[j].z + v[j].w * v[j].w);
                float dt[8];
#pragma unroll
                for (int jj = 0; jj < 8; ++jj) { float d = 0.f;
#pragma unroll
                    for (int j = 0; j < 4; ++j) { const f32x4 w = *(const LAS f32x4*)(gwL + jj * 1024 + j * 256 + lane * 4); d += (v[j].x * w.x + v[j].y * w.y) + (v[j].z * w.z + v[j].w * w.w); }
                    dt[jj] = wave_sum(d); }
                s = wave_sum(s);
                const float rstd = 1.0f / sqrtf(s * (1.f / D) + EPS);
#pragma unroll
                for (int j = 0; j < 4; ++j) o8[64 * j] = (unsigned long long)pk2(v[j].x, v[j].y) | ((unsigned long long)pk2(v[j].z, v[j].w) << 32);
                if (lane == 0) { sm[SM_RSTD0 + row] = rstd;
#pragma unroll
                    for (int jj = 0; jj < 4; ++jj) { sm[SM_GI + row * 4 + jj] = dt[jj] * rstd + INP(12)[jj]; sm[SM_GF + row * 4 + jj] = dt[4 + jj] * rstd + INP(12)[4 + jj]; } }
            }
#pragma unroll
            for (int j = 0; j < 4; ++j) v[j] = vn[j];
        }
    }
    const int gt = blockIdx.x * NT + tid, NGT = G * NT;
    bf16_t* PB = (bf16_t*)(ws + WS_PB);
    for (int i0 = gt; i0 < M * (PD / 4); i0 += 4 * NGT) { asm volatile("" : "+v"(i0));
        f32x4 pv[4];
#pragma unroll
        for (int q = 0; q < 4; ++q) { const int i = i0 + q * NGT, row = i >> 6, c4 = (i & 63) * 4; pv[q] = (f32x4){0.f, 0.f, 0.f, 0.f};
            if (row < MP) pv[q] = *(const f32x4*)(INP(8) + (size_t)row * PD + c4); else if (row < MR) pv[q] = *(const f32x4*)(INP(9) + (size_t)(row - MP) * PD + c4); }
#pragma unroll
        for (int q = 0; q < 4; ++q) { const int i = i0 + q * NGT, row = i >> 6, c4 = (i & 63) * 4;
            if (row < M) *(unsigned long long*)(PB + (size_t)row * PD + c4) = (unsigned long long)pk2(pv[q].x, pv[q].y) | ((unsigned long long)pk2(pv[q].z, pv[q].w) << 32); } }
    for (int i = gt; i < 3 * M; i += NGT) { sm[SM_SS1 + i] = 0.f; asm volatile("" : "+v"(i)); }
}

#define LBAR() do { asm volatile("s_waitcnt lgkmcnt(0)" ::: "memory"); __builtin_amdgcn_s_barrier(); asm volatile("" ::: "memory"); } while (0)
__device__ __forceinline__ void p2a_item(const Args& a, LAS unsigned char* lds, int idx) {
    int tid = threadIdx.x; asm volatile("" : "+v"(tid)); const int lane = tid & 63, wave = tid >> 6;
    unsigned char* ws = a.ws + opq0(); float* sm = (float*)(ws + WS_SMALL);
    const bf16_t* Z = (const bf16_t*)(ws + WS_Z); bf16_t* XC = (bf16_t*)(ws + WS_XC);
    if (idx >= 2048) {
        const int sb = idx - 2048, row = MP + sb;
#pragma unroll
        for (int cc = 0; cc < 2; ++cc) { const int ch = tid * 2 + cc;
            { const float s0 = INP(2)[((size_t)sb * 3 + 0) * D + ch], s1 = INP(2)[((size_t)sb * 3 + 1) * D + ch], s2 = INP(2)[((size_t)sb * 3 + 2) * D + ch], xv = bf2f(Z[(size_t)row * NZ + ch]);
              const float o = INP(14)[ch] + INP(13)[ch] * s0 + INP(13)[D + ch] * s1 + INP(13)[2 * D + ch] * s2 + INP(13)[3 * D + ch] * xv;
              sm[SM_XLS + sb * D + ch] = o;
              a.out[O_SLC + ((size_t)sb * 3 + 0) * D + ch] = s1; a.out[O_SLC + ((size_t)sb * 3 + 1) * D + ch] = s2; a.out[O_SLC + ((size_t)sb * 3 + 2) * D + ch] = xv; }
            { const float s0 = INP(4)[((size_t)sb * 3 + 0) * D + ch], s1 = INP(4)[((size_t)sb * 3 + 1) * D + ch], s2 = INP(4)[((size_t)sb * 3 + 2) * D + ch], xv = bf2f(Z[(size_t)row * NZ + 1024 + ch]);
              const float o = INP(21)[ch] + INP(20)[ch] * s0 + INP(20)[D + ch] * s1 + INP(20)[2 * D + ch] * s2 + INP(20)[3 * D + ch] * xv;
              XC[(size_t)row * D + ch] = (bf16_t)f2bf(o * sigmoidf_(o));
              a.out[O_SMC + ((size_t)sb * 3 + 0) * D + ch] = s1; a.out[O_SMC + ((size_t)sb * 3 + 1) * D + ch] = s2; a.out[O_SMC + ((size_t)sb * 3 + 2) * D + ch] = xv; }
        }
        return;
    }
    const int cb = idx & 7, tt = (idx >> 3) & 31, b = idx >> 8;
    LAS bf16_t* AL = (LAS bf16_t*)lds;
    LAS float* U = (LAS float*)(lds + 17408);
    LAS float* AA = (LAS float*)(lds + 17408 + 32768);
    const int t0 = tt * 64, tokb = b * T;
    {
        const int c8 = tid & 15, rs = tid >> 4, chl = cb * 128 + c8 * 8;
        float wl[4][8], wm[4][8], bl[8], bm[8];
#pragma unroll
        for (int j = 0; j < 4; ++j)
#pragma unroll
            for (int i = 0; i < 8; ++i) { wl[j][i] = INP(13)[j * D + chl + i]; wm[j][i] = INP(20)[j * D + chl + i]; }
#pragma unroll
        for (int i = 0; i < 8; ++i) { bl[i] = INP(14)[chl + i]; bm[i] = INP(21)[chl + i]; }
#pragma unroll
        for (int rr = 0; rr < 2; ++rr) { const int tl = rs + 32 * rr, tg = t0 + tl;
            float ol[8], om[8], xl3[8], xm3[8];
#pragma unroll
            for (int i = 0; i < 8; ++i) { ol[i] = bl[i]; om[i] = bm[i]; xl3[i] = 0.f; xm3[i] = 0.f; }
#pragma unroll
            for (int j = 0; j < 4; ++j) { const int ts = tg - 3 + j;
                if (ts >= 0) { float xl[8], xm[8];
                    unpack8(*(const u32x4*)(Z + (size_t)(tokb + ts) * NZ + chl), xl); unpack8(*(const u32x4*)(Z + (size_t)(tokb + ts) * NZ + 1024 + chl), xm);
#pragma unroll
                    for (int i = 0; i < 8; ++i) { ol[i] += wl[j][i] * xl[i]; om[i] += wm[j][i] * xm[i]; if (j == 3) { xl3[i] = xl[i]; xm3[i] = xm[i]; } } } }
            *(LAS u32x4*)(AL + tl * 136 + c8 * 8) = pack8(ol);
            *(LAS f32x4*)(U + tl * 128 + c8 * 8) = (f32x4){ol[0], ol[1], ol[2], ol[3]}; *(LAS f32x4*)(U + tl * 128 + c8 * 8 + 4) = (f32x4){ol[4], ol[5], ol[6], ol[7]};
            float xs[8];
#pragma unroll
            for (int i = 0; i < 8; ++i) xs[i] = om[i] * sigmoidf_(om[i]);
            *(u32x4*)(XC + (size_t)(tokb + tg) * D + chl) = pack8(xs);
            if (tg >= T - 3) { const int j3 = tg - (T - 3);
#pragma unroll
                for (int i = 0; i < 8; ++i) { a.out[O_PLC + ((size_t)b * 3 + j3) * D + chl + i] = xl3[i]; a.out[O_PMC + ((size_t)b * 3 + j3) * D + chl + i] = xm3[i]; } }
        }
    }
    __syncthreads();
    {
        const int fr = lane & 15, fq = lane >> 4;
        const bf16_t* Wl = (const bf16_t*)(ws + WS_WLRUT) + (size_t)cb * 256 * 128;
        f32x4 ar[4], ai[4];
#pragma unroll
        for (int m = 0; m < 4; ++m) { ar[m] = (f32x4){0.f, 0.f, 0.f, 0.f}; ai[m] = (f32x4){0.f, 0.f, 0.f, 0.f}; }
#pragma unroll
        for (int ks = 0; ks < 4; ++ks) {
            const bf16x8 br = *(const bf16x8*)(Wl + (size_t)(16 * wave + fr) * 128 + ks * 32 + fq * 8);
            const bf16x8 bi = *(const bf16x8*)(Wl + (size_t)(128 + 16 * wave + fr) * 128 + ks * 32 + fq * 8);
#pragma unroll
            for (int m = 0; m < 4; ++m) { const bf16x8 af = *(const LAS bf16x8*)(AL + (m * 16 + fr) * 136 + ks * 32 + fq * 8);
                ar[m] = MFMA16(af, br, ar[m]); ai[m] = MFMA16(af, bi, ai[m]); }
        }
        const int c = 16 * wave + fr, ch = cb * 128 + c;
        const float ba = INP(16)[ch], bx = INP(18)[ch], lam = INP(19)[ch];
        const float sp = fmaxf(-lam, 0.f) + log1pf(__expf(-fabsf(lam)));
#pragma unroll
        for (int m = 0; m < 4; ++m)
#pragma unroll
            for (int j = 0; j < 4; ++j) { const int t = m * 16 + fq * 4 + j;
                const float r = sigmoidf_(ar[m][j] + ba), ig = sigmoidf_(ai[m][j] + bx);
                const float la = -8.0f * r * sp, av = fexp_(la);
                const float uv = __builtin_amdgcn_sqrtf(fmaxf(1.f - av * av, 0.f)) * ig * U[t * 128 + c];
                AA[t * 128 + c] = av; U[t * 128 + c] = uv; }
    }
    __syncthreads();
    {
        const int c = tid & 127, seg = tid >> 7;
        float h = 0.f, P = 1.f;
#pragma unroll
        for (int i = 0; i < 16; ++i) { const int t = seg * 16 + i; const float av = AA[t * 128 + c], uv = U[t * 128 + c]; h = av * h + uv; P *= av; U[t * 128 + c] = h; AA[t * 128 + c] = P; }
        __syncthreads();
        float hc = 0.f, pc = 1.f;
        for (int s = 0; s < seg; ++s) { const int te = s * 16 + 15; const float pe = AA[te * 128 + c]; hc = pe * hc + U[te * 128 + c]; pc *= pe; }
        __syncthreads();
        if (seg > 0) {
#pragma unroll
            for (int i = 0; i < 16; ++i) { const int t = seg * 16 + i; const float pv = AA[t * 128 + c]; U[t * 128 + c] += pv * hc; AA[t * 128 + c] = pv * pc; }
        }
    }
    __syncthreads();
    {
        const int c8 = tid & 15, rs = tid >> 4, chl = cb * 128 + c8 * 8;
        bf16_t* HL = (bf16_t*)(ws + WS_HLOC); bf16_t* CA = (bf16_t*)(ws + WS_CUMA);
#pragma unroll
        for (int rr = 0; rr < 2; ++rr) { const int tl = rs + 32 * rr; float hv[8], cv[8];
#pragma unroll
            for (int i = 0; i < 8; ++i) { hv[i] = U[tl * 128 + c8 * 8 + i]; cv[i] = AA[tl * 128 + c8 * 8 + i]; }
            *(u32x4*)(HL + (size_t)(tokb + t0 + tl) * D + chl) = pack8(hv); *(u32x4*)(CA + (size_t)(tokb + t0 + tl) * D + chl) = pack8(cv); }
        if (tid < 128) { sm[SM_LRA + (b * 32 + tt) * D + cb * 128 + tid] = AA[63 * 128 + tid]; sm[SM_LRH + (b * 32 + tt) * D + cb * 128 + tid] = U[63 * 128 + tid]; }
    }
    __syncthreads();
}

__device__ __forceinline__ void p2_zload(const bf16_t* Z, int idx, int tid, u32x4 (&zr)[5]) {
    const int cb = idx & 7, tt = (idx >> 3) & 31, b = idx >> 8, t0 = tt * 64, tokb = b * T;
#pragma unroll
    for (int q = 0; q < 5; ++q) { const int p = tid + NT * q, r = p >> 5, pp = p & 31, ts = t0 - 3 + r;
        zr[q] = (u32x4){0u, 0u, 0u, 0u};
        if (r < 67 && ts >= 0) zr[q] = *(const u32x4*)(Z + (size_t)(tokb + ts) * NZ + (pp >> 4) * 1024 + cb * 128 + (pp & 15) * 8); }
}
__device__ __forceinline__ void p2_phase(const Args& a, LAS unsigned char* lds, int G) {
    int tid = threadIdx.x; asm volatile("" : "+v"(tid)); const int lane = tid & 63, wave = tid >> 6, fr = lane & 15, fq = lane >> 4;
    unsigned char* ws = a.ws + opq0(); float* sm = (float*)(ws + WS_SMALL);
    const bf16_t* Z = (const bf16_t*)(ws + WS_Z); bf16_t* XC = (bf16_t*)(ws + WS_XC);
    LAS bf16_t* AL = (LAS bf16_t*)lds;
    LAS float* U = (LAS float*)(lds + 17408);
    LAS float* AA = (LAS float*)(lds + 17408 + 32768);
    LAS bf16_t* ZT = (LAS bf16_t*)(lds + 82944);
    LAS float* CW = (LAS float*)(lds + 117248);
    int idx = blockIdx.x;
    if (idx >= 2048) return;
    u32x4 zr[5];
    p2_zload(Z, idx, tid, zr);
    int cb_prev = -1;
    bf16x8 br[4], bi[4]; float ba = 0.f, bx = 0.f, sp = 0.f;
    for (; idx < 2048; idx += G) {
        const int cb = idx & 7, tt = (idx >> 3) & 31, b = idx >> 8, t0 = tt * 64, tokb = b * T;
#pragma unroll
        for (int q = 0; q < 5; ++q) { const int p = tid + NT * q, r = p >> 5, pp = p & 31; if (r < 67) *(LAS u32x4*)(ZT + ((pp >> 4) * 67 + r) * 128 + (pp & 15) * 8) = zr[q]; }
        if (cb != cb_prev) {
            for (int i = tid; i < 2 * 5 * 128; i += NT) { const int which = i / 640, j = (i % 640) >> 7, c = i & 127, ch = cb * 128 + c;
                CW[i] = which == 0 ? (j < 4 ? INP(13)[j * D + ch] : INP(14)[ch]) : (j < 4 ? INP(20)[j * D + ch] : INP(21)[ch]); }
            const bf16_t* Wl = (const bf16_t*)(ws + WS_WLRUT) + (size_t)cb * 256 * 128;
#pragma unroll
            for (int ks = 0; ks < 4; ++ks) { br[ks] = *(const bf16x8*)(Wl + (size_t)(16 * wave + fr) * 128 + ks * 32 + fq * 8); bi[ks] = *(const bf16x8*)(Wl + (size_t)(128 + 16 * wave + fr) * 128 + ks * 32 + fq * 8); }
            const int ch = cb * 128 + 16 * wave + fr; const float lam = INP(19)[ch];
            ba = INP(16)[ch]; bx = INP(18)[ch]; sp = fmaxf(-lam, 0.f) + log1pf(__expf(-fabsf(lam)));
            cb_prev = cb;
        }
        if (idx + G < 2048) p2_zload(Z, idx + G, tid, zr);
        LBAR();
        {
            const int c8 = tid & 15, rs = tid >> 4, chl = cb * 128 + c8 * 8;
#pragma unroll
            for (int rr = 0; rr < 2; ++rr) { const int tl = rs + 32 * rr, tg = t0 + tl;
                float ol[8], om[8], xl3[8], xm3[8];
#pragma unroll
                for (int i = 0; i < 8; ++i) { ol[i] = CW[4 * 128 + c8 * 8 + i]; om[i] = CW[640 + 4 * 128 + c8 * 8 + i]; }
#pragma unroll
                for (int j = 0; j < 4; ++j) { float xl[8], xm[8];
                    unpack8(*(const LAS u32x4*)(ZT + (tl + j) * 128 + c8 * 8), xl); unpack8(*(const LAS u32x4*)(ZT + (67 + tl + j) * 128 + c8 * 8), xm);
#pragma unroll
                    for (int i = 0; i < 8; ++i) { ol[i] += CW[j * 128 + c8 * 8 + i] * xl[i]; om[i] += CW[640 + j * 128 + c8 * 8 + i] * xm[i]; if (j == 3) { xl3[i] = xl[i]; xm3[i] = xm[i]; } } }
                *(LAS u32x4*)(AL + tl * 136 + c8 * 8) = pack8(ol);
                *(LAS f32x4*)(U + tl * 128 + c8 * 8) = (f32x4){ol[0], ol[1], ol[2], ol[3]}; *(LAS f32x4*)(U + tl * 128 + c8 * 8 + 4) = (f32x4){ol[4], ol[5], ol[6], ol[7]};
                float xs[8];
#pragma unroll
                for (int i = 0; i < 8; ++i) xs[i] = om[i] * sigmoidf_(om[i]);
                *(u32x4*)(XC + (size_t)(tokb + tg) * D + chl) = pack8(xs);
                if (tg >= T - 3) { const int j3 = tg - (T - 3);
#pragma unroll
                    for (int i = 0; i < 8; ++i) { a.out[O_PLC + ((size_t)b * 3 + j3) * D + chl + i] = xl3[i]; a.out[O_PMC + ((size_t)b * 3 + j3) * D + chl + i] = xm3[i]; } }
            }
        }
        LBAR();
        {
            f32x4 ar[4], ai[4];
#pragma unroll
            for (int m = 0; m < 4; ++m) { ar[m] = (f32x4){0.f, 0.f, 0.f, 0.f}; ai[m] = (f32x4){0.f, 0.f, 0.f, 0.f}; }
#pragma unroll
            for (int ks = 0; ks < 4; ++ks)
#pragma unroll
                for (int m = 0; m < 4; ++m) { const bf16x8 af = *(const LAS bf16x8*)(AL + (m * 16 + fr) * 136 + ks * 32 + fq * 8);
                    ar[m] = MFMA16(af, br[ks], ar[m]); ai[m] = MFMA16(af, bi[ks], ai[m]); }
            const int c = 16 * wave + fr;
#pragma unroll
            for (int m = 0; m < 4; ++m)
#pragma unroll
                for (int j = 0; j < 4; ++j) { const int t = m * 16 + fq * 4 + j;
                    const float r = sigmoidf_(ar[m][j] + ba), ig = sigmoidf_(ai[m][j] + bx);
                    const float la = -8.0f * r * sp, av = fexp_(la);
                    const float uv = __builtin_amdgcn_sqrtf(fmaxf(1.f - av * av, 0.f)) * ig * U[t * 128 + c];
                    AA[t * 128 + c] = av; U[t * 128 + c] = uv; }
        }
        LBAR();
        {
            const int c = tid & 127, seg = tid >> 7;
            float h = 0.f, P = 1.f;
#pragma unroll
            for (int i = 0; i < 16; ++i) { const int t = seg * 16 + i; const float av = AA[t * 128 + c], uv = U[t * 128 + c]; h = av * h + uv; P *= av; U[t * 128 + c] = h; AA[t * 128 + c] = P; }
            LBAR();
            float hc = 0.f, pc = 1.f;
            for (int s2 = 0; s2 < seg; ++s2) { const int te = s2 * 16 + 15; const float pe = AA[te * 128 + c]; hc = pe * hc + U[te * 128 + c]; pc *= pe; }
            LBAR();
            if (seg > 0) {
#pragma unroll
                for (int i = 0; i < 16; ++i) { const int t = seg * 16 + i; const float pv = AA[t * 128 + c]; U[t * 128 + c] += pv * hc; AA[t * 128 + c] = pv * pc; }
            }
        }
        LBAR();
        {
            const int c8 = tid & 15, rs = tid >> 4, chl = cb * 128 + c8 * 8;
            bf16_t* HL = (bf16_t*)(ws + WS_HLOC); bf16_t* CA = (bf16_t*)(ws + WS_CUMA);
#pragma unroll
            for (int rr = 0; rr < 2; ++rr) { const int tl = rs + 32 * rr; float hv[8], cv[8];
#pragma unroll
                for (int i = 0; i < 8; ++i) { hv[i] = U[tl * 128 + c8 * 8 + i]; cv[i] = AA[tl * 128 + c8 * 8 + i]; }
                *(u32x4*)(HL + (size_t)(tokb + t0 + tl) * D + chl) = pack8(hv); *(u32x4*)(CA + (size_t)(tokb + t0 + tl) * D + chl) = pack8(cv); }
            if (tid < 128) { sm[SM_LRA + (b * 32 + tt) * D + cb * 128 + tid] = AA[63 * 128 + tid]; sm[SM_LRH + (b * 32 + tt) * D + cb * 128 + tid] = U[63 * 128 + tid]; }
        }
        LBAR();
    }
}

__device__ __forceinline__ float block_excl_sum(float v, LAS float* red, int tid) {
    const int lane = tid & 63, wave = tid >> 6; float inc = v;
#pragma unroll
    for (int o = 1; o < 64; o <<= 1) { const float t = __shfl_up(inc, o); if (lane >= o) inc += t; }
    __syncthreads();
    if (lane == 63) red[wave] = inc;
    __syncthreads();
    float base = 0.f;
    for (int w = 0; w < wave; ++w) base += red[w];
    return base + inc - v;
}
__device__ __forceinline__ float block_excl_max(float v, LAS float* red, int tid) {
    const int lane = tid & 63, wave = tid >> 6; float inc = v;
#pragma unroll
    for (int o = 1; o < 64; o <<= 1) { const float t = __shfl_up(inc, o); if (lane >= o) inc = fmaxf(inc, t); }
    __syncthreads();
    if (lane == 63) red[wave] = inc;
    __syncthreads();
    float base = -INFINITY;
    for (int w = 0; w < wave; ++w) base = fmaxf(base, red[w]);
    const float prev = __shfl_up(inc, 1);
    return fmaxf(base, lane > 0 ? prev : -INFINITY);
}
__device__ __forceinline__ void gate_scan(const Args& a, LAS unsigned char* lds, int bh) {
    int tid = threadIdx.x; asm volatile("" : "+v"(tid)); float* sm = (float*)(a.ws + WS_SMALL);
    LAS float* BCl = (LAS float*)lds; LAS float* MMl = BCl + T; LAS float* red = MMl + T;
    const int b = bh >> 2, h = bh & 3;
    float lf[4], ig[4], bc[4], gv[4], pmx[4];
#pragma unroll
    for (int i = 0; i < 4; ++i) { const int row = b * T + tid * 4 + i; lf[i] = log_sigmoid_(sm[SM_GF + row * 4 + h]); ig[i] = sm[SM_GI + row * 4 + h]; }
    const float tot = (lf[0] + lf[1]) + (lf[2] + lf[3]);
    const float ex = block_excl_sum(tot, red, tid);
    float run = ex;
#pragma unroll
    for (int i = 0; i < 4; ++i) { run += lf[i]; bc[i] = run; gv[i] = ig[i] - run; }
    const float lm = fmaxf(fmaxf(gv[0], gv[1]), fmaxf(gv[2], gv[3]));
    const float exm = block_excl_max(lm, red, tid);
    float rm = exm;
#pragma unroll
    for (int i = 0; i < 4; ++i) { rm = fmaxf(rm, gv[i]); pmx[i] = rm; BCl[tid * 4 + i] = bc[i]; MMl[tid * 4 + i] = bc[i] + rm; }
    __syncthreads();
#pragma unroll
    for (int i = 0; i < 4; ++i) { const int t = tid * 4 + i, c = t >> 6;
        const float Bprev = c ? BCl[64 * c - 1] : 0.f, mprev = c ? MMl[64 * c - 1] : M_INIT, Blast = BCl[64 * c + 63], mlast = MMl[64 * c + 63];
        const float mm = bc[i] + pmx[i];
        sm[SM_BM + bh * T + t] = -pmx[i]; sm[SM_GIB + bh * T + t] = gv[i]; sm[SM_MM + bh * T + t] = mm;
        sm[SM_SC + bh * T + t] = __expf(bc[i] - Bprev + mprev - mm);
        sm[SM_WK + bh * T + t] = __expf(Blast - bc[i] + ig[i] - mlast);
        if ((t & 63) == 0) sm[SM_DEC + bh * 32 + c] = __expf(Blast - Bprev + mprev - mlast);
        if (t == T - 1) a.out[O_PM + bh] = mm; }
    __syncthreads();
}

struct P3Ops { bf16x8 vf[2][2]; bf16x8 kf[2][2]; float sc, dec; };
__device__ __forceinline__ void p3_load(P3Ops& o, const bf16_t* Q, const bf16_t* KT, const bf16_t* VT, const float* sm, int b, int h, int bh, int es, int c, int wave, int fr, int fq) {
    const int tok0 = b * T + c * 64, gb = bh * T + c * 64, mt = wave >> 1;
#pragma unroll
    for (int ks = 0; ks < 2; ++ks) {
#pragma unroll
        for (int e = 0; e < 2; ++e) o.vf[ks][e] = *(const bf16x8*)(VT + ((size_t)(bh * 32 + c) * 256 + es * 32 + e * 16 + fr) * 64 + ks * 32 + fq * 8);
#pragma unroll
        for (int d = 0; d < 2; ++d) o.kf[ks][d] = *(const bf16x8*)(KT + ((size_t)(bh * 32 + c) * 256 + 32 * wave + d * 16 + fr) * 64 + ks * 32 + fq * 8);
    }
    o.sc = sm[SM_SC + gb + mt * 16 + fr]; o.dec = sm[SM_DEC + bh * 32 + c];
}
__device__ __forceinline__ void p3_item(const Args& a, LAS unsigned char* lds, int idx) {
    int tid = threadIdx.x; asm volatile("" : "+v"(tid)); const int lane = tid & 63, wave = tid >> 6, fr = lane & 15, fq = lane >> 4;
    unsigned char* ws = a.ws + opq0(); float* sm = (float*)(ws + WS_SMALL);
    const int es = idx & 7, bh = idx >> 3, b = bh >> 2, h = bh & 3;
    const bf16_t* Q = (const bf16_t*)(ws + WS_Q); const bf16_t* KT = (const bf16_t*)(ws + WS_KT); const bf16_t* VT = (const bf16_t*)(ws + WS_VT);
    bf16_t* NUMI = (bf16_t*)(ws + WS_XC);
    const int ii = tid >> 8, q_ = tid & 255, sit = idx * 2 + ii, ssb = sit >> 2, shh = sit & 3, srow = MP + ssb, ssh = ssb * 4 + shh;
    LAS float* SQ = (LAS float*)(lds + 34816) + ii * 256; LAS float* SK = (LAS float*)(lds + 36864) + ii * 256; LAS float* SV = (LAS float*)(lds + 38912) + ii * 256;
    LAS float* SRED = (LAS float*)(lds + 40960) + ii * 1024; LAS float* SR2 = (LAS float*)(lds + 49152) + ii * 16;
    SQ[q_] = bf2f(Q[((size_t)shh * M + srow) * 256 + q_]); SK[q_] = bf2f(((const bf16_t*)(ws + WS_K))[((size_t)shh * M + srow) * 256 + q_]); SV[q_] = bf2f(((const bf16_t*)(ws + WS_VS))[(size_t)ssb * D + shh * 256 + q_]);
    const float s_lf = log_sigmoid_(sm[SM_GF + srow * 4 + shh]), s_ig = sm[SM_GI + srow * 4 + shh], s_m0 = INP(7)[ssh];
    const float s_mn = fmaxf(s_lf + s_m0, s_ig), s_dec = fexp_(s_lf + s_m0 - s_mn), s_wkk = fexp_(s_ig - s_mn);
    const int s_r = q_ >> 6, s_e4 = (q_ & 63) * 4;
    const float* sC0 = INP(5) + (size_t)ssh * 65536 + s_e4; float* sC1 = a.out + O_SC + (size_t)ssh * 65536 + s_e4;
    f32x4 sacc = (f32x4){0.f, 0.f, 0.f, 0.f};
    const int s_ch = shh * 256 + q_;
    LAS float* SXL = (LAS float*)(lds + 49280) + ii * 256;
    SXL[q_] = sm[SM_XLS + ssb * D + s_ch];
    const float* wa = INP(15) + (size_t)(s_ch >> 7) * 16384 + (s_ch & 127); const float* wx = INP(17) + (size_t)(s_ch >> 7) * 16384 + (s_ch & 127);
    float s_rp = INP(16)[s_ch], s_ip = INP(18)[s_ch];
    f32x4 acc[2][2], accn[2];
#pragma unroll
    for (int e = 0; e < 2; ++e)
#pragma unroll
        for (int d = 0; d < 2; ++d) acc[e][d] = (f32x4){0.f, 0.f, 0.f, 0.f};
    accn[0] = (f32x4){0.f, 0.f, 0.f, 0.f}; accn[1] = (f32x4){0.f, 0.f, 0.f, 0.f};
    bf16x8 ones_f; { const short o1 = fr == 0 ? (short)0x3F80 : (short)0; ones_f = (bf16x8){o1, o1, o1, o1, o1, o1, o1, o1}; }
    P3Ops cur, nxt;
    p3_load(cur, Q, KT, VT, sm, b, h, bh, es, 0, wave, fr, fq);
    bf16x8 qf[8];
#pragma unroll
    for (int ks = 0; ks < 8; ++ks) qf[ks] = *(const bf16x8*)(Q + ((size_t)h * M + b * T + 64 + (wave >> 1) * 16 + fr) * 256 + ks * 32 + fq * 8);
    __syncthreads();
    const f32x4 s_v4 = *(const LAS f32x4*)(SV + s_e4);
    for (int c = 0; c < NCH; ++c) {
        const int tok0 = b * T + c * 64;
        LAS bf16_t* CTr = (LAS bf16_t*)(lds + (c & 1) * 16896);
        LAS bf16_t* CTw = (LAS bf16_t*)(lds + ((c + 1) & 1) * 16896);
        p3_load(nxt, Q, KT, VT, sm, b, h, bh, es, c + 1 < NCH ? c + 1 : c, wave, fr, fq);
        const int sd0 = c * 8 + s_r, sd1 = sd0 + 4;
        const f32x4 sc0 = *(const f32x4*)(sC0 + (size_t)sd0 * 256), sc1 = *(const f32x4*)(sC0 + (size_t)sd1 * 256);
        float wa4[4], wx4[4];
#pragma unroll
        for (int k = 0; k < 4; ++k) { wa4[k] = wa[(c * 4 + k) * 128]; wx4[k] = wx[(c * 4 + k) * 128]; }
        if (c > 0) {
            const int mt = wave >> 1, et = wave & 1;
            f32x4 ai = (f32x4){0.f, 0.f, 0.f, 0.f};
#pragma unroll
            for (int ks = 0; ks < 8; ++ks) { const bf16x8 cf = *(const LAS bf16x8*)(CTr + (et * 16 + fr) * 264 + ks * 32 + fq * 8); ai = MFMA16(cf, qf[ks], ai); }
            u32x2 w; w.x = pk2(ai[0] * cur.sc, ai[1] * cur.sc); w.y = pk2(ai[2] * cur.sc, ai[3] * cur.sc);
            *(u32x2*)(NUMI + (size_t)(tok0 + mt * 16 + fr) * D + h * 256 + es * 32 + et * 16 + fq * 4) = w;
            const int cq = c + 1 < NCH ? c + 1 : c;
#pragma unroll
            for (int ks = 0; ks < 8; ++ks) qf[ks] = *(const bf16x8*)(Q + ((size_t)h * M + b * T + cq * 64 + mt * 16 + fr) * 256 + ks * 32 + fq * 8);
        }
        if (es == 0 && fq == 0) { sm[SM_NST + (bh * 32 + c) * 256 + 32 * wave + fr] = accn[0][0]; sm[SM_NST + (bh * 32 + c) * 256 + 32 * wave + 16 + fr] = accn[1][0]; }
        const float dec = cur.dec;
#pragma unroll
        for (int e = 0; e < 2; ++e)
#pragma unroll
            for (int d = 0; d < 2; ++d) acc[e][d] = acc[e][d] * dec;
        accn[0] = accn[0] * dec; accn[1] = accn[1] * dec;
#pragma unroll
        for (int ks = 0; ks < 2; ++ks) {
#pragma unroll
            for (int e = 0; e < 2; ++e)
#pragma unroll
                for (int d = 0; d < 2; ++d) acc[e][d] = MFMA16(cur.vf[ks][e], cur.kf[ks][d], acc[e][d]);
            if (es == 0) { accn[0] = MFMA16(ones_f, cur.kf[ks][0], accn[0]); accn[1] = MFMA16(ones_f, cur.kf[ks][1], accn[1]); }
        }
#pragma unroll
        for (int e = 0; e < 2; ++e)
#pragma unroll
            for (int d = 0; d < 2; ++d)
#pragma unroll
                for (int j = 0; j < 4; ++j) CTw[(e * 16 + fq * 4 + j) * 264 + 32 * wave + d * 16 + fr] = (bf16_t)f2bf(acc[e][d][j]);
        {
            const float k0 = SK[sd0] * s_wkk, k1 = SK[sd1] * s_wkk, q0 = SQ[sd0], q1 = SQ[sd1];
            const f32x4 cn0 = sc0 * s_dec + s_v4 * k0, cn1 = sc1 * s_dec + s_v4 * k1;
            *(f32x4*)(sC1 + (size_t)sd0 * 256) = cn0; *(f32x4*)(sC1 + (size_t)sd1 * 256) = cn1;
            sacc += cn0 * q0 + cn1 * q1;
#pragma unroll
            for (int k = 0; k < 4; ++k) { const float xv = SXL[(q_ >> 7) * 128 + c * 4 + k]; s_rp += xv * wa4[k]; s_ip += xv * wx4[k]; }
        }
        LBAR();
        cur = nxt;
    }
#pragma unroll
    for (int e = 0; e < 2; ++e)
#pragma unroll
        for (int d = 0; d < 2; ++d) *(f32x4*)(a.out + O_PC + ((size_t)bh * 256 + 32 * wave + d * 16 + fr) * 256 + es * 32 + e * 16 + fq * 4) = acc[e][d];
    if (es == 0 && fq == 0) { a.out[O_PN + bh * 256 + 32 * wave + fr] = accn[0][0]; a.out[O_PN + bh * 256 + 32 * wave + 16 + fr] = accn[1][0]; }
    *(LAS f32x4*)(SRED + s_r * 256 + s_e4) = sacc;
    const float nn = s_dec * INP(6)[ssh * 256 + q_] + s_wkk * SK[q_];
    a.out[O_SN + ssh * 256 + q_] = nn;
    const float dn = wave_sum(SQ[q_] * nn);
    if (lane == 0) SR2[wave & 3] = dn;
    __syncthreads();
    const float den = (SR2[0] + SR2[1]) + (SR2[2] + SR2[3]);
    const float num = (SRED[q_] + SRED[256 + q_]) + (SRED[512 + q_] + SRED[768 + q_]);
    const float hv = num / fmaxf(fabsf(den), fexp_(-s_mn));
    const float hq = wave_sum(hv * hv);
    if (lane == 0) SR2[4 + (wave & 3)] = hq;
    __syncthreads();
    {
        const float rs = 1.0f / sqrtf(((SR2[4] + SR2[5]) + (SR2[6] + SR2[7])) * (1.f / 256.f) + EPS);
        const bf16_t* Z = (const bf16_t*)(ws + WS_Z);
        const int ch = s_ch;
        const float ym = hv * rs * INP(25)[ch] * sigmoidf_(bf2f(Z[(size_t)srow * NZ + 2048 + ch]));
        const float rp = s_rp, ip = s_ip;
        const float lam = INP(19)[ch], sp = fmaxf(-lam, 0.f) + log1pf(__expf(-fabsf(lam)));
        const float r = sigmoidf_(rp), ig = sigmoidf_(ip), la = -8.0f * r * sp, av = fexp_(la);
        const float uv = __builtin_amdgcn_sqrtf(fmaxf(1.f - av * av, 0.f)) * ig * SXL[q_];
        const float hn = av * INP(3)[ssb * D + ch] + uv;
        a.out[O_SLH + ssb * D + ch] = hn;
        const float mg = sigmoidf_(bf2f(Z[(size_t)srow * NZ + 3072 + ch])) * hn + sigmoidf_(bf2f(Z[(size_t)srow * NZ + 4096 + ch])) * ym;
        ((bf16_t*)(ws + WS_XB))[(size_t)srow * D + ch] = (bf16_t)f2bf(mg);
        if (q_ == 0) a.out[O_SM + ssh] = s_mn;
    }
    __syncthreads();
}
__device__ __forceinline__ void carry_scan(const Args& a, int G) {
    int tid = threadIdx.x; asm volatile("" : "+v"(tid));
    float* sm = (float*)(a.ws + opq0() + WS_SMALL);
    const int per = (NB * D + G - 1) / G;
    if (tid < per) { const int i = blockIdx.x * per + tid;
        if (i < NB * D) { const int b = i >> 10, ch = i & 1023; float la[NCH], lh[NCH];
#pragma unroll
            for (int j = 0; j < NCH; ++j) { la[j] = sm[SM_LRA + (b * 32 + j) * D + ch]; lh[j] = sm[SM_LRH + (b * 32 + j) * D + ch]; }
            float cr = 0.f;
#pragma unroll
            for (int j = 0; j < NCH; ++j) { sm[SM_CARRY + (b * 32 + j) * D + ch] = cr; cr = la[j] * cr + lh[j]; }
            a.out[O_PLH + b * D + ch] = cr; } }
}

__device__ __forceinline__ void sample_item(const Args& a, LAS unsigned char* lds, int idx) {
    int tid = threadIdx.x; asm volatile("" : "+v"(tid)); const int lane = tid & 63, wave = tid >> 6;
    unsigned char* ws = a.ws + opq0(); float* sm = (float*)(ws + WS_SMALL);
    const int sb = idx >> 2, h = idx & 3, row = MP + sb, sh = sb * 4 + h;
    const bf16_t* Q = (const bf16_t*)(ws + WS_Q); const bf16_t* Kb = (const bf16_t*)(ws + WS_K); const bf16_t* VT = (const bf16_t*)(ws + WS_VT); const bf16_t* Z = (const bf16_t*)(ws + WS_Z);
    LAS float* qs = (LAS float*)lds; LAS float* ks = qs + 256; LAS float* vs = ks + 256; LAS float* red = vs + 256  ; LAS float* r2 = red + 2048  ;
    if (tid < 256) { qs[tid] = bf2f(Q[(size_t)row * D + h * 256 + tid]); ks[tid] = bf2f(Kb[(size_t)row * D + h * 256 + tid]); vs[tid] = bf2f(VT[(size_t)(h * 256 + tid) * M + row]); }
    const float fpre = sm[SM_GF + row * 4 + h], ipre = sm[SM_GI + row * 4 + h], lf = log_sigmoid_(fpre), m0 = INP(7)[sh];
    const float mn = fmaxf(lf + m0, ipre), dec = __expf(lf + m0 - mn), wkk = __expf(ipre - mn);
    __syncthreads();
    {
        const int e4 = (tid & 63) * 4, dr = tid >> 6;
        const f32x4 v4 = *(const LAS f32x4*)(vs + e4);
        f32x4 ac = (f32x4){0.f, 0.f, 0.f, 0.f};
        const float* C0 = INP(5) + (size_t)sh * 65536; float* C1 = a.out + O_SC + (size_t)sh * 65536;
#pragma unroll 4
        for (int d = dr; d < 256; d += 8) { const f32x4 c0 = *(const f32x4*)(C0 + (size_t)d * 256 + e4); const float kd = ks[d] * wkk;
            const f32x4 cn = c0 * dec + v4 * kd; *(f32x4*)(C1 + (size_t)d * 256 + e4) = cn; ac += cn * qs[d]; }
        *(LAS f32x4*)(red + dr * 256 + e4) = ac;
    }
    float dn = 0.f;
    if (tid < 256) { const float nn = dec * INP(6)[sh * 256 + tid] + wkk * ks[tid]; a.out[O_SN + sh * 256 + tid] = nn; dn = qs[tid] * nn; }
    dn = wave_sum(dn);
    if (lane == 0) r2[wave] = dn;
    __syncthreads();
    const float den = (r2[0] + r2[1]) + (r2[2] + r2[3]);
    float hv = 0.f;
    if (tid < 256) { float num = 0.f;
#pragma unroll
        for (int r = 0; r < 8; ++r) num += red[r * 256 + tid];
        hv = num / fmaxf(fabsf(den), __expf(-mn)); }
    const float hq = wave_sum(hv * hv);
    if (lane == 0) r2[8 + wave] = hq;
    __syncthreads();
    if (tid < 256) {
        const float rs = 1.0f / sqrtf(((r2[8] + r2[9]) + (r2[10] + r2[11])) * (1.f / 256.f) + EPS);
        const int ch = h * 256 + tid, blk = ch >> 7, dd = ch & 127;
        const float ym = hv * rs * INP(25)[ch] * sigmoidf_(bf2f(Z[(size_t)row * NZ + 2048 + ch]));
        const float* xl = sm + SM_XLS + sb * D + blk * 128; const float* wa = INP(15) + (size_t)blk * 16384 + dd; const float* wx = INP(17) + (size_t)blk * 16384 + dd;
        float rp = INP(16)[ch], ip = INP(18)[ch];
#pragma unroll 8
        for (int c = 0; c < 128; ++c) { const float xv = xl[c]; rp += xv * wa[c * 128]; ip += xv * wx[c * 128]; }
        const float lam = INP(19)[ch], sp = fmaxf(-lam, 0.f) + log1pf(__expf(-fabsf(lam)));
        const float r = sigmoidf_(rp), ig = sigmoidf_(ip), la = -8.0f * r * sp, av = __expf(la);
        const float uv = sqrtf(-expm1f(2.f * la)) * ig * sm[SM_XLS + sb * D + ch];
        const float hn = av * INP(3)[sb * D + ch] + uv;
        a.out[O_SLH + sb * D + ch] = hn;
        const float mg = sigmoidf_(bf2f(Z[(size_t)row * NZ + 3072 + ch])) * hn + sigmoidf_(bf2f(Z[(size_t)row * NZ + 4096 + ch])) * ym;
        ((bf16_t*)(ws + WS_XB))[(size_t)row * D + ch] = (bf16_t)f2bf(mg);
        if (tid == 0) a.out[O_SM + sh] = mn;
    }
    __syncthreads();
}

__device__ __forceinline__ void p4w_item(const Args& a, LAS unsigned char* lds, int it) {
    int tid = threadIdx.x; asm volatile("" : "+v"(tid)); const int lane = tid & 63, wave = tid >> 6, fr = lane & 15, fq = lane >> 4;
    unsigned char* ws = a.ws + opq0(); float* sm = (float*)(ws + WS_SMALL);
    it = __builtin_amdgcn_readfirstlane(it);
    const int tt = it & 3, bch = it >> 2, h = bch & 3, c = (bch >> 2) & 31, b = bch >> 7, bh = b * 4 + h, tok0 = b * T + c * 64, gb = bh * T + c * 64;
    const bf16_t* Q = (const bf16_t*)(ws + WS_Q); const bf16_t* Kb = (const bf16_t*)(ws + WS_K); const bf16_t* VT = (const bf16_t*)(ws + WS_VT); const bf16_t* Z = (const bf16_t*)(ws + WS_Z);
    const bf16_t* NUMI = (const bf16_t*)(ws + WS_XC); const bf16_t* HL = (const bf16_t*)(ws + WS_HLOC); const bf16_t* CA = (const bf16_t*)(ws + WS_CUMA);
    bf16_t* MG = (bf16_t*)(ws + WS_XB);
    LAS bf16_t* Sl = (LAS bf16_t*)(lds + wave * 2304);
    const int t = tt * 16 + fr; const size_t tok = (size_t)(tok0 + t);
    bf16x8 qf[8];
#pragma unroll
    for (int ks = 0; ks < 8; ++ks) qf[ks] = *(const bf16x8*)(Q + ((size_t)h * M + tok) * 256 + ks * 32 + fq * 8);
    float di = 0.f;
#pragma unroll
    for (int ks = 0; ks < 8; ++ks) { float qq[8]; unpack8(__builtin_bit_cast(u32x4, qf[ks]), qq);
        const f32x4 n0 = *(const f32x4*)(sm + SM_NST + (bh * 32 + c) * 256 + ks * 32 + fq * 8), n1 = *(const f32x4*)(sm + SM_NST + (bh * 32 + c) * 256 + ks * 32 + fq * 8 + 4);
        di += (qq[0] * n0[0] + qq[1] * n0[1]) + (qq[2] * n0[2] + qq[3] * n0[3]) + (qq[4] * n1[0] + qq[5] * n1[1]) + (qq[6] * n1[2] + qq[7] * n1[3]); }
    di += __shfl_xor(di, 16); di += __shfl_xor(di, 32);
    di *= sm[SM_SC + gb + t];
    const float bm = sm[SM_BM + gb + t];
    float ds = 0.f;
    for (int st = 0; st <= tt; ++st) {
        f32x4 sa = (f32x4){0.f, 0.f, 0.f, 0.f};
#pragma unroll
        for (int ks = 0; ks < 8; ++ks) { const bf16x8 kf = *(const bf16x8*)(Kb + ((size_t)h * M + tok0 + st * 16 + fr) * 256 + ks * 32 + fq * 8); sa = MFMA16(kf, qf[ks], sa); }
        const f32x4 gib = *(const f32x4*)(sm + SM_GIB + gb + st * 16 + fq * 4);
        float vv[4];
#pragma unroll
        for (int j = 0; j < 4; ++j) { const int s_ = st * 16 + fq * 4 + j; vv[j] = (s_ <= t) ? sa[j] * fexp_(bm + gib[j]) : 0.f; ds += vv[j]; }
        u32x2 w; w.x = pk2(vv[0], vv[1]); w.y = pk2(vv[2], vv[3]);
        *(LAS u32x2*)(Sl + fr * 72 + st * 16 + fq * 4) = w;
    }
    if ((tt & 1) == 0) { unsigned z0 = 0u; asm volatile("" : "+v"(z0)); *(LAS u32x2*)(Sl + fr * 72 + (tt + 1) * 16 + fq * 4) = (u32x2){z0, z0}; }
    ds += __shfl_xor(ds, 16); ds += __shfl_xor(ds, 32);
    const float den = ds + di;
    const float inv = 1.0f / fmaxf(fabsf(den), fexp_(-sm[SM_MM + gb + t]));
    asm volatile("s_waitcnt lgkmcnt(0)" ::: "memory");
    f32x4 acc[16];
#pragma unroll
    for (int e = 0; e < 16; ++e) acc[e] = (f32x4){0.f, 0.f, 0.f, 0.f};
    const int nks = tt < 2 ? 1 : 2;
    for (int ks = 0; ks < nks; ++ks) { const bf16x8 sf = *(const LAS bf16x8*)(Sl + fr * 72 + ks * 32 + fq * 8);
#pragma unroll
        for (int e = 0; e < 16; ++e) { const bf16x8 vf = *(const bf16x8*)(VT + ((size_t)(bh * 32 + c) * 256 + e * 16 + fr) * 64 + ks * 32 + fq * 8); acc[e] = MFMA16(vf, sf, acc[e]); } }
    asm volatile("s_waitcnt lgkmcnt(0)" ::: "memory");
    float hq = 0.f;
#pragma unroll
    for (int e = 0; e < 16; ++e) { float ni[4] = {0.f, 0.f, 0.f, 0.f};
        if (c > 0) { const u32x2 w = *(const u32x2*)(NUMI + tok * D + h * 256 + e * 16 + fq * 4); ni[0] = bflo(w.x); ni[1] = bfhi(w.x); ni[2] = bflo(w.y); ni[3] = bfhi(w.y); }
#pragma unroll
        for (int j = 0; j < 4; ++j) { const float hv = (acc[e][j] + ni[j]) * inv; acc[e][j] = hv; hq += hv * hv; } }
    hq += __shfl_xor(hq, 16); hq += __shfl_xor(hq, 32);
    const float rs = __builtin_amdgcn_rsqf(hq * (1.f / 256.f) + EPS);
#pragma unroll
    for (int e = 0; e < 16; ++e) { const int ch = h * 256 + e * 16 + fq * 4;
        const f32x4 mg = *(const f32x4*)(INP(25) + ch); const f32x4 cr = *(const f32x4*)(sm + SM_CARRY + (b * 32 + c) * D + ch);
        const u32x2 ow = *(const u32x2*)(Z + tok * NZ + 2048 + ch), glw = *(const u32x2*)(Z + tok * NZ + 3072 + ch), gmw = *(const u32x2*)(Z + tok * NZ + 4096 + ch);
        const u32x2 hlw = *(const u32x2*)(HL + tok * D + ch), caw = *(const u32x2*)(CA + tok * D + ch);
        const float ov[4] = {bflo(ow.x), bfhi(ow.x), bflo(ow.y), bfhi(ow.y)}, gl[4] = {bflo(glw.x), bfhi(glw.x), bflo(glw.y), bfhi(glw.y)}, gm[4] = {bflo(gmw.x), bfhi(gmw.x), bflo(gmw.y), bfhi(gmw.y)};
        const float hl[4] = {bflo(hlw.x), bfhi(hlw.x), bflo(hlw.y), bfhi(hlw.y)}, ca[4] = {bflo(caw.x), bfhi(caw.x), bflo(caw.y), bfhi(caw.y)};
        float o[4];
#pragma unroll
        for (int j = 0; j < 4; ++j) { const float ym = acc[e][j] * rs * mg[j] * sigmoidf_(ov[j]); const float yl = hl[j] + ca[j] * cr[j];
            o[j] = sigmoidf_(gl[j]) * yl + sigmoidf_(gm[j]) * ym; }
        u32x2 w; w.x = pk2(o[0], o[1]); w.y = pk2(o[2], o[3]);
        *(u32x2*)(MG + tok * D + ch) = w; }
}

__device__ __forceinline__ void p9_final(const Args& a, int G) {
    int tid = threadIdx.x; asm volatile("" : "+v"(tid)); const int lane = tid & 63, wave = tid >> 6;
    const float* sm = (const float*)(a.ws + WS_SMALL); const bf16_t* X = (const bf16_t*)(a.ws + WS_X1B);
    const int gw = blockIdx.x * 8 + wave, NGW = G * 8;
    f32x4 g4[4];
#pragma unroll
    for (int j = 0; j < 4; ++j) g4[j] = *((const f32x4*)INP(34) + lane + 64 * j);
    for (int row = gw; row < MR; row += NGW) {
        const float rs = 1.0f / sqrtf(sm[SM_SS3 + row] * (1.f / D) + EPS);
        const u32x2* xr = (const u32x2*)(X + (size_t)row * D) + lane;
        f32x4* o = (f32x4*)(a.out + (row < MP ? O_YP + (size_t)row * D : O_YS + (size_t)(row - MP) * D)) + lane;
#pragma unroll
        for (int j = 0; j < 4; ++j) { const u32x2 w = xr[64 * j]; const f32x4 v = (f32x4){bflo(w.x), bfhi(w.x), bflo(w.y), bfhi(w.y)}; o[64 * j] = v * rs * g4[j]; }
    }
}

template <int KS>
__device__ __forceinline__ void skinny_job(const Args& a, LAS unsigned char* lds, int kind, int G) {
    int tid = threadIdx.x; asm volatile("" : "+v"(tid)); const int lane = tid & 63, wave = tid >> 6, fr = lane & 15, fq = lane >> 4;
    unsigned char* ws = a.ws + opq0(); float* sm = (float*)(ws + WS_SMALL);
    const bf16_t* A; const bf16_t* Bt; int lda, ldb, K, nunits;
    switch (kind) {
    case 0: A = (const bf16_t*)(ws + WS_XB); lda = D; Bt = (const bf16_t*)(ws + WS_W1T); ldb = D; K = D; nunits = NZ / 16; break;
    case 1: A = (const bf16_t*)(ws + WS_XC); lda = D; Bt = (const bf16_t*)(ws + WS_WQKT); ldb = HD; K = HD; nunits = NH * 32; break;
    case 3: A = (const bf16_t*)(ws + WS_Z) + 1024; lda = NZ; Bt = (const bf16_t*)(ws + WS_WVT); ldb = HD; K = HD; nunits = NH * 16; break;
    case 4: A = (const bf16_t*)(ws + WS_XB); lda = D; Bt = (const bf16_t*)(ws + WS_WOT); ldb = D; K = D; nunits = D / 16; break;
    case 5: A = (const bf16_t*)(ws + WS_X1B); lda = D; Bt = (const bf16_t*)(ws + WS_WGUT); ldb = D; K = D; nunits = (DFF / 128) * 8; break;
    case 6: A = (const bf16_t*)(ws + WS_Z); lda = DFF; Bt = (const bf16_t*)(ws + WS_WDT); ldb = DFF; K = DFF; nunits = D / 16; break;
    case 7: A = (const bf16_t*)(ws + WS_PB); lda = PD; Bt = (const bf16_t*)(ws + WS_WPT); ldb = PD; K = PD; nunits = D / 16; break;
    default: A = (const bf16_t*)(ws + WS_X2B); lda = D; Bt = (const bf16_t*)(ws + WS_WPGT); ldb = D; K = D; nunits = D / 16; break;
    }
    const int row = MP + 16 * wave + fr, nksw = K / 256, kw = wave * (K / 8);
    LAS f32x4* red0 = (LAS f32x4*)lds; LAS f32x4* red1 = (LAS f32x4*)(lds + 65536);
    for (int u = blockIdx.x; u < nunits; u += G) {
        int acol = 0, brow0 = u * 16, brow1 = u * 16, z = 0; size_t boff = 0;
        if (kind == 1) { z = u >> 5; acol = z * 256; brow0 = (u & 31) * 16; brow1 = brow0; boff = (size_t)z * 512 * 256; }
        if (kind == 3) { z = u >> 4; acol = z * 256; brow0 = (u & 15) * 16; brow1 = brow0; boff = (size_t)z * 65536; }
        if (kind == 5) { brow0 = (u >> 3) * 256 + (u & 7) * 16; brow1 = brow0 + 128; }
        const bf16_t* Ap = A + (size_t)(MP + fr) * lda + acol + kw + fq * 8;
        const bf16_t* B0p = Bt + boff + (size_t)(brow0 + fr) * ldb + kw + fq * 8;
        const bf16_t* B1p = Bt + boff + (size_t)(brow1 + fr) * ldb + kw + fq * 8;
        bf16x8 b0[KS], b1[KS];
#pragma unroll
        for (int i = 0; i < KS; ++i) if (i < nksw) { b0[i] = *(const bf16x8*)(B0p + i * 32); if (kind == 5) b1[i] = *(const bf16x8*)(B1p + i * 32); }
        f32x4 p0[8], p1[8];
#pragma unroll
        for (int m = 0; m < 8; ++m) { p0[m] = (f32x4){0.f, 0.f, 0.f, 0.f}; p1[m] = (f32x4){0.f, 0.f, 0.f, 0.f}; }
        bf16x8 af[8];
#pragma unroll
        for (int m = 0; m < 8; ++m) af[m] = *(const bf16x8*)(Ap + (size_t)m * 16 * lda);
#pragma unroll
        for (int i = 0; i < KS; ++i) if (i < nksw) {
            bf16x8 an[8];
            const int inx = (i + 1 < nksw) ? i + 1 : i;
#pragma unroll
            for (int m = 0; m < 8; ++m) an[m] = *(const bf16x8*)(Ap + (size_t)m * 16 * lda + inx * 32);
#pragma unroll
            for (int m = 0; m < 8; ++m) { p0[m] = MFMA16(b0[i], af[m], p0[m]); if (kind == 5) p1[m] = MFMA16(b1[i], af[m], p1[m]); }
#pragma unroll
            for (int m = 0; m < 8; ++m) af[m] = an[m];
        }
#pragma unroll
        for (int m = 0; m < 8; ++m) { red0[(wave * 8 + m) * 64 + lane] = p0[m]; if (kind == 5) red1[(wave * 8 + m) * 64 + lane] = p1[m]; }
        __syncthreads();
        f32x4 acc0 = (f32x4){0.f, 0.f, 0.f, 0.f}, acc1 = (f32x4){0.f, 0.f, 0.f, 0.f};
#pragma unroll
        for (int w = 0; w < 8; ++w) { acc0 += red0[(w * 8 + wave) * 64 + lane]; if (kind == 5) acc1 += red1[(w * 8 + wave) * 64 + lane]; }
        __syncthreads();
        switch (kind) {
        case 0: { const float s = sm[SM_RSTD0 + row]; u32x2 w; w.x = pk2(acc0[0] * s, acc0[1] * s); w.y = pk2(acc0[2] * s, acc0[3] * s);
                  *(u32x2*)((bf16_t*)(ws + WS_Z) + (size_t)row * NZ + u * 16 + fq * 4) = w; } break;
        case 1: { const int col = brow0 + fq * 4; bf16_t* dst = (col < 256 ? (bf16_t*)(ws + WS_Q) + col : (bf16_t*)(ws + WS_K) + col - 256) + ((size_t)z * M + row) * 256;
                  u32x2 w; w.x = pk2(acc0[0], acc0[1]); w.y = pk2(acc0[2], acc0[3]); *(u32x2*)dst = w; } break;
        case 3: { u32x2 w; w.x = pk2(acc0[0], acc0[1]); w.y = pk2(acc0[2], acc0[3]); *(u32x2*)((bf16_t*)(ws + WS_VS) + (size_t)(row - MP) * D + z * 256 + brow0 + fq * 4) = w; } break;
        case 4: case 6: { const int col = u * 16 + fq * 4; f32x4 b;
                  if (kind == 4) b = *(const f32x4*)(INP(1) + (size_t)(row - MP) * D + col);
                  else { const u32x2 w = *(const u32x2*)((const bf16_t*)(ws + WS_X1B) + (size_t)row * D + col); b = (f32x4){bflo(w.x), bfhi(w.x), bflo(w.y), bfhi(w.y)}; }
                  const f32x4 v = acc0 + b; u32x2 w; w.x = pk2(v[0], v[1]); w.y = pk2(v[2], v[3]);
                  *(u32x2*)((bf16_t*)(ws + (kind == 4 ? WS_X1B : WS_X2B)) + (size_t)row * D + col) = w;
                  float q = (v[0] * v[0] + v[1] * v[1]) + (v[2] * v[2] + v[3] * v[3]); q += __shfl_xor(q, 16); q += __shfl_xor(q, 32);
                  if (fq == 0) atomicAdd(sm + (kind == 4 ? SM_SS1 : SM_SS2) + row, q); } break;
        case 5: { const float s = __builtin_amdgcn_rsqf(sm[SM_SS1 + row] * (1.f / D) + EPS); float o[4];
#pragma unroll
                  for (int j = 0; j < 4; ++j) { const float gv = acc0[j] * s, uv = acc1[j] * s; o[j] = gv * sigmoidf_(gv) * uv; }
                  u32x2 w; w.x = pk2(o[0], o[1]); w.y = pk2(o[2], o[3]);
                  *(u32x2*)((bf16_t*)(ws + WS_Z) + (size_t)row * DFF + (u >> 3) * 128 + (u & 7) * 16 + fq * 4) = w; } break;
        case 7: { u32x2 w; w.x = pk2(acc0[0], acc0[1]); w.y = pk2(acc0[2], acc0[3]); *(u32x2*)((bf16_t*)(ws + WS_PE) + (size_t)row * D + u * 16 + fq * 4) = w; } break;
        default: { const int col = u * 16 + fq * 4; const float s = __builtin_amdgcn_rsqf(sm[SM_SS2 + row] * (1.f / D) + EPS);
                  const u32x2 xw = *(const u32x2*)((const bf16_t*)(ws + WS_X2B) + (size_t)row * D + col), pw = *(const u32x2*)((const bf16_t*)(ws + WS_PE) + (size_t)row * D + col);
                  const float xb[4] = {bflo(xw.x), bfhi(xw.x), bflo(xw.y), bfhi(xw.y)}, pe[4] = {bflo(pw.x), bfhi(pw.x), bflo(pw.y), bfhi(pw.y)};
                  float v[4], q = 0.f;
#pragma unroll
                  for (int j = 0; j < 4; ++j) { v[j] = xb[j] + sigmoidf_(acc0[j] * s) * pe[j]; q += v[j] * v[j]; }
                  u32x2 w; w.x = pk2(v[0], v[1]); w.y = pk2(v[2], v[3]); *(u32x2*)((bf16_t*)(ws + WS_X1B) + (size_t)row * D + col) = w;
                  q += __shfl_xor(q, 16); q += __shfl_xor(q, 32);
                  if (fq == 0) atomicAdd(sm + SM_SS3 + row, q); } break;
        }
    }
}
__device__ __forceinline__ int skinny_kind(int ph, int j) {
    if (ph == 1) return j == 0 ? 0 : -1;
    if (ph == 3) return j == 0 ? 1 : (j == 1 ? 3 : -1);
    if (ph == 6) return j == 0 ? 4 : -1;
    if (ph == 7) return j == 0 ? 5 : -1;
    if (ph == 8) return j == 0 ? 6 : -1;
    if (ph == 9) return j == 0 ? 7 : (j == 1 ? 8 : -1);
    return -1;
}

#define XB_TMO      128
#define XB_XCNT(j)  (256  + 64 * (j))
#define XB_XSUB(j)  (1280 + 64 * (j))
#define XB_XGEN(j)  (2304 + 64 * (j))
#define XB_TOP      3328
#define XB_TOPGEN   3392
#define XCD_BAR_WORDS 3456
#define XB_SPIN_CAP (1u << 18)
__device__ __forceinline__ unsigned xb_ld(unsigned* p)              { return __hip_atomic_load(p, __ATOMIC_RELAXED, __HIP_MEMORY_SCOPE_AGENT); }
__device__ __forceinline__ unsigned xb_add(unsigned* p, unsigned v) { return __hip_atomic_fetch_add(p, v, __ATOMIC_RELAXED, __HIP_MEMORY_SCOPE_AGENT); }
__device__ __forceinline__ unsigned xb_xcc_id() { return (unsigned)__builtin_amdgcn_s_getreg((3 << 11) | 20) & 0xFu; }
#define XB_SPIN(cond, bar) do { unsigned _sp = 0; while (cond) { __builtin_amdgcn_s_sleep(1); \
    if ((++_sp & 255u) == 0u) { if (xb_ld(&(bar)[XB_TMO])) break; if (_sp > XB_SPIN_CAP) { atomicAdd(&(bar)[XB_TMO], 1u); break; } } } } while (0)
struct XcdBarrier { unsigned* bar; unsigned x; volatile LAS unsigned* st; };
__device__ __forceinline__ XcdBarrier xcd_barrier_post(unsigned* bar, volatile LAS unsigned* st) {
    XcdBarrier b; b.bar = bar; b.x = xb_xcc_id(); b.st = st;
    if (threadIdx.x == 0) (void)xb_add(&bar[XB_XCNT(b.x)], 1u);
    return b;
}
__device__ __forceinline__ void xcd_barrier_complete(unsigned* bar, unsigned x, unsigned& nloc, unsigned& nx) {
    const unsigned G = gridDim.x * gridDim.y * gridDim.z;
    unsigned sum, cnt, mine, sp = 0u;
    for (;;) {
        sum = 0u; cnt = 0u; mine = 0u;
#pragma unroll
        for (unsigned j = 0; j < 16; ++j) { const unsigned c = xb_ld(&bar[XB_XCNT(j)]); sum += c; cnt += (c > 0u) ? 1u : 0u; mine = (j == x) ? c : mine; }
        if (sum == G) break;
        __builtin_amdgcn_s_sleep(1);
        if ((++sp & 255u) == 0u) { if (xb_ld(&bar[XB_TMO])) break; if (sp > XB_SPIN_CAP) { atomicAdd(&bar[XB_TMO], 1u); break; } }
    }
    nloc = mine > 0u ? mine : 1u; nx = cnt > 0u ? cnt : 1u;
}
__device__ __forceinline__ void xcd_barrier(const XcdBarrier& b) {
    asm volatile("s_waitcnt vmcnt(0)" ::: "memory");
    __syncthreads();
    if (threadIdx.x == 0) {
        unsigned* bar = b.bar;
        __builtin_amdgcn_s_waitcnt(0);
        unsigned nloc = b.st[0], nx = b.st[1];
        if (nloc == 0u) { xcd_barrier_complete(bar, b.x, nloc, nx); b.st[0] = nloc; b.st[1] = nx; }
        const unsigned old = xb_add(&bar[XB_XSUB(b.x)], 1u);
        const unsigned gen = old / nloc;
        if (old + 1u == (gen + 1u) * nloc) {
            __builtin_amdgcn_fence(__ATOMIC_RELEASE, "agent");
            asm volatile("s_waitcnt vmcnt(0)" ::: "memory");
            const unsigned og = xb_add(&bar[XB_TOP], 1u);
            const unsigned tg = og / nx;
            if (og + 1u == (tg + 1u) * nx) xb_add(&bar[XB_TOPGEN], 1u);
            else XB_SPIN(xb_ld(&bar[XB_TOPGEN]) == tg, bar);
            __builtin_amdgcn_fence(__ATOMIC_ACQUIRE, "agent");
            xb_add(&bar[XB_XGEN(b.x)], 1u);
            asm volatile("s_waitcnt vmcnt(0)" ::: "memory");
        } else {
            XB_SPIN(xb_ld(&bar[XB_XGEN(b.x)]) == gen, bar);
            __builtin_amdgcn_fence(__ATOMIC_ACQUIRE, "agent");
            asm volatile("s_waitcnt vmcnt(0)" ::: "memory");
        }
    }
    __syncthreads();
}

namespace pg8 {
struct EpiAny {
    int kind; unsigned char* ws; const float* xp; const float* xs;
    __device__ __forceinline__ void operator()(const f32x4 (&acc)[2][2][4][2], const Unit& u, int wr, int wc, int fr, int fq) const {
        float* sm = (float*)(ws + WS_SMALL);
        switch (kind) {
        case 0: { EpiZ E{(bf16_t*)(ws + WS_Z), sm + SM_RSTD0}; E(acc, u, wr, wc, fr, fq); } break;
        case 1: { EpiQK E{(bf16_t*)(ws + WS_Q), (bf16_t*)(ws + WS_K)}; E(acc, u, wr, wc, fr, fq); } break;
        case 2: { EpiT E{(bf16_t*)(ws + WS_KT), sm + SM_WK}; E(acc, u, wr, wc, fr, fq); } break;
        case 3: { EpiT E{(bf16_t*)(ws + WS_VT), nullptr}; E(acc, u, wr, wc, fr, fq); } break;
        case 4: { EpiRes<0> E{xp, xs, nullptr, (bf16_t*)(ws + WS_X1B), sm + SM_SS1}; E(acc, u, wr, wc, fr, fq); } break;
        case 5: { EpiGU E{(bf16_t*)(ws + WS_Z), sm + SM_SS1}; E(acc, u, wr, wc, fr, fq); } break;
        case 6: { EpiRes<1> E{nullptr, nullptr, (const bf16_t*)(ws + WS_X1B), (bf16_t*)(ws + WS_X2B), sm + SM_SS2}; E(acc, u, wr, wc, fr, fq); } break;
        case 7: { EpiPlain E{(bf16_t*)(ws + WS_PE), D}; E(acc, u, wr, wc, fr, fq); } break;
        default: { EpiPle E{(const bf16_t*)(ws + WS_X2B), (bf16_t*)(ws + WS_X1B), (const bf16_t*)(ws + WS_PE), sm + SM_SS2, sm + SM_SS3}; E(acc, u, wr, wc, fr, fq); } break;
        }
    }
};
}

__device__ __forceinline__ bool gemm_job(unsigned char* ws, int ph, int j, pg8::Gemm& g, int& nM, int& nN, int& nZ, int& kind) {
    using namespace pg8;
    const bf16_t* w = (const bf16_t*)ws;
#define WSB(off) ((const bf16_t*)(ws + (off)))
    if (ph == 1 && j == 0) { g = Gemm{WSB(WS_XB), WSB(WS_W1T), D, D, D, 0, 0}; nM = MP / 256; nN = NZ / 256; nZ = 1; kind = 0; return true; }
    if (ph == 3 && j == 0) { g = Gemm{WSB(WS_XC), WSB(WS_WQKT), D, HD, HD, 512, (size_t)512 * 256 * 2}; nM = MP / 256; nN = 2; nZ = NH; kind = 1; return true; }
    if (ph == 3 && j == 1) { g = Gemm{WSB(WS_WQKT) + 65536, WSB(WS_XC), HD, D, HD, (size_t)512 * 256 * 2, 512}; nM = 1; nN = MP / 256; nZ = NH; kind = 2; return true; }
    if (ph == 3 && j == 2) { g = Gemm{WSB(WS_WVT), WSB(WS_Z) + 1024, HD, NZ, HD, (size_t)65536 * 2, 512}; nM = 1; nN = MP / 256; nZ = NH; kind = 3; return true; }
    if (ph == 6 && j == 0) { g = Gemm{WSB(WS_XB), WSB(WS_WOT), D, D, D, 0, 0}; nM = MP / 256; nN = D / 256; nZ = 1; kind = 4; return true; }
    if (ph == 7 && j == 0) { g = Gemm{WSB(WS_X1B), WSB(WS_WGUT), D, D, D, 0, 0}; nM = MP / 256; nN = NGU / 256; nZ = 1; kind = 5; return true; }
    if (ph == 8 && j == 0) { g = Gemm{WSB(WS_Z), WSB(WS_WDT), DFF, DFF, DFF, 0, 0}; nM = MP / 256; nN = D / 256; nZ = 1; kind = 6; return true; }
    if (ph == 9 && j == 0) { g = Gemm{WSB(WS_PB), WSB(WS_WPT), PD, PD, PD, 0, 0}; nM = MP / 256; nN = D / 256; nZ = 1; kind = 7; return true; }
    if (ph == 9 && j == 1) { g = Gemm{WSB(WS_X2B), WSB(WS_WPGT), D, D, D, 0, 0}; nM = MP / 256; nN = D / 256; nZ = 1; kind = 8; return true; }
#undef WSB
    (void)w; return false;
}

#ifndef REPMASK
#define REPMASK 0
#endif
constexpr int NPHASE = 11;
__global__ void __launch_bounds__(NT, 2) hawk_fwd(Args a) {
    extern __shared__ __attribute__((aligned(16))) unsigned char lds_raw[];
    LAS unsigned char* lds = (LAS unsigned char*)lds_raw;
    cg::grid_group grid = cg::this_grid();
    const int G = gridDim.x, bx = blockIdx.x;
    volatile LAS unsigned* bst = (volatile LAS unsigned*)(lds + LDS_BYTES - 64);
    if (threadIdx.x == 0) { bst[0] = 0u; bst[1] = 0u; }
    __syncthreads();
    const XcdBarrier xbar = xcd_barrier_post((unsigned*)(a.ws + WS_BAR), bst);
    if (a.ph_hi < 0) grid.sync();
    for (int ph = a.ph_lo; ph < a.ph_hi; ++ph) {
        for (int rep = 0; rep < 1 + ((REPMASK >> ph) & 1); ++rep) {
            if (rep) xcd_barrier(xbar);
            switch (ph) {
            case 0: p0_prologue(a, lds, G); break;
            case 2: p2_phase(a, lds, G); __syncthreads();
                    for (int it = 2048 + bx; it < 2048 + MS; it += G) p2a_item(a, lds, it);
                    __syncthreads();
                    for (int bh = G - 1 - bx; bh < 32; bh += G) gate_scan(a, lds, bh); break;
            case 4: carry_scan(a, G);
                    for (int it = bx; it < 256; it += G) p3_item(a, lds, ((it & 7) << 5) | (it >> 3)); break;
            case 5: { int tw = threadIdx.x; asm volatile("" : "+v"(tw)); for (int it = bx * 8 + (tw >> 6); it < 4096; it += G * 8) p4w_item(a, lds, it); } break;
            case 10: p9_final(a, G); break;
            default: break;
            }
            for (int sj = 0; sj < 2; ++sj) { const int sk = skinny_kind(ph, sj); if (sk < 0) break; if (sk == 6) skinny_job<11>(a, lds, sk, G); else skinny_job<4>(a, lds, sk, G); __syncthreads(); }
            __syncthreads();
            for (int j = 0; j < 3; ++j) {
                pg8::Gemm g; int nM, nN, nZ, kind;
                if (!gemm_job(a.ws, ph, j, g, nM, nN, nZ, kind)) break;
                pg8::Order S; S.init(nM, nN, nZ, G, bx);
                pg8::EpiAny E{kind, a.ws, a.in[0], a.in[1]};
                pg8::gemm_phase(lds, g, S, E);
            }
        }
        if (ph + 1 < a.ph_hi) xcd_barrier(xbar);
    }
}

#ifndef N_LAUNCH_SPLIT
#define N_LAUNCH_SPLIT 0
#endif
extern "C" void kernel_launch(void* const* d_in, const int* in_sizes, int n_in, void* d_out, int out_size, void* d_ws, size_t ws_size, hipStream_t stream) {
    static int grid = 0;
    if (grid == 0) {
        int dev = 0, cus = 0, per_cu = 0;
        hipGetDevice(&dev);
        hipDeviceGetAttribute(&cus, hipDeviceAttributeMultiprocessorCount, dev);
        hipFuncSetAttribute((const void*)hawk_fwd, hipFuncAttributeMaxDynamicSharedMemorySize, LDS_BYTES);
        hipOccupancyMaxActiveBlocksPerMultiprocessor(&per_cu, (const void*)hawk_fwd, NT, LDS_BYTES);
        if (per_cu < 1) { fprintf(stderr, "kernel_launch: occupancy query says %d blocks per CU\n", per_cu); per_cu = 1; }
        grid = cus * per_cu;
        if (n_in != 35 || ws_size < WS_END || (size_t)out_size != O_END) fprintf(stderr, "kernel_launch: unexpected sizes n_in %d ws %zu out %d\n", n_in, ws_size, out_size);
    }
    Args a{};
    for (int i = 0; i < 35; ++i) a.in[i] = (const float*)d_in[i];
    a.out = (float*)d_out; a.ws = (unsigned char*)d_ws;
#if N_LAUNCH_SPLIT
    for (int p = 0; p < NPHASE; ++p) { a.ph_lo = p; a.ph_hi = p + 1; hipLaunchKernelGGL(hawk_fwd, dim3(grid), dim3(NT), LDS_BYTES, stream, a); }
#else
    a.ph_lo = 0; a.ph_hi = NPHASE;
    hipMemsetAsync((char*)d_ws + WS_BAR, 0, 16384, stream);
    void* args[] = {&a};
    hipError_t e = hipLaunchCooperativeKernel((const void*)hawk_fwd, dim3(grid), dim3(NT), args, LDS_BYTES, stream);
    if (e != hipSuccess) fprintf(stderr, "cooperative launch failed: %s (grid %d)\n", hipGetErrorString(e), grid);
#endif
}
```

```cpp
#include <hip/hip_runtime.h>
#include <hip/hip_cooperative_groups.h>
#include <cstdio>
#include <cstdint>
namespace cg = cooperative_groups;

#define LAS __attribute__((address_space(3)))
typedef unsigned short bf16_t;
typedef short bf16x8 __attribute__((ext_vector_type(8)));
typedef float f32x4 __attribute__((ext_vector_type(4)));
typedef float f32x2 __attribute__((ext_vector_type(2)));
typedef unsigned u32x4 __attribute__((ext_vector_type(4)));
typedef unsigned u32x2 __attribute__((ext_vector_type(2)));

constexpr int D = 1024, NB = 8, T = 2048, MP = NB * T, MS = 128, MR = MP + MS, M = 16640  ;
constexpr int NZ = 5120, DFF = 2816, NGU = 2 * DFF, PD = 256, NIN = 5128, NH = 4, HD = 256, NCH = T / 64;
constexpr float EPS = 1e-6f;
constexpr float M_INIT = -1e30f;

constexpr size_t MiB = 1u << 20;
constexpr size_t WS_W1T = 0;
constexpr size_t WS_WOT = 10 * MiB;
constexpr size_t WS_WGUT = 12 * MiB;
constexpr size_t WS_WDT = 23 * MiB;
constexpr size_t WS_WPGT = 57 * MiB / 2;
constexpr size_t WS_WPT = 61 * MiB / 2;
constexpr size_t WS_WQKT = 31 * MiB;
constexpr size_t WS_WVT = 32 * MiB;
constexpr size_t WS_WLRUT = 65 * MiB / 2;
constexpr size_t WS_BAR = 40 * MiB - 16384;
constexpr size_t WS_SMALL = 33 * MiB;
constexpr size_t WS_XB = 40 * MiB;
constexpr size_t WS_PB = 73 * MiB;
constexpr size_t WS_Z = 82 * MiB;
constexpr size_t WS_XC = 245 * MiB;
constexpr size_t WS_Q = 278 * MiB;
constexpr size_t WS_K = 311 * MiB;
constexpr size_t WS_KT = 344 * MiB;
constexpr size_t WS_VT = 377 * MiB;
constexpr size_t WS_HLOC = 410 * MiB;
constexpr size_t WS_CUMA = 443 * MiB;
constexpr size_t WS_VS = 476 * MiB;
constexpr size_t WS_END = 477 * MiB;
constexpr size_t WS_X1 = WS_Q;
constexpr size_t WS_X1B = WS_KT;
constexpr size_t WS_X2B = WS_VT;
constexpr size_t WS_PE = WS_HLOC;
constexpr int SM_RSTD0 = 0;
constexpr int SM_SS1 = SM_RSTD0 + M;
constexpr int SM_SS2 = SM_SS1 + M;
constexpr int SM_SS3 = SM_SS2 + M;
constexpr int SM_GI = SM_SS3 + M;
constexpr int SM_GF = SM_GI + 4 * M;
constexpr int SM_BM = SM_GF + 4 * M;
constexpr int SM_GIB = SM_BM + 32 * T;
constexpr int SM_SC = SM_GIB + 32 * T;
constexpr int SM_WK = SM_SC + 32 * T;
constexpr int SM_MM = SM_WK + 32 * T;
constexpr int SM_DEC = SM_MM + 32 * T;
constexpr int SM_NST = SM_DEC + 1024;
constexpr int SM_LRA = SM_NST + 32 * 32 * 256;
constexpr int SM_LRH = SM_LRA + 8 * 32 * 1024;
constexpr int SM_XLS = SM_LRH + 8 * 32 * 1024;
constexpr int SM_CARRY = SM_XLS + 128 * 1024;
constexpr int SM_END = SM_CARRY + 8 * 32 * 1024;
static_assert((size_t)SM_END * 4 <= 7 * MiB - 16384, "small arrays");
static_assert(WS_END <= 512 * MiB, "workspace");

constexpr size_t O_YP = 0, O_YS = O_YP + (size_t)MP * D, O_PLC = O_YS + (size_t)MS * D, O_PLH = O_PLC + 8 * 3 * 1024, O_PMC = O_PLH + 8 * 1024,
                 O_PC = O_PMC + 8 * 3 * 1024, O_PN = O_PC + (size_t)8 * 4 * 65536, O_PM = O_PN + 8 * 4 * 256, O_SLC = O_PM + 32, O_SLH = O_SLC + (size_t)128 * 3 * 1024,
                 O_SMC = O_SLH + 128 * 1024, O_SC = O_SMC + (size_t)128 * 3 * 1024, O_SN = O_SC + (size_t)128 * 4 * 65536, O_SM = O_SN + 128 * 4 * 256, O_END = O_SM + 512;

constexpr int LDS_BYTES = 147456;
constexpr int NT = 512;

struct Args {
    const float* in[35];
    float* out;
    unsigned char* ws;
    int ph_lo, ph_hi;
};

__device__ __forceinline__ size_t opq0() { size_t z = 0; asm volatile("" : "+s"(z)); return z; }
#define INP(k) (a.in[k] + opq0())
__device__ __forceinline__ unsigned f2bf(float f) { unsigned u = __builtin_bit_cast(unsigned, f); return (u + 0x7fffu + ((u >> 16) & 1u)) >> 16; }
__device__ __forceinline__ unsigned pk2(float lo, float hi) { return f2bf(lo) | (f2bf(hi) << 16); }
__device__ __forceinline__ float bf2f(unsigned short h) { return __builtin_bit_cast(float, (unsigned)h << 16); }
__device__ __forceinline__ float bflo(unsigned w) { return __builtin_bit_cast(float, w << 16); }
__device__ __forceinline__ float bfhi(unsigned w) { return __builtin_bit_cast(float, w & 0xffff0000u); }
__device__ __forceinline__ float sigmoidf_(float x) { return __builtin_amdgcn_rcpf(1.f + __builtin_amdgcn_exp2f(-1.4426950408889634f * x)); }
__device__ __forceinline__ float fexp_(float x) { return __builtin_amdgcn_exp2f(1.4426950408889634f * x); }
__device__ __forceinline__ void unpack8x(const u32x4 w, float (&o)[8]) { o[0] = bflo(w.x); o[1] = bfhi(w.x); o[2] = bflo(w.y); o[3] = bfhi(w.y); o[4] = bflo(w.z); o[5] = bfhi(w.z); o[6] = bflo(w.w); o[7] = bfhi(w.w); }
__device__ __forceinline__ float wave_sum(float v) {
#pragma unroll
    for (int o = 1; o < 64; o <<= 1) v += __shfl_xor(v, o);
    return v;
}
__device__ __forceinline__ const float* xrow_ptr(const Args& a, int row) {
    return row < MP ? INP(0) + (size_t)row * D : INP(1) + (size_t)(row - MP) * D;
}

namespace pg8 {
constexpr int BM = 256, BK = 64, HALF = 128, HTB = HALF * BK * 2, STAGE_BYTES = 8 * HTB, NXCD = 8, WGM = 8;
__device__ __forceinline__ int lds_byte(int r, int c) { const int st = (r >> 4) * 2 + (c >> 5), rr = r & 15, cc = c & 31, ob = rr * 64 + cc * 2; return st * 1024 + (ob ^ (((ob >> 9) & 1) << 5)); }
__device__ __forceinline__ void stage_rc(int b, int& R, int& C) { const int st = b / 1024, sb = b % 1024, swz = sb ^ (((sb >> 9) & 1) << 5); R = (st >> 1) * 16 + swz / 64; C = (st & 1) * 32 + (swz % 64) / 2; }
__device__ __forceinline__ int perm32(int rho) { const int n = rho >> 4, i = rho & 15; return 8 * (i >> 2) + 4 * n + (i & 3); }

struct Unit { int pm, pn, z; };
struct Gemm { const bf16_t* A; const bf16_t* Bt; int lda, ldb, K; size_t zA, zB; };

struct Order {
    int nM, nN, nwg, total, G, c;
    __device__ void init(int nM_, int nN_, int nZ_, int G_, int c_) { nM = nM_; nN = nN_; nwg = nM * nN; total = nwg * nZ_; G = G_; c = c_; }
    __device__ bool next(int i, Unit& u) const {
        const long L = (long)i * G + c; if (L >= total) return false;
        u.z = (int)(L / nwg); int wgid = (int)(L % nwg);
        { const int q = nwg / NXCD, r = nwg % NXCD, xcd = wgid % NXCD, off = wgid / NXCD; wgid = (xcd < r ? xcd * (q + 1) : r * (q + 1) + (xcd - r) * q) + off; }
        const int nig = WGM * nN, gid = wgid / nig, fm = gid * WGM, gsz = (nM - fm) < WGM ? (nM - fm) : WGM;
        u.pm = fm + ((wgid % nig) % gsz); u.pn = (wgid % nig) / gsz; return true;
    }
};

__device__ __forceinline__ unsigned cvt_pk_bf16(float lo, float hi) { unsigned r; asm volatile("v_cvt_pk_bf16_f32 %0, %1, %2" : "=v"(r) : "v"(lo), "v"(hi)); return r; }

template <class Epi>
__device__ __forceinline__ void gemm_phase(LAS unsigned char* lds, const Gemm g, const Order& S, const Epi& E) {
    int tid = threadIdx.x; asm volatile("" : "+v"(tid));
    const int wid = __builtin_amdgcn_readfirstlane(tid >> 6), lane = tid & 63, wr = wid >> 2, wc = wid & 3, fr = lane & 15, fq = lane >> 4;
    const int K = g.K, nt = K / BK;
    unsigned voffA[2], voffB[2];
#pragma unroll
    for (int i = 0; i < 2; ++i) { int R, C; stage_rc(tid * 16 + i * 8192, R, C); const int Rb = (R & ~31) + perm32(R & 31);
        voffA[i] = (unsigned)(R * g.lda + C) * 2u; voffB[i] = (unsigned)(Rb * g.ldb + C) * 2u; }
    const size_t kstep = (size_t)(BK * 2);
    const size_t hstepA = (size_t)HALF * g.lda * 2, hstepB = (size_t)HALF * g.ldb * 2;
    const size_t tstepA = 2 * hstepA, tstepB = 2 * hstepB;
    const unsigned ldsw = (unsigned)wid * 1024u;
    const int aoff = lds_byte(wr * 64 + fr, fq * 8), boff = lds_byte(wc * 32 + fr, fq * 8);
#define PG8_SA(b, h) (((b) * 2 + (h)) * HTB)
#define PG8_SB(b, h) ((4 + (b) * 2 + (h)) * HTB)
#define PG8_STAGE(bufoff, gbase, voff) do { _Pragma("unroll") for (int _i = 0; _i < 2; ++_i) \
        __builtin_amdgcn_global_load_lds((const unsigned*)((const char*)(gbase) + (voff)[_i]), (LAS unsigned*)(lds + (bufoff) + ldsw + _i * 8192), 16, 0, 0); } while (0)
#define PG8_LDA(dst, b, h) do { _Pragma("unroll") for (int m = 0; m < 4; ++m) _Pragma("unroll") for (int k = 0; k < 2; ++k) dst[m][k] = *(const LAS bf16x8*)(lds + PG8_SA(b, h) + aoff + m * 2048 + k * 1024); } while (0)
#define PG8_LDB(dst, b, h) do { _Pragma("unroll") for (int n = 0; n < 2; ++n) _Pragma("unroll") for (int k = 0; k < 2; ++k) dst[n][k] = *(const LAS bf16x8*)(lds + PG8_SB(b, h) + boff + n * 2048 + k * 1024); } while (0)
#define PG8_MMA(ai, bj, At, Bt) do { __builtin_amdgcn_s_setprio(1); _Pragma("unroll") for (int m = 0; m < 4; ++m) _Pragma("unroll") for (int n = 0; n < 2; ++n) _Pragma("unroll") for (int k = 0; k < 2; ++k) \
        acc[ai][bj][m][n] = __builtin_amdgcn_mfma_f32_16x16x32_bf16(Bt[n][k], At[m][k], acc[ai][bj][m][n], 0, 0, 0); __builtin_amdgcn_s_setprio(0); } while (0)
#define PG8_WAIT_V(n) asm volatile("s_waitcnt vmcnt(" #n ")" ::: "memory")
#define PG8_WAIT_L(n) asm volatile("s_waitcnt lgkmcnt(" #n ")" ::: "memory")
#define PG8_BAR __builtin_amdgcn_s_barrier()
#define PG8_SCHED __builtin_amdgcn_sched_barrier(0)
    Unit cur, nxt; int ui = 0;
    if (!S.next(0, cur)) return;
    f32x4 acc[2][2][4][2];
#pragma unroll
    for (int a = 0; a < 2; ++a)
#pragma unroll
        for (int b = 0; b < 2; ++b)
#pragma unroll
            for (int m = 0; m < 4; ++m)
#pragma unroll
                for (int n = 0; n < 2; ++n) acc[a][b][m][n] = (f32x4){0.f, 0.f, 0.f, 0.f};
    bf16x8 At[4][2], B0[2][2], B1[2][2];
    const char* cA = (const char*)g.A + (size_t)cur.pm * tstepA + (size_t)cur.z * g.zA; const char* cB = (const char*)g.Bt + (size_t)cur.pn * tstepB + (size_t)cur.z * g.zB;
    PG8_STAGE(PG8_SB(0, 0), cB, voffB); PG8_STAGE(PG8_SB(0, 1), cB + hstepB, voffB); PG8_STAGE(PG8_SA(0, 0), cA, voffA); PG8_STAGE(PG8_SA(0, 1), cA + hstepA, voffA);
    if (wr == 1) PG8_BAR;
    PG8_WAIT_V(2); PG8_BAR;
    PG8_STAGE(PG8_SB(1, 0), cB + kstep, voffB); PG8_STAGE(PG8_SA(1, 0), cA + kstep, voffA); PG8_STAGE(PG8_SB(1, 1), cB + hstepB + kstep, voffB);
    PG8_WAIT_V(6); PG8_BAR;
    for (;;) {
        const bool has_next = S.next(ui + 1, nxt);
        const char* nA = has_next ? (const char*)g.A + (size_t)nxt.pm * tstepA + (size_t)nxt.z * g.zA : cA;
        const char* nB = has_next ? (const char*)g.Bt + (size_t)nxt.pn * tstepB + (size_t)nxt.z * g.zB : cB;
        for (int t = 0; t < nt; t += 2) {
            const bool last = (t == nt - 2);
            const char* a1 = cA + (size_t)(t + 1) * kstep;
            const char* a2 = last ? nA : cA + (size_t)(t + 2) * kstep; const char* b2 = last ? nB : cB + (size_t)(t + 2) * kstep;
            const char* a3 = a2 + kstep; const char* b3 = b2 + kstep;
            PG8_LDB(B0, 0, 0); PG8_LDB(B1, 0, 1); PG8_SCHED; PG8_LDA(At, 0, 0); PG8_STAGE(PG8_SA(1, 1), a1 + hstepA, voffA);
            PG8_WAIT_V(8); PG8_WAIT_L(0); PG8_BAR; PG8_MMA(0, 0, At, B0); PG8_MMA(0, 1, At, B1); PG8_BAR; PG8_SCHED;
            PG8_LDA(At, 0, 1); PG8_STAGE(PG8_SB(0, 0), b2, voffB); PG8_STAGE(PG8_SB(0, 1), b2 + hstepB, voffB); PG8_STAGE(PG8_SA(0, 0), a2, voffA);
            PG8_WAIT_V(8); PG8_WAIT_L(0); PG8_BAR; PG8_MMA(1, 0, At, B0); PG8_MMA(1, 1, At, B1); PG8_BAR; PG8_SCHED;
            PG8_LDB(B0, 1, 0); PG8_LDB(B1, 1, 1); PG8_SCHED; PG8_LDA(At, 1, 0); PG8_STAGE(PG8_SA(0, 1), a2 + hstepA, voffA);
            PG8_WAIT_V(8); PG8_WAIT_L(0); PG8_BAR; PG8_MMA(0, 0, At, B0); PG8_MMA(0, 1, At, B1); PG8_BAR; PG8_SCHED;
            PG8_LDA(At, 1, 1); PG8_STAGE(PG8_SB(1, 0), b3, voffB); PG8_STAGE(PG8_SB(1, 1), b3 + hstepB, voffB); PG8_STAGE(PG8_SA(1, 0), a3, voffA);
            PG8_WAIT_V(8); PG8_WAIT_L(0); PG8_BAR; PG8_MMA(1, 0, At, B0); PG8_MMA(1, 1, At, B1); PG8_BAR; PG8_SCHED;
        }
        if (wr == 0) PG8_BAR;
        E(acc, cur, wr, wc, fr, fq);
        if (!has_next) break;
#pragma unroll
        for (int a = 0; a < 2; ++a)
#pragma unroll
            for (int b = 0; b < 2; ++b)
#pragma unroll
                for (int m = 0; m < 4; ++m)
#pragma unroll
                    for (int n = 0; n < 2; ++n) acc[a][b][m][n] = (f32x4){0.f, 0.f, 0.f, 0.f};
        cur = nxt; cA = nA; cB = nB; ++ui;
        if (wr == 1) PG8_BAR;
    }
    PG8_WAIT_V(0);
    PG8_BAR;
#undef PG8_SA
#undef PG8_SB
#undef PG8_STAGE
#undef PG8_LDA
#undef PG8_LDB
#undef PG8_MMA
#undef PG8_WAIT_V
#undef PG8_WAIT_L
#undef PG8_BAR
#undef PG8_SCHED
}

#define EPI_ROW0(u) ((u).pm * BM + wr * 64 + fr)
#define EPI_COL0(u) ((u).pn * BM + wc * 32 + 8 * fq)

struct EpiZ {
    bf16_t* Zp; const float* rstd;
    __device__ __forceinline__ void operator()(const f32x4 (&acc)[2][2][4][2], const Unit& u, int wr, int wc, int fr, int fq) const {
        const int row0 = EPI_ROW0(u), col0 = EPI_COL0(u);
#pragma unroll
        for (int ai = 0; ai < 2; ++ai)
#pragma unroll
            for (int m = 0; m < 4; ++m) { const int row = row0 + ai * HALF + m * 16; const float s = 1.f; bf16_t* rp = Zp + (size_t)row * NZ + col0;
#pragma unroll
                for (int bj = 0; bj < 2; ++bj) { const f32x4 v0 = acc[ai][bj][m][0] * s, v1 = acc[ai][bj][m][1] * s; u32x4 w;
                    w.x = cvt_pk_bf16(v0[0], v0[1]); w.y = cvt_pk_bf16(v0[2], v0[3]); w.z = cvt_pk_bf16(v1[0], v1[1]); w.w = cvt_pk_bf16(v1[2], v1[3]);
                    *(u32x4*)(rp + bj * HALF) = w; } }
    }
};
struct EpiQK {
    bf16_t* Qp; bf16_t* Kp;
    __device__ __forceinline__ void operator()(const f32x4 (&acc)[2][2][4][2], const Unit& u, int wr, int wc, int fr, int fq) const {
        const int row0 = EPI_ROW0(u), col0 = wc * 32 + 8 * fq; bf16_t* base = (u.pn ? Kp : Qp) + (size_t)u.z * M * 256;
#pragma unroll
        for (int ai = 0; ai < 2; ++ai)
#pragma unroll
            for (int m = 0; m < 4; ++m) { const int row = row0 + ai * HALF + m * 16; bf16_t* rp = base + (size_t)row * 256 + col0;
#pragma unroll
                for (int bj = 0; bj < 2; ++bj) { const f32x4 v0 = acc[ai][bj][m][0], v1 = acc[ai][bj][m][1]; u32x4 w;
                    w.x = cvt_pk_bf16(v0[0], v0[1]); w.y = cvt_pk_bf16(v0[2], v0[3]); w.z = cvt_pk_bf16(v1[0], v1[1]); w.w = cvt_pk_bf16(v1[2], v1[3]);
                    *(u32x4*)(rp + bj * HALF) = w; } }
    }
};
struct EpiT {
    bf16_t* Op; const float* wk;
    __device__ __forceinline__ void operator()(const f32x4 (&acc)[2][2][4][2], const Unit& u, int wr, int wc, int fr, int fq) const {
        const int row0 = wr * 64 + fr, col0 = EPI_COL0(u);
#pragma unroll
        for (int ai = 0; ai < 2; ++ai)
#pragma unroll
            for (int m = 0; m < 4; ++m) { const int row = row0 + ai * HALF + m * 16;
#pragma unroll
                for (int bj = 0; bj < 2; ++bj) { const int tok = col0 + bj * HALF, b = tok >> 11, c = (tok >> 6) & 31, s_ = tok & 63;
                    bf16_t* rp = Op + ((((size_t)(b * 4 + u.z) * 32 + c) * 256 + row) * 64 + s_);
                    f32x4 v0 = acc[ai][bj][m][0], v1 = acc[ai][bj][m][1]; u32x4 w;
                    if (wk) { const float* wp = wk + (size_t)(b * 4 + u.z) * T + (tok & (T - 1)); v0 = v0 * *(const f32x4*)wp; v1 = v1 * *(const f32x4*)(wp + 4); }
                    w.x = cvt_pk_bf16(v0[0], v0[1]); w.y = cvt_pk_bf16(v0[2], v0[3]); w.z = cvt_pk_bf16(v1[0], v1[1]); w.w = cvt_pk_bf16(v1[2], v1[3]);
                    *(u32x4*)rp = w; } }
    }
};
struct EpiPlain {
    bf16_t* Op; int ldc;
    __device__ __forceinline__ void operator()(const f32x4 (&acc)[2][2][4][2], const Unit& u, int wr, int wc, int fr, int fq) const {
        const int row0 = EPI_ROW0(u), col0 = EPI_COL0(u);
#pragma unroll
        for (int ai = 0; ai < 2; ++ai)
#pragma unroll
            for (int m = 0; m < 4; ++m) { const int row = row0 + ai * HALF + m * 16; bf16_t* rp = Op + (size_t)row * ldc + col0;
#pragma unroll
                for (int bj = 0; bj < 2; ++bj) { const f32x4 v0 = acc[ai][bj][m][0], v1 = acc[ai][bj][m][1]; u32x4 w;
                    w.x = cvt_pk_bf16(v0[0], v0[1]); w.y = cvt_pk_bf16(v0[2], v0[3]); w.z = cvt_pk_bf16(v1[0], v1[1]); w.w = cvt_pk_bf16(v1[2], v1[3]);
                    *(u32x4*)(rp + bj * HALF) = w; } }
    }
};
template <int MODE> struct EpiRes {
    const float* xp; const float* xs; const bf16_t* XI; bf16_t* XO; float* ss;
    __device__ __forceinline__ void operator()(const f32x4 (&acc)[2][2][4][2], const Unit& u, int wr, int wc, int fr, int fq) const {
        const int row0 = EPI_ROW0(u), col0 = EPI_COL0(u);
#pragma unroll
        for (int ai = 0; ai < 2; ++ai)
#pragma unroll
            for (int m = 0; m < 4; ++m) { const int row = row0 + ai * HALF + m * 16;
                float q = 0.f;
                if (row < MR) {
#pragma unroll
                    for (int bj = 0; bj < 2; ++bj) { const int c = col0 + bj * HALF;
                        f32x4 b0, b1;
                        if (MODE == 0) { const float* bp = row < MP ? xp + (size_t)row * D : xs + (size_t)(row - MP) * D; b0 = *(const f32x4*)(bp + c); b1 = *(const f32x4*)(bp + c + 4); }
                        else { const u32x4 w = *(const u32x4*)(XI + (size_t)row * D + c); b0 = (f32x4){bflo(w.x), bfhi(w.x), bflo(w.y), bfhi(w.y)}; b1 = (f32x4){bflo(w.z), bfhi(w.z), bflo(w.w), bfhi(w.w)}; }
                        const f32x4 v0 = acc[ai][bj][m][0] + b0, v1 = acc[ai][bj][m][1] + b1;
                        u32x4 w; w.x = cvt_pk_bf16(v0[0], v0[1]); w.y = cvt_pk_bf16(v0[2], v0[3]); w.z = cvt_pk_bf16(v1[0], v1[1]); w.w = cvt_pk_bf16(v1[2], v1[3]);
                        *(u32x4*)(XO + (size_t)row * D + c) = w;
                        q += (v0[0] * v0[0] + v0[1] * v0[1]) + (v0[2] * v0[2] + v0[3] * v0[3]) + (v1[0] * v1[0] + v1[1] * v1[1]) + (v1[2] * v1[2] + v1[3] * v1[3]); }
                }
                q += __shfl_xor(q, 16); q += __shfl_xor(q, 32);
                if (fq == 0 && row < MR) atomicAdd(ss + row, q);
            }
    }
};
struct EpiGU {
    bf16_t* Hp; const float* ss;
    __device__ __forceinline__ void operator()(const f32x4 (&acc)[2][2][4][2], const Unit& u, int wr, int wc, int fr, int fq) const {
        const int row0 = EPI_ROW0(u), col0 = u.pn * HALF + wc * 32 + 8 * fq;
#pragma unroll
        for (int ai = 0; ai < 2; ++ai)
#pragma unroll
            for (int m = 0; m < 4; ++m) { const int row = row0 + ai * HALF + m * 16; const float s = __builtin_amdgcn_rsqf(ss[row] * (1.f / D) + EPS);
                float o[8];
#pragma unroll
                for (int n = 0; n < 2; ++n)
#pragma unroll
                    for (int i = 0; i < 4; ++i) { const float gv = acc[ai][0][m][n][i] * s, uv = acc[ai][1][m][n][i] * s; o[n * 4 + i] = gv * sigmoidf_(gv) * uv; }
                u32x4 w; w.x = cvt_pk_bf16(o[0], o[1]); w.y = cvt_pk_bf16(o[2], o[3]); w.z = cvt_pk_bf16(o[4], o[5]); w.w = cvt_pk_bf16(o[6], o[7]);
                *(u32x4*)(Hp + (size_t)row * DFF + col0) = w; }
    }
};
struct EpiPle {
    const bf16_t* XI; bf16_t* XO; const bf16_t* PEp; const float* ss2; float* ss3;
    __device__ __forceinline__ void operator()(const f32x4 (&acc)[2][2][4][2], const Unit& u, int wr, int wc, int fr, int fq) const {
        const int row0 = EPI_ROW0(u), col0 = EPI_COL0(u);
#pragma unroll
        for (int ai = 0; ai < 2; ++ai)
#pragma unroll
            for (int m = 0; m < 4; ++m) { const int row = row0 + ai * HALF + m * 16;
                float q = 0.f;
                if (row < MR) {
                    const float s = __builtin_amdgcn_rsqf(ss2[row] * (1.f / D) + EPS);
#pragma unroll
                    for (int bj = 0; bj < 2; ++bj) { const int c = col0 + bj * HALF;
                        float xb[8], pe[8];
                        unpack8x(*(const u32x4*)(XI + (size_t)row * D + c), xb); unpack8x(*(const u32x4*)(PEp + (size_t)row * D + c), pe);
                        float v[8];
#pragma unroll
                        for (int i = 0; i < 4; ++i) { v[i] = xb[i] + sigmoidf_(acc[ai][bj][m][0][i] * s) * pe[i]; v[4 + i] = xb[4 + i] + sigmoidf_(acc[ai][bj][m][1][i] * s) * pe[4 + i]; }
                        u32x4 w; w.x = cvt_pk_bf16(v[0], v[1]); w.y = cvt_pk_bf16(v[2], v[3]); w.z = cvt_pk_bf16(v[4], v[5]); w.w = cvt_pk_bf16(v[6], v[7]);
                        *(u32x4*)(XO + (size_t)row * D + c) = w;
#pragma unroll
                        for (int i = 0; i < 8; ++i) q += v[i] * v[i]; }
                }
                q += __shfl_xor(q, 16); q += __shfl_xor(q, 32);
                if (fq == 0 && row < MR) atomicAdd(ss3 + row, q);
            }
    }
};
}

#define MFMA16(a, b, c) __builtin_amdgcn_mfma_f32_16x16x32_bf16((a), (b), (c), 0, 0, 0)
__device__ __forceinline__ float log_sigmoid_(float f) { return fminf(f, 0.f) - log1pf(__expf(-fabsf(f))); }
__device__ __forceinline__ void unpack8(const u32x4 w, float (&o)[8]) { o[0] = bflo(w.x); o[1] = bfhi(w.x); o[2] = bflo(w.y); o[3] = bfhi(w.y); o[4] = bflo(w.z); o[5] = bfhi(w.z); o[6] = bflo(w.w); o[7] = bfhi(w.w); }
__device__ __forceinline__ u32x4 pack8(const float (&o)[8]) { u32x4 w; w.x = pk2(o[0], o[1]); w.y = pk2(o[2], o[3]); w.z = pk2(o[4], o[5]); w.w = pk2(o[6], o[7]); return w; }

struct TJob { const float* W; int ldw, col0; bf16_t* WT; int drow0, ldt; const float* gk; float scal; int k0; };
__device__ __forceinline__ void transpose_load(const TJob& j, float (&wv)[32], float& g0, int lane) {
#pragma unroll
    for (int i = 0; i < 32; ++i) { const int kk = 2 * i + (lane >> 5); wv[i] = j.W[(size_t)(j.k0 + kk) * j.ldw + j.col0 + (lane & 31)]; }
    g0 = j.gk ? j.gk[j.k0 + (lane >> 5) + 2 * (lane & 31)] : 1.f;
}
__device__ __forceinline__ void transpose_finish(const TJob& j, const float (&wv)[32], float g0, LAS float* scr, int lane) {
#pragma unroll
    for (int i = 0; i < 32; ++i) { const int kk = 2 * i + (lane >> 5); const float gg = __shfl(g0, (lane & 32) + i) * j.scal;
        scr[kk * 33 + (lane & 31)] = wv[i] * gg; }
    asm volatile("s_waitcnt lgkmcnt(0)" ::: "memory");
    const int c = lane & 7;
#pragma unroll
    for (int q = 0; q < 4; ++q) { const int n = (lane >> 3) + 8 * q; const LAS float* sp = scr + (8 * c) * 33 + n;
        u32x4 o; o.x = pk2(sp[0 * 33], sp[1 * 33]); o.y = pk2(sp[2 * 33], sp[3 * 33]); o.z = pk2(sp[4 * 33], sp[5 * 33]); o.w = pk2(sp[6 * 33], sp[7 * 33]);
        *(u32x4*)(j.WT + (size_t)(j.drow0 + n) * j.ldt + j.k0 + 8 * c) = o; }
    asm volatile("s_waitcnt lgkmcnt(0)" ::: "memory");
}

__device__ __forceinline__ void p0_prologue(const Args& a, LAS unsigned char* lds, int G) {
    int tid = threadIdx.x; asm volatile("" : "+v"(tid)); const int lane = tid & 63, wave = tid >> 6;
    unsigned char* ws = a.ws + opq0();
    float* sm = (float*)(ws + WS_SMALL);
    const int gw = blockIdx.x * 8 + wave, NGW = G * 8;
    LAS float* scr = (LAS float*)(lds + wave * 16384);
    constexpr int I0 = 16 * 96, I1 = 16 * 64, I2 = 16 * 32, I3 = 16 * 88, I4 = I3, I5 = 44 * 32, I6 = 16 * 32, I7 = 4 * 32, I8 = 4 * 32, I9 = I8, I10 = I8, I11 = 8 * 8, I12 = I11;
    constexpr int NIT = I0 + I1 + I2 + I3 + I4 + I5 + I6 + I7 + I8 + I9 + I10 + I11 + I12;
    auto decode = [&](int it) -> TJob {
        int r = it;
        if (r < I0) { const int kb = r / 96, nb = r % 96; return TJob{INP(11), NIN, nb * 32, (bf16_t*)(ws + WS_W1T), nb * 32, D, INP(10), 1.f, kb * 64}; } r -= I0;
        if (r < I1) { const int kb = r / 64, nb = r % 64; return TJob{INP(11), NIN, 3080 + nb * 32, (bf16_t*)(ws + WS_W1T), 3072 + nb * 32, D, INP(10), 1.f, kb * 64}; } r -= I1;
        if (r < I2) { const int kb = r / 32, nb = r % 32; return TJob{INP(26), D, nb * 32, (bf16_t*)(ws + WS_WOT), nb * 32, D, nullptr, 1.f, kb * 64}; } r -= I2;
        if (r < I3) { const int kb = r / 88, nb = r % 88, n0 = nb * 32; return TJob{INP(28), DFF, n0, (bf16_t*)(ws + WS_WGUT), (n0 / 128) * 256 + (n0 % 128), D, INP(27), 1.f, kb * 64}; } r -= I3;
        if (r < I4) { const int kb = r / 88, nb = r % 88, n0 = nb * 32; return TJob{INP(29), DFF, n0, (bf16_t*)(ws + WS_WGUT), (n0 / 128) * 256 + 128 + (n0 % 128), D, INP(27), 1.f, kb * 64}; } r -= I4;
        if (r < I5) { const int kb = r / 32, nb = r % 32; return TJob{INP(30), D, nb * 32, (bf16_t*)(ws + WS_WDT), nb * 32, DFF, nullptr, 1.f, kb * 64}; } r -= I5;
        if (r < I6) { const int kb = r / 32, nb = r % 32; return TJob{INP(32), D, nb * 32, (bf16_t*)(ws + WS_WPGT), nb * 32, D, INP(31), 1.f, kb * 64}; } r -= I6;
        if (r < I7) { const int kb = r / 32, nb = r % 32; return TJob{INP(33), D, nb * 32, (bf16_t*)(ws + WS_WPT), nb * 32, PD, nullptr, 1.f, kb * 64}; } r -= I7;
        if (r < I8) { const int h = r / 32, q = r % 32, kb = q / 8, nb = q % 8; return TJob{INP(22) + (size_t)h * 65536, HD, nb * 32, (bf16_t*)(ws + WS_WQKT) + (size_t)h * 512 * 256, nb * 32, HD, nullptr, 0.0625f, kb * 64}; } r -= I8;
        if (r < I9) { const int h = r / 32, q = r % 32, kb = q / 8, nb = q % 8; return TJob{INP(23) + (size_t)h * 65536, HD, nb * 32, (bf16_t*)(ws + WS_WQKT) + (size_t)h * 512 * 256, 256 + nb * 32, HD, nullptr, 1.f, kb * 64}; } r -= I9;
        if (r < I10) { const int h = r / 32, q = r % 32, kb = q / 8, nb = q % 8; return TJob{INP(24) + (size_t)h * 65536, HD, nb * 32, (bf16_t*)(ws + WS_WVT) + (size_t)h * 65536, nb * 32, HD, nullptr, 1.f, kb * 64}; } r -= I10;
        if (r < I11) { const int bl = r / 8, q = r % 8, kb = q / 4, nb = q % 4; return TJob{INP(15) + (size_t)bl * 16384, 128, nb * 32, (bf16_t*)(ws + WS_WLRUT) + (size_t)bl * 256 * 128, nb * 32, 128, nullptr, 1.f, kb * 64}; } r -= I11;
        { const int bl = r / 8, q = r % 8, kb = q / 4, nb = q % 4; return TJob{INP(17) + (size_t)bl * 16384, 128, nb * 32, (bf16_t*)(ws + WS_WLRUT) + (size_t)bl * 256 * 128, 128 + nb * 32, 128, nullptr, 1.f, kb * 64}; }
    };
    for (int it = gw; it < NIT; it += 2 * NGW) {
        const bool has1 = it + NGW < NIT;
        const TJob ja = decode(it), jb = decode(has1 ? it + NGW : it);
        float wa_[32], wb_[32], ga, gb;
        transpose_load(ja, wa_, ga, lane);
        if (has1) transpose_load(jb, wb_, gb, lane);
        transpose_finish(ja, wa_, ga, scr, lane);
        if (has1) transpose_finish(jb, wb_, gb, scr, lane);
    }
    __syncthreads();
    LAS float* gwL = (LAS float*)lds;
    for (int i = tid; i < 8192; i += NT) { const int j = i >> 10, k = i & 1023; gwL[i] = INP(10)[k] * INP(11)[(size_t)k * NIN + 3072 + j]; }
    __syncthreads();
    bf16_t* XB = (bf16_t*)(ws + WS_XB);
    {
        f32x4 v[4], vn[4];
        if (gw < MR) { const f32x4* xr = (const f32x4*)xrow_ptr(a, gw) + lane;
#pragma unroll
            for (int j = 0; j < 4; ++j) v[j] = xr[64 * j]; }
        for (int row = gw; row < M; row += NGW) {
            unsigned long long* o8 = (unsigned long long*)(XB + (size_t)row * D) + lane;
            const int rn = row + NGW;
            if (rn < MR) { const f32x4* xr = (const f32x4*)xrow_ptr(a, rn) + lane;
#pragma unroll
                for (int j = 0; j < 4; ++j) vn[j] = xr[64 * j]; }
            if (row >= MR) {
#pragma unroll
                for (int j = 0; j < 4; ++j) o8[64 * j] = 0ull;
                if (lane == 0) sm[SM_RSTD0 + row] = 0.f;
            } else {
                float s = 0.f;
#pragma unroll
                for (int j = 0; j < 4; ++j) s += (v[j].x * v[j].x + v[j].y * v[j].y) + (v[j].z * v[j].z + v[j].w * v[j].w);
                float dt[8];
#pragma unroll
                for (int jj = 0; jj < 8; ++jj) { float d = 0.f;
#pragma unroll
                    for (int j = 0; j < 4; ++j) { const f32x4 w = *(const LAS f32x4*)(gwL + jj * 1024 + j * 256 + lane * 4); d += (v[j].x * w.x + v[j].y * w.y) + (v[j].z * w.z + v[j].w * w.w); }
                    dt[jj] = wave_sum(d); }
                s = wave_sum(s);
                const float rstd = 1.0f / sqrtf(s * (1.f / D) + EPS);
#pragma unroll
                for (int j = 0; j < 4; ++j) o8[64 * j] = (unsigned long long)pk2(v[j].x * rstd, v[j].y * rstd) | ((unsigned long long)pk2(v[j].z * rstd, v[j].w * rstd) << 32);
                if (lane == 0) { sm[SM_RSTD0 + row] = rstd;
#pragma unroll
                    for (int jj = 0; jj < 4; ++jj) { sm[SM_GI + row * 4 + jj] = dt[jj] * rstd + INP(12)[jj]; sm[SM_GF + row * 4 + jj] = dt[4 + jj] * rstd + INP(12)[4 + jj]; } }
            }
#pragma unroll
            for (int j = 0; j < 4; ++j) v[j] = vn[j];
        }
    }
    const int gt = blockIdx.x * NT + tid, NGT = G * NT;
    bf16_t* PB = (bf16_t*)(ws + WS_PB);
    for (int i0 = gt; i0 < M * (PD / 4); i0 += 4 * NGT) { asm volatile("" : "+v"(i0));
        f32x4 pv[4];
#pragma unroll
        for (int q = 0; q < 4; ++q) { const int i = i0 + q * NGT, row = i >> 6, c4 = (i & 63) * 4; pv[q] = (f32x4){0.f, 0.f, 0.f, 0.f};
            if (row < MP) pv[q] = *(const f32x4*)(INP(8) + (size_t)row * PD + c4); else if (row < MR) pv[q] = *(const f32x4*)(INP(9) + (size_t)(row - MP) * PD + c4); }
#pragma unroll
        for (int q = 0; q < 4; ++q) { const int i = i0 + q * NGT, row = i >> 6, c4 = (i & 63) * 4;
            if (row < M) *(unsigned long long*)(PB + (size_t)row * PD + c4) = (unsigned long long)pk2(pv[q].x, pv[q].y) | ((unsigned long long)pk2(pv[q].z, pv[q].w) << 32); } }
    for (int i = gt; i < 3 * M; i += NGT) { sm[SM_SS1 + i] = 0.f; asm volatile("" : "+v"(i)); }
}

#define LBAR() do { asm volatile("s_waitcnt lgkmcnt(0)" ::: "memory"); __builtin_amdgcn_s_barrier(); asm volatile("" ::: "memory"); } while (0)
__device__ __forceinline__ void p2a_item(const Args& a, LAS unsigned char* lds, int idx) {
    int tid = threadIdx.x; asm volatile("" : "+v"(tid)); const int lane = tid & 63, wave = tid >> 6;
    unsigned char* ws = a.ws + opq0(); float* sm = (float*)(ws + WS_SMALL);
    const bf16_t* Z = (const bf16_t*)(ws + WS_Z); bf16_t* XC = (bf16_t*)(ws + WS_XC);
    if (idx >= 2048) {
        const int sb = idx - 2048, row = MP + sb;
#pragma unroll
        for (int cc = 0; cc < 2; ++cc) { const int ch = tid * 2 + cc;
            { const float s0 = INP(2)[((size_t)sb * 3 + 0) * D + ch], s1 = INP(2)[((size_t)sb * 3 + 1) * D + ch], s2 = INP(2)[((size_t)sb * 3 + 2) * D + ch], xv = bf2f(Z[(size_t)row * NZ + ch]);
              const float o = INP(14)[ch] + INP(13)[ch] * s0 + INP(13)[D + ch] * s1 + INP(13)[2 * D + ch] * s2 + INP(13)[3 * D + ch] * xv;
              sm[SM_XLS + sb * D + ch] = o;
              a.out[O_SLC + ((size_t)sb * 3 + 0) * D + ch] = s1; a.out[O_SLC + ((size_t)sb * 3 + 1) * D + ch] = s2; a.out[O_SLC + ((size_t)sb * 3 + 2) * D + ch] = xv; }
            { const float s0 = INP(4)[((size_t)sb * 3 + 0) * D + ch], s1 = INP(4)[((size_t)sb * 3 + 1) * D + ch], s2 = INP(4)[((size_t)sb * 3 + 2) * D + ch], xv = bf2f(Z[(size_t)row * NZ + 1024 + ch]);
              const float o = INP(21)[ch] + INP(20)[ch] * s0 + INP(20)[D + ch] * s1 + INP(20)[2 * D + ch] * s2 + INP(20)[3 * D + ch] * xv;
              XC[(size_t)row * D + ch] = (bf16_t)f2bf(o * sigmoidf_(o));
              a.out[O_SMC + ((size_t)sb * 3 + 0) * D + ch] = s1; a.out[O_SMC + ((size_t)sb * 3 + 1) * D + ch] = s2; a.out[O_SMC + ((size_t)sb * 3 + 2) * D + ch] = xv; }
        }
        return;
    }
    const int cb = idx & 7, tt = (idx >> 3) & 31, b = idx >> 8;
    LAS bf16_t* AL = (LAS bf16_t*)lds;
    LAS float* U = (LAS float*)(lds + 17408);
    LAS float* AA = (LAS float*)(lds + 17408 + 32768);
    const int t0 = tt * 64, tokb = b * T;
    {
        const int c8 = tid & 15, rs = tid >> 4, chl = cb * 128 + c8 * 8;
        float wl[4][8], wm[4][8], bl[8], bm[8];
#pragma unroll
        for (int j = 0; j < 4; ++j)
#pragma unroll
            for (int i = 0; i < 8; ++i) { wl[j][i] = INP(13)[j * D + chl + i]; wm[j][i] = INP(20)[j * D + chl + i]; }
#pragma unroll
        for (int i = 0; i < 8; ++i) { bl[i] = INP(14)[chl + i]; bm[i] = INP(21)[chl + i]; }
#pragma unroll
        for (int rr = 0; rr < 2; ++rr) { const int tl = rs + 32 * rr, tg = t0 + tl;
            float ol[8], om[8], xl3[8], xm3[8];
#pragma unroll
            for (int i = 0; i < 8; ++i) { ol[i] = bl[i]; om[i] = bm[i]; xl3[i] = 0.f; xm3[i] = 0.f; }
#pragma unroll
            for (int j = 0; j < 4; ++j) { const int ts = tg - 3 + j;
                if (ts >= 0) { float xl[8], xm[8];
                    unpack8(*(const u32x4*)(Z + (size_t)(tokb + ts) * NZ + chl), xl); unpack8(*(const u32x4*)(Z + (size_t)(tokb + ts) * NZ + 1024 + chl), xm);
#pragma unroll
                    for (int i = 0; i < 8; ++i) { ol[i] += wl[j][i] * xl[i]; om[i] += wm[j][i] * xm[i]; if (j == 3) { xl3[i] = xl[i]; xm3[i] = xm[i]; } } } }
            *(LAS u32x4*)(AL + tl * 136 + c8 * 8) = pack8(ol);
            *(LAS f32x4*)(U + tl * 128 + c8 * 8) = (f32x4){ol[0], ol[1], ol[2], ol[3]}; *(LAS f32x4*)(U + tl * 128 + c8 * 8 + 4) = (f32x4){ol[4], ol[5], ol[6], ol[7]};
            float xs[8];
#pragma unroll
            for (int i = 0; i < 8; ++i) xs[i] = om[i] * sigmoidf_(om[i]);
            *(u32x4*)(XC + (size_t)(tokb + tg) * D + chl) = pack8(xs);
            if (tg >= T - 3) { const int j3 = tg - (T - 3);
#pragma unroll
                for (int i = 0; i < 8; ++i) { a.out[O_PLC + ((size_t)b * 3 + j3) * D + chl + i] = xl3[i]; a.out[O_PMC + ((size_t)b * 3 + j3) * D + chl + i] = xm3[i]; } }
        }
    }
    __syncthreads();
    {
        const int fr = lane & 15, fq = lane >> 4;
        const bf16_t* Wl = (const bf16_t*)(ws + WS_WLRUT) + (size_t)cb * 256 * 128;
        f32x4 ar[4], ai[4];
#pragma unroll
        for (int m = 0; m < 4; ++m) { ar[m] = (f32x4){0.f, 0.f, 0.f, 0.f}; ai[m] = (f32x4){0.f, 0.f, 0.f, 0.f}; }
#pragma unroll
        for (int ks = 0; ks < 4; ++ks) {
            const bf16x8 br = *(const bf16x8*)(Wl + (size_t)(16 * wave + fr) * 128 + ks * 32 + fq * 8);
            const bf16x8 bi = *(const bf16x8*)(Wl + (size_t)(128 + 16 * wave + fr) * 128 + ks * 32 + fq * 8);
#pragma unroll
            for (int m = 0; m < 4; ++m) { const bf16x8 af = *(const LAS bf16x8*)(AL + (m * 16 + fr) * 136 + ks * 32 + fq * 8);
                ar[m] = MFMA16(af, br, ar[m]); ai[m] = MFMA16(af, bi, ai[m]); }
        }
        const int c = 16 * wave + fr, ch = cb * 128 + c;
        const float ba = INP(16)[ch], bx = INP(18)[ch], lam = INP(19)[ch];
        const float sp = fmaxf(-lam, 0.f) + log1pf(__expf(-fabsf(lam)));
#pragma unroll
        for (int m = 0; m < 4; ++m)
#pragma unroll
            for (int j = 0; j < 4; ++j) { const int t = m * 16 + fq * 4 + j;
                const float r = sigmoidf_(ar[m][j] + ba), ig = sigmoidf_(ai[m][j] + bx);
                const float la = -8.0f * r * sp, av = fexp_(la);
                const float uv = __builtin_amdgcn_sqrtf(fmaxf(1.f - av * av, 0.f)) * ig * U[t * 128 + c];
                AA[t * 128 + c] = av; U[t * 128 + c] = uv; }
    }
    __syncthreads();
    {
        const int c = tid & 127, seg = tid >> 7;
        float h = 0.f, P = 1.f;
#pragma unroll
        for (int i = 0; i < 16; ++i) { const int t = seg * 16 + i; const float av = AA[t * 128 + c], uv = U[t * 128 + c]; h = av * h + uv; P *= av; U[t * 128 + c] = h; AA[t * 128 + c] = P; }
        __syncthreads();
        float hc = 0.f, pc = 1.f;
        for (int s = 0; s < seg; ++s) { const int te = s * 16 + 15; const float pe = AA[te * 128 + c]; hc = pe * hc + U[te * 128 + c]; pc *= pe; }
        __syncthreads();
        if (seg > 0) {
#pragma unroll
            for (int i = 0; i < 16; ++i) { const int t = seg * 16 + i; const float pv = AA[t * 128 + c]; U[t * 128 + c] += pv * hc; AA[t * 128 + c] = pv * pc; }
        }
    }
    __syncthreads();
    {
        const int c8 = tid & 15, rs = tid >> 4, chl = cb * 128 + c8 * 8;
        bf16_t* HL = (bf16_t*)(ws + WS_HLOC); bf16_t* CA = (bf16_t*)(ws + WS_CUMA);
#pragma unroll
        for (int rr = 0; rr < 2; ++rr) { const int tl = rs + 32 * rr; float hv[8], cv[8];
#pragma unroll
            for (int i = 0; i < 8; ++i) { hv[i] = U[tl * 128 + c8 * 8 + i]; cv[i] = AA[tl * 128 + c8 * 8 + i]; }
            *(u32x4*)(HL + (size_t)(tokb + t0 + tl) * D + chl) = pack8(hv); *(u32x4*)(CA + (size_t)(tokb + t0 + tl) * D + chl) = pack8(cv); }
        if (tid < 128) { sm[SM_LRA + (b * 32 + tt) * D + cb * 128 + tid] = AA[63 * 128 + tid]; sm[SM_LRH + (b * 32 + tt) * D + cb * 128 + tid] = U[63 * 128 + tid]; }
    }
    __syncthreads();
}

__device__ __forceinline__ void p2_zload(const bf16_t* Z, int idx, int tid, u32x4 (&zr)[5]) {
    const int cb = idx & 7, tt = (idx >> 3) & 31, b = idx >> 8, t0 = tt * 64, tokb = b * T;
#pragma unroll
    for (int q = 0; q < 5; ++q) { const int p = tid + NT * q, r = p >> 5, pp = p & 31, ts = t0 - 3 + r;
        zr[q] = (u32x4){0u, 0u, 0u, 0u};
        if (r < 67 && ts >= 0) zr[q] = *(const u32x4*)(Z + (size_t)(tokb + ts) * NZ + (pp >> 4) * 1024 + cb * 128 + (pp & 15) * 8); }
}
__device__ __forceinline__ void p2_phase(const Args& a, LAS unsigned char* lds, int G) {
    int tid = threadIdx.x; asm volatile("" : "+v"(tid)); const int lane = tid & 63, wave = tid >> 6, fr = lane & 15, fq = lane >> 4;
    unsigned char* ws = a.ws + opq0(); float* sm = (float*)(ws + WS_SMALL);
    const bf16_t* Z = (const bf16_t*)(ws + WS_Z); bf16_t* XC = (bf16_t*)(ws + WS_XC);
    LAS bf16_t* AL = (LAS bf16_t*)lds;
    LAS float* U = (LAS float*)(lds + 17408);
    LAS float* AA = (LAS float*)(lds + 17408 + 32768);
    LAS bf16_t* ZT = (LAS bf16_t*)(lds + 82944);
    LAS float* CW = (LAS float*)(lds + 117248);
    int idx = blockIdx.x;
    if (idx >= 2048) return;
    u32x4 zr[5];
    p2_zload(Z, idx, tid, zr);
    int cb_prev = -1;
    bf16x8 br[4], bi[4]; float ba = 0.f, bx = 0.f, sp = 0.f;
    for (; idx < 2048; idx += G) {
        const int cb = idx & 7, tt = (idx >> 3) & 31, b = idx >> 8, t0 = tt * 64, tokb = b * T;
#pragma unroll
        for (int q = 0; q < 5; ++q) { const int p = tid + NT * q, r = p >> 5, pp = p & 31; if (r < 67) *(LAS u32x4*)(ZT + ((pp >> 4) * 67 + r) * 128 + (pp & 15) * 8) = zr[q]; }
        if (cb != cb_prev) {
            for (int i = tid; i < 2 * 5 * 128; i += NT) { const int which = i / 640, j = (i % 640) >> 7, c = i & 127, ch = cb * 128 + c;
                CW[i] = which == 0 ? (j < 4 ? INP(13)[j * D + ch] : INP(14)[ch]) : (j < 4 ? INP(20)[j * D + ch] : INP(21)[ch]); }
            const bf16_t* Wl = (const bf16_t*)(ws + WS_WLRUT) + (size_t)cb * 256 * 128;
#pragma unroll
            for (int ks = 0; ks < 4; ++ks) { br[ks] = *(const bf16x8*)(Wl + (size_t)(16 * wave + fr) * 128 + ks * 32 + fq * 8); bi[ks] = *(const bf16x8*)(Wl + (size_t)(128 + 16 * wave + fr) * 128 + ks * 32 + fq * 8); }
            const int ch = cb * 128 + 16 * wave + fr; const float lam = INP(19)[ch];
            ba = INP(16)[ch]; bx = INP(18)[ch]; sp = fmaxf(-lam, 0.f) + log1pf(__expf(-fabsf(lam)));
            cb_prev = cb;
        }
        if (idx + G < 2048) p2_zload(Z, idx + G, tid, zr);
        LBAR();
        {
            const int c8 = tid & 15, rs = tid >> 4, chl = cb * 128 + c8 * 8;
#pragma unroll
            for (int rr = 0; rr < 2; ++rr) { const int tl = rs + 32 * rr, tg = t0 + tl;
                float ol[8], om[8], xl3[8], xm3[8];
#pragma unroll
                for (int i = 0; i < 8; ++i) { ol[i] = CW[4 * 128 + c8 * 8 + i]; om[i] = CW[640 + 4 * 128 + c8 * 8 + i]; }
#pragma unroll
                for (int j = 0; j < 4; ++j) { float xl[8], xm[8];
                    unpack8(*(const LAS u32x4*)(ZT + (tl + j) * 128 + c8 * 8), xl); unpack8(*(const LAS u32x4*)(ZT + (67 + tl + j) * 128 + c8 * 8), xm);
#pragma unroll
                    for (int i = 0; i < 8; ++i) { ol[i] += CW[j * 128 + c8 * 8 + i] * xl[i]; om[i] += CW[640 + j * 128 + c8 * 8 + i] * xm[i]; if (j == 3) { xl3[i] = xl[i]; xm3[i] = xm[i]; } } }
                *(LAS u32x4*)(AL + tl * 136 + c8 * 8) = pack8(ol);
                *(LAS f32x4*)(U + tl * 128 + c8 * 8) = (f32x4){ol[0], ol[1], ol[2], ol[3]}; *(LAS f32x4*)(U + tl * 128 + c8 * 8 + 4) = (f32x4){ol[4], ol[5], ol[6], ol[7]};
                float xs[8];
#pragma unroll
                for (int i = 0; i < 8; ++i) xs[i] = om[i] * sigmoidf_(om[i]);
                *(u32x4*)(XC + (size_t)(tokb + tg) * D + chl) = pack8(xs);
                if (tg >= T - 3) { const int j3 = tg - (T - 3);
#pragma unroll
                    for (int i = 0; i < 8; ++i) { a.out[O_PLC + ((size_t)b * 3 + j3) * D + chl + i] = xl3[i]; a.out[O_PMC + ((size_t)b * 3 + j3) * D + chl + i] = xm3[i]; } }
            }
        }
        LBAR();
        {
            f32x4 ar[4], ai[4];
#pragma unroll
            for (int m = 0; m < 4; ++m) { ar[m] = (f32x4){0.f, 0.f, 0.f, 0.f}; ai[m] = (f32x4){0.f, 0.f, 0.f, 0.f}; }
#pragma unroll
            for (int ks = 0; ks < 4; ++ks)
#pragma unroll
                for (int m = 0; m < 4; ++m) { const bf16x8 af = *(const LAS bf16x8*)(AL + (m * 16 + fr) * 136 + ks * 32 + fq * 8);
                    ar[m] = MFMA16(af, br[ks], ar[m]); ai[m] = MFMA16(af, bi[ks], ai[m]); }
            const int c = 16 * wave + fr;
            float Aq[4][4], Bq[4][4];
#pragma unroll
            for (int m = 0; m < 4; ++m)
#pragma unroll
                for (int j = 0; j < 4; ++j) { const int t = m * 16 + fq * 4 + j;
                    const float r = sigmoidf_(ar[m][j] + ba), ig = sigmoidf_(ai[m][j] + bx);
                    const float la = -8.0f * r * sp, av = fexp_(la);
                    Aq[m][j] = av; Bq[m][j] = __builtin_amdgcn_sqrtf(fmaxf(1.f - av * av, 0.f)) * ig * U[t * 128 + c]; }
            float Ac = 1.f, Bc = 0.f;
#pragma unroll
            for (int m = 0; m < 4; ++m) {
#pragma unroll
                for (int j = 1; j < 4; ++j) { Bq[m][j] = Aq[m][j] * Bq[m][j - 1] + Bq[m][j]; Aq[m][j] = Aq[m][j] * Aq[m][j - 1]; }
                const float Ra = Aq[m][3], Rb = Bq[m][3];
                float Pa = 1.f, Pb = 0.f, Ga = 1.f, Gb = 0.f;
#pragma unroll
                for (int sgrp = 0; sgrp < 4; ++sgrp) { const float xa = __shfl(Ra, fr + 16 * sgrp), xb = __shfl(Rb, fr + 16 * sgrp);
                    if (sgrp < fq) { Pb = xa * Pb + xb; Pa = xa * Pa; }
                    Gb = xa * Gb + xb; Ga = xa * Ga; }
                const float Qb = Pa * Bc + Pb, Qa = Pa * Ac;
#pragma unroll
                for (int j = 0; j < 4; ++j) { const int t = m * 16 + fq * 4 + j; const float hv = Aq[m][j] * Qb + Bq[m][j], pv = Aq[m][j] * Qa;
                    U[t * 128 + c] = hv; AA[t * 128 + c] = pv;
                    if (m == 3 && j == 3 && fq == 3) { sm[SM_LRA + (b * 32 + tt) * D + cb * 128 + c] = pv; sm[SM_LRH + (b * 32 + tt) * D + cb * 128 + c] = hv; } }
                Bc = Ga * Bc + Gb; Ac = Ga * Ac;
            }
        }
        LBAR();
        {
            const int c8 = tid & 15, rs = tid >> 4, chl = cb * 128 + c8 * 8;
            bf16_t* HL = (bf16_t*)(ws + WS_HLOC); bf16_t* CA = (bf16_t*)(ws + WS_CUMA);
#pragma unroll
            for (int rr = 0; rr < 2; ++rr) { const int tl = rs + 32 * rr; float hv[8], cv[8];
#pragma unroll
                for (int i = 0; i < 8; ++i) { hv[i] = U[tl * 128 + c8 * 8 + i]; cv[i] = AA[tl * 128 + c8 * 8 + i]; }
                *(u32x4*)(HL + (size_t)(tokb + t0 + tl) * D + chl) = pack8(hv); *(u32x4*)(CA + (size_t)(tokb + t0 + tl) * D + chl) = pack8(cv); }
        }
    }
}

__device__ __forceinline__ float block_excl_sum(float v, LAS float* red, int tid) {
    const int lane = tid & 63, wave = tid >> 6; float inc = v;
#pragma unroll
    for (int o = 1; o < 64; o <<= 1) { const float t = __shfl_up(inc, o); if (lane >= o) inc += t; }
    __syncthreads();
    if (lane == 63) red[wave] = inc;
    __syncthreads();
    float base = 0.f;
    for (int w = 0; w < wave; ++w) base += red[w];
    return base + inc - v;
}
__device__ __forceinline__ float block_excl_max(float v, LAS float* red, int tid) {
    const int lane = tid & 63, wave = tid >> 6; float inc = v;
#pragma unroll
    for (int o = 1; o < 64; o <<= 1) { const float t = __shfl_up(inc, o); if (lane >= o) inc = fmaxf(inc, t); }
    __syncthreads();
    if (lane == 63) red[wave] = inc;
    __syncthreads();
    float base = -INFINITY;
    for (int w = 0; w < wave; ++w) base = fmaxf(base, red[w]);
    const float prev = __shfl_up(inc, 1);
    return fmaxf(base, lane > 0 ? prev : -INFINITY);
}
__device__ __forceinline__ void gate_scan(const Args& a, LAS unsigned char* lds, int bh) {
    int tid = threadIdx.x; asm volatile("" : "+v"(tid)); float* sm = (float*)(a.ws + WS_SMALL);
    LAS float* BCl = (LAS float*)lds; LAS float* MMl = BCl + T; LAS float* red = MMl + T;
    const int b = bh >> 2, h = bh & 3;
    float lf[4], ig[4], bc[4], gv[4], pmx[4];
#pragma unroll
    for (int i = 0; i < 4; ++i) { const int row = b * T + tid * 4 + i; lf[i] = log_sigmoid_(sm[SM_GF + row * 4 + h]); ig[i] = sm[SM_GI + row * 4 + h]; }
    const float tot = (lf[0] + lf[1]) + (lf[2] + lf[3]);
    const float ex = block_excl_sum(tot, red, tid);
    float run = ex;
#pragma unroll
    for (int i = 0; i < 4; ++i) { run += lf[i]; bc[i] = run; gv[i] = ig[i] - run; }
    const float lm = fmaxf(fmaxf(gv[0], gv[1]), fmaxf(gv[2], gv[3]));
    const float exm = block_excl_max(lm, red, tid);
    float rm = exm;
#pragma unroll
    for (int i = 0; i < 4; ++i) { rm = fmaxf(rm, gv[i]); pmx[i] = rm; BCl[tid * 4 + i] = bc[i]; MMl[tid * 4 + i] = bc[i] + rm; }
    __syncthreads();
#pragma unroll
    for (int i = 0; i < 4; ++i) { const int t = tid * 4 + i, c = t >> 6;
        const float Bprev = c ? BCl[64 * c - 1] : 0.f, mprev = c ? MMl[64 * c - 1] : M_INIT, Blast = BCl[64 * c + 63], mlast = MMl[64 * c + 63];
        const float mm = bc[i] + pmx[i];
        sm[SM_BM + bh * T + t] = -pmx[i]; sm[SM_GIB + bh * T + t] = gv[i]; sm[SM_MM + bh * T + t] = mm;
        sm[SM_SC + bh * T + t] = __expf(bc[i] - Bprev + mprev - mm);
        sm[SM_WK + bh * T + t] = __expf(Blast - bc[i] + ig[i] - mlast);
        if ((t & 63) == 0) sm[SM_DEC + bh * 32 + c] = __expf(Blast - Bprev + mprev - mlast);
        if (t == T - 1) a.out[O_PM + bh] = mm; }
    __syncthreads();
}

struct P3Ops { bf16x8 vf[2][2]; bf16x8 kf[2][2]; float sc, dec; };
__device__ __forceinline__ void p3_load(P3Ops& o, const bf16_t* Q, const bf16_t* KT, const bf16_t* VT, const float* sm, int b, int h, int bh, int es, int c, int wave, int fr, int fq) {
    const int tok0 = b * T + c * 64, gb = bh * T + c * 64, mt = wave >> 1;
#pragma unroll
    for (int ks = 0; ks < 2; ++ks) {
#pragma unroll
        for (int e = 0; e < 2; ++e) o.vf[ks][e] = *(const bf16x8*)(VT + ((size_t)(bh * 32 + c) * 256 + es * 32 + e * 16 + fr) * 64 + ks * 32 + fq * 8);
#pragma unroll
        for (int d = 0; d < 2; ++d) o.kf[ks][d] = *(const bf16x8*)(KT + ((size_t)(bh * 32 + c) * 256 + 32 * wave + d * 16 + fr) * 64 + ks * 32 + fq * 8);
    }
    o.sc = sm[SM_SC + gb + mt * 16 + fr]; o.dec = sm[SM_DEC + bh * 32 + c];
}
__device__ __forceinline__ void p3_item(const Args& a, LAS unsigned char* lds, int idx) {
    int tid = threadIdx.x; asm volatile("" : "+v"(tid)); const int lane = tid & 63, wave = tid >> 6, fr = lane & 15, fq = lane >> 4;
    unsigned char* ws = a.ws + opq0(); float* sm = (float*)(ws + WS_SMALL);
    const int es = idx & 7, bh = idx >> 3, b = bh >> 2, h = bh & 3;
    const bf16_t* Q = (const bf16_t*)(ws + WS_Q); const bf16_t* KT = (const bf16_t*)(ws + WS_KT); const bf16_t* VT = (const bf16_t*)(ws + WS_VT);
    bf16_t* NUMI = (bf16_t*)(ws + WS_XC);
    const int ii = tid >> 8, q_ = tid & 255, sit = idx * 2 + ii, ssb = sit >> 2, shh = sit & 3, srow = MP + ssb, ssh = ssb * 4 + shh;
    LAS float* SQ = (LAS float*)(lds + 34816) + ii * 256; LAS float* SK = (LAS float*)(lds + 36864) + ii * 256; LAS float* SV = (LAS float*)(lds + 38912) + ii * 256;
    LAS float* SRED = (LAS float*)(lds + 40960) + ii * 1024; LAS float* SR2 = (LAS float*)(lds + 49152) + ii * 16;
    SQ[q_] = bf2f(Q[((size_t)shh * M + srow) * 256 + q_]); SK[q_] = bf2f(((const bf16_t*)(ws + WS_K))[((size_t)shh * M + srow) * 256 + q_]); SV[q_] = bf2f(((const bf16_t*)(ws + WS_VS))[(size_t)ssb * D + shh * 256 + q_]);
    const float s_lf = log_sigmoid_(sm[SM_GF + srow * 4 + shh]), s_ig = sm[SM_GI + srow * 4 + shh], s_m0 = INP(7)[ssh];
    const float s_mn = fmaxf(s_lf + s_m0, s_ig), s_dec = fexp_(s_lf + s_m0 - s_mn), s_wkk = fexp_(s_ig - s_mn);
    const int s_r = q_ >> 6, s_e4 = (q_ & 63) * 4;
    const float* sC0 = INP(5) + (size_t)ssh * 65536 + s_e4; float* sC1 = a.out + O_SC + (size_t)ssh * 65536 + s_e4;
    f32x4 sacc = (f32x4){0.f, 0.f, 0.f, 0.f};
    const int s_ch = shh * 256 + q_;
    LAS float* SXL = (LAS float*)(lds + 49280) + ii * 256;
    SXL[q_] = sm[SM_XLS + ssb * D + s_ch];
    const float* wa = INP(15) + (size_t)(s_ch >> 7) * 16384 + (s_ch & 127); const float* wx = INP(17) + (size_t)(s_ch >> 7) * 16384 + (s_ch & 127);
    float s_rp = INP(16)[s_ch], s_ip = INP(18)[s_ch];
    f32x4 acc[2][2], accn[2];
#pragma unroll
    for (int e = 0; e < 2; ++e)
#pragma unroll
        for (int d = 0; d < 2; ++d) acc[e][d] = (f32x4){0.f, 0.f, 0.f, 0.f};
    accn[0] = (f32x4){0.f, 0.f, 0.f, 0.f}; accn[1] = (f32x4){0.f, 0.f, 0.f, 0.f};
    bf16x8 ones_f; { const short o1 = fr == 0 ? (short)0x3F80 : (short)0; ones_f = (bf16x8){o1, o1, o1, o1, o1, o1, o1, o1}; }
    P3Ops cur, nxt;
    p3_load(cur, Q, KT, VT, sm, b, h, bh, es, 0, wave, fr, fq);
    bf16x8 qf[8];
#pragma unroll
    for (int ks = 0; ks < 8; ++ks) qf[ks] = *(const bf16x8*)(Q + ((size_t)h * M + b * T + 64 + (wave >> 1) * 16 + fr) * 256 + ks * 32 + fq * 8);
    __syncthreads();
    const f32x4 s_v4 = *(const LAS f32x4*)(SV + s_e4);
    for (int c = 0; c < NCH; ++c) {
        const int tok0 = b * T + c * 64;
        LAS bf16_t* CTr = (LAS bf16_t*)(lds + (c & 1) * 16896);
        LAS bf16_t* CTw = (LAS bf16_t*)(lds + ((c + 1) & 1) * 16896);
        p3_load(nxt, Q, KT, VT, sm, b, h, bh, es, c + 1 < NCH ? c + 1 : c, wave, fr, fq);
        const int sd0 = c * 8 + s_r, sd1 = sd0 + 4;
        const f32x4 sc0 = __builtin_nontemporal_load((const f32x4*)(sC0 + (size_t)sd0 * 256)), sc1 = __builtin_nontemporal_load((const f32x4*)(sC0 + (size_t)sd1 * 256));
        float wa4[4], wx4[4];
#pragma unroll
        for (int k = 0; k < 4; ++k) { wa4[k] = wa[(c * 4 + k) * 128]; wx4[k] = wx[(c * 4 + k) * 128]; }
        if (c > 0) {
            const int mt = wave >> 1, et = wave & 1;
            f32x4 ai = (f32x4){0.f, 0.f, 0.f, 0.f};
#pragma unroll
            for (int ks = 0; ks < 8; ++ks) { const bf16x8 cf = *(const LAS bf16x8*)(CTr + (et * 16 + fr) * 264 + ks * 32 + fq * 8); ai = MFMA16(cf, qf[ks], ai); }
            u32x2 w; w.x = pk2(ai[0] * cur.sc, ai[1] * cur.sc); w.y = pk2(ai[2] * cur.sc, ai[3] * cur.sc);
            *(u32x2*)(NUMI + (size_t)(tok0 + mt * 16 + fr) * D + h * 256 + es * 32 + et * 16 + fq * 4) = w;
            const int cq = c + 1 < NCH ? c + 1 : c;
#pragma unroll
            for (int ks = 0; ks < 8; ++ks) qf[ks] = *(const bf16x8*)(Q + ((size_t)h * M + b * T + cq * 64 + mt * 16 + fr) * 256 + ks * 32 + fq * 8);
        }
        if (es == 0 && fq == 0) { sm[SM_NST + (bh * 32 + c) * 256 + 32 * wave + fr] = accn[0][0]; sm[SM_NST + (bh * 32 + c) * 256 + 32 * wave + 16 + fr] = accn[1][0]; }
        const float dec = cur.dec;
#pragma unroll
        for (int e = 0; e < 2; ++e)
#pragma unroll
            for (int d = 0; d < 2; ++d) acc[e][d] = acc[e][d] * dec;
        accn[0] = accn[0] * dec; accn[1] = accn[1] * dec;
#pragma unroll
        for (int ks = 0; ks < 2; ++ks) {
#pragma unroll
            for (int e = 0; e < 2; ++e)
#pragma unroll
                for (int d = 0; d < 2; ++d) acc[e][d] = MFMA16(cur.vf[ks][e], cur.kf[ks][d], acc[e][d]);
            if (es == 0) { accn[0] = MFMA16(ones_f, cur.kf[ks][0], accn[0]); accn[1] = MFMA16(ones_f, cur.kf[ks][1], accn[1]); }
        }
#pragma unroll
        for (int e = 0; e < 2; ++e)
#pragma unroll
            for (int d = 0; d < 2; ++d)
#pragma unroll
                for (int j = 0; j < 4; ++j) CTw[(e * 16 + fq * 4 + j) * 264 + 32 * wave + d * 16 + fr] = (bf16_t)f2bf(acc[e][d][j]);
        {
            const float k0 = SK[sd0] * s_wkk, k1 = SK[sd1] * s_wkk, q0 = SQ[sd0], q1 = SQ[sd1];
            const f32x4 cn0 = sc0 * s_dec + s_v4 * k0, cn1 = sc1 * s_dec + s_v4 * k1;
            __builtin_nontemporal_store(cn0, (f32x4*)(sC1 + (size_t)sd0 * 256)); __builtin_nontemporal_store(cn1, (f32x4*)(sC1 + (size_t)sd1 * 256));
            sacc += cn0 * q0 + cn1 * q1;
#pragma unroll
            for (int k = 0; k < 4; ++k) { const float xv = SXL[(q_ >> 7) * 128 + c * 4 + k]; s_rp += xv * wa4[k]; s_ip += xv * wx4[k]; }
        }
        LBAR();
        cur = nxt;
    }
#pragma unroll
    for (int e = 0; e < 2; ++e)
#pragma unroll
        for (int d = 0; d < 2; ++d) *(f32x4*)(a.out + O_PC + ((size_t)bh * 256 + 32 * wave + d * 16 + fr) * 256 + es * 32 + e * 16 + fq * 4) = acc[e][d];
    if (es == 0 && fq == 0) { a.out[O_PN + bh * 256 + 32 * wave + fr] = accn[0][0]; a.out[O_PN + bh * 256 + 32 * wave + 16 + fr] = accn[1][0]; }
    *(LAS f32x4*)(SRED + s_r * 256 + s_e4) = sacc;
    const float nn = s_dec * INP(6)[ssh * 256 + q_] + s_wkk * SK[q_];
    a.out[O_SN + ssh * 256 + q_] = nn;
    const float dn = wave_sum(SQ[q_] * nn);
    if (lane == 0) SR2[wave & 3] = dn;
    __syncthreads();
    const float den = (SR2[0] + SR2[1]) + (SR2[2] + SR2[3]);
    const float num = (SRED[q_] + SRED[256 + q_]) + (SRED[512 + q_] + SRED[768 + q_]);
    const float hv = num / fmaxf(fabsf(den), fexp_(-s_mn));
    const float hq = wave_sum(hv * hv);
    if (lane == 0) SR2[4 + (wave & 3)] = hq;
    __syncthreads();
    {
        const float rs = 1.0f / sqrtf(((SR2[4] + SR2[5]) + (SR2[6] + SR2[7])) * (1.f / 256.f) + EPS);
        const bf16_t* Z = (const bf16_t*)(ws + WS_Z);
        const int ch = s_ch;
        const float ym = hv * rs * INP(25)[ch] * sigmoidf_(bf2f(Z[(size_t)srow * NZ + 2048 + ch]));
        const float rp = s_rp, ip = s_ip;
        const float lam = INP(19)[ch], sp = fmaxf(-lam, 0.f) + log1pf(__expf(-fabsf(lam)));
        const float r = sigmoidf_(rp), ig = sigmoidf_(ip), la = -8.0f * r * sp, av = fexp_(la);
        const float uv = __builtin_amdgcn_sqrtf(fmaxf(1.f - av * av, 0.f)) * ig * SXL[q_];
        const float hn = av * INP(3)[ssb * D + ch] + uv;
        a.out[O_SLH + ssb * D + ch] = hn;
        const float mg = sigmoidf_(bf2f(Z[(size_t)srow * NZ + 3072 + ch])) * hn + sigmoidf_(bf2f(Z[(size_t)srow * NZ + 4096 + ch])) * ym;
        ((bf16_t*)(ws + WS_XB))[(size_t)srow * D + ch] = (bf16_t)f2bf(mg);
        if (q_ == 0) a.out[O_SM + ssh] = s_mn;
    }
    __syncthreads();
}
__device__ __forceinline__ void carry_scan(const Args& a, int G) {
    int tid = threadIdx.x; asm volatile("" : "+v"(tid));
    float* sm = (float*)(a.ws + opq0() + WS_SMALL);
    const int per = (NB * D + G - 1) / G;
    if (tid < per) { const int i = blockIdx.x * per + tid;
        if (i < NB * D) { const int b = i >> 10, ch = i & 1023; float la[NCH], lh[NCH];
#pragma unroll
            for (int j = 0; j < NCH; ++j) { la[j] = sm[SM_LRA + (b * 32 + j) * D + ch]; lh[j] = sm[SM_LRH + (b * 32 + j) * D + ch]; }
            float cr = 0.f;
#pragma unroll
            for (int j = 0; j < NCH; ++j) { sm[SM_CARRY + (b * 32 + j) * D + ch] = cr; cr = la[j] * cr + lh[j]; }
            a.out[O_PLH + b * D + ch] = cr; } }
}

__device__ __forceinline__ void sample_item(const Args& a, LAS unsigned char* lds, int idx) {
    int tid = threadIdx.x; asm volatile("" : "+v"(tid)); const int lane = tid & 63, wave = tid >> 6;
    unsigned char* ws = a.ws + opq0(); float* sm = (float*)(ws + WS_SMALL);
    const int sb = idx >> 2, h = idx & 3, row = MP + sb, sh = sb * 4 + h;
    const bf16_t* Q = (const bf16_t*)(ws + WS_Q); const bf16_t* Kb = (const bf16_t*)(ws + WS_K); const bf16_t* VT = (const bf16_t*)(ws + WS_VT); const bf16_t* Z = (const bf16_t*)(ws + WS_Z);
    LAS float* qs = (LAS float*)lds; LAS float* ks = qs + 256; LAS float* vs = ks + 256; LAS float* red = vs + 256  ; LAS float* r2 = red + 2048  ;
    if (tid < 256) { qs[tid] = bf2f(Q[(size_t)row * D + h * 256 + tid]); ks[tid] = bf2f(Kb[(size_t)row * D + h * 256 + tid]); vs[tid] = bf2f(VT[(size_t)(h * 256 + tid) * M + row]); }
    const float fpre = sm[SM_GF + row * 4 + h], ipre = sm[SM_GI + row * 4 + h], lf = log_sigmoid_(fpre), m0 = INP(7)[sh];
    const float mn = fmaxf(lf + m0, ipre), dec = __expf(lf + m0 - mn), wkk = __expf(ipre - mn);
    __syncthreads();
    {
        const int e4 = (tid & 63) * 4, dr = tid >> 6;
        const f32x4 v4 = *(const LAS f32x4*)(vs + e4);
        f32x4 ac = (f32x4){0.f, 0.f, 0.f, 0.f};
        const float* C0 = INP(5) + (size_t)sh * 65536; float* C1 = a.out + O_SC + (size_t)sh * 65536;
#pragma unroll 4
        for (int d = dr; d < 256; d += 8) { const f32x4 c0 = *(const f32x4*)(C0 + (size_t)d * 256 + e4); const float kd = ks[d] * wkk;
            const f32x4 cn = c0 * dec + v4 * kd; *(f32x4*)(C1 + (size_t)d * 256 + e4) = cn; ac += cn * qs[d]; }
        *(LAS f32x4*)(red + dr * 256 + e4) = ac;
    }
    float dn = 0.f;
    if (tid < 256) { const float nn = dec * INP(6)[sh * 256 + tid] + wkk * ks[tid]; a.out[O_SN + sh * 256 + tid] = nn; dn = qs[tid] * nn; }
    dn = wave_sum(dn);
    if (lane == 0) r2[wave] = dn;
    __syncthreads();
    const float den = (r2[0] + r2[1]) + (r2[2] + r2[3]);
    float hv = 0.f;
    if (tid < 256) { float num = 0.f;
#pragma unroll
        for (int r = 0; r < 8; ++r) num += red[r * 256 + tid];
        hv = num / fmaxf(fabsf(den), __expf(-mn)); }
    const float hq = wave_sum(hv * hv);
    if (lane == 0) r2[8 + wave] = hq;
    __syncthreads();
    if (tid < 256) {
        const float rs = 1.0f / sqrtf(((r2[8] + r2[9]) + (r2[10] + r2[11])) * (1.f / 256.f) + EPS);
        const int ch = h * 256 + tid, blk = ch >> 7, dd = ch & 127;
        const float ym = hv * rs * INP(25)[ch] * sigmoidf_(bf2f(Z[(size_t)row * NZ + 2048 + ch]));
        const float* xl = sm + SM_XLS + sb * D + blk * 128; const float* wa = INP(15) + (size_t)blk * 16384 + dd; const float* wx = INP(17) + (size_t)blk * 16384 + dd;
        float rp = INP(16)[ch], ip = INP(18)[ch];
#pragma unroll 8
        for (int c = 0; c < 128; ++c) { const float xv = xl[c]; rp += xv * wa[c * 128]; ip += xv * wx[c * 128]; }
        const float lam = INP(19)[ch], sp = fmaxf(-lam, 0.f) + log1pf(__expf(-fabsf(lam)));
        const float r = sigmoidf_(rp), ig = sigmoidf_(ip), la = -8.0f * r * sp, av = __expf(la);
        const float uv = sqrtf(-expm1f(2.f * la)) * ig * sm[SM_XLS + sb * D + ch];
        const float hn = av * INP(3)[sb * D + ch] + uv;
        a.out[O_SLH + sb * D + ch] = hn;
        const float mg = sigmoidf_(bf2f(Z[(size_t)row * NZ + 3072 + ch])) * hn + sigmoidf_(bf2f(Z[(size_t)row * NZ + 4096 + ch])) * ym;
        ((bf16_t*)(ws + WS_XB))[(size_t)row * D + ch] = (bf16_t)f2bf(mg);
        if (tid == 0) a.out[O_SM + sh] = mn;
    }
    __syncthreads();
}

__device__ __forceinline__ void p4w_item(const Args& a, LAS unsigned char* lds, int it) {
    int tid = threadIdx.x; asm volatile("" : "+v"(tid)); const int lane = tid & 63, wave = tid >> 6, fr = lane & 15, fq = lane >> 4;
    unsigned char* ws = a.ws + opq0(); float* sm = (float*)(ws + WS_SMALL);
    it = __builtin_amdgcn_readfirstlane(it);
    const int tt = it < 2048 ? (it & 3) : 3 - (it & 3), bch = it >> 2,
              h = bch & 3, c = (bch >> 2) & 31, b = bch >> 7, bh = b * 4 + h, tok0 = b * T + c * 64, gb = bh * T + c * 64;
    const bf16_t* Q = (const bf16_t*)(ws + WS_Q); const bf16_t* Kb = (const bf16_t*)(ws + WS_K); const bf16_t* VT = (const bf16_t*)(ws + WS_VT); const bf16_t* Z = (const bf16_t*)(ws + WS_Z);
    const bf16_t* NUMI = (const bf16_t*)(ws + WS_XC); const bf16_t* HL = (const bf16_t*)(ws + WS_HLOC); const bf16_t* CA = (const bf16_t*)(ws + WS_CUMA);
    bf16_t* MG = (bf16_t*)(ws + WS_XB);
    LAS bf16_t* Sl = (LAS bf16_t*)(lds + wave * 2304);
    const int t = tt * 16 + fr; const size_t tok = (size_t)(tok0 + t);
    bf16x8 qf[8];
#pragma unroll
    for (int ks = 0; ks < 8; ++ks) qf[ks] = *(const bf16x8*)(Q + ((size_t)h * M + tok) * 256 + ks * 32 + fq * 8);
    float di = 0.f;
#pragma unroll
    for (int ks = 0; ks < 8; ++ks) { float qq[8]; unpack8(__builtin_bit_cast(u32x4, qf[ks]), qq);
        const f32x4 n0 = *(const f32x4*)(sm + SM_NST + (bh * 32 + c) * 256 + ks * 32 + fq * 8), n1 = *(const f32x4*)(sm + SM_NST + (bh * 32 + c) * 256 + ks * 32 + fq * 8 + 4);
        di += (qq[0] * n0[0] + qq[1] * n0[1]) + (qq[2] * n0[2] + qq[3] * n0[3]) + (qq[4] * n1[0] + qq[5] * n1[1]) + (qq[6] * n1[2] + qq[7] * n1[3]); }
    di += __shfl_xor(di, 16); di += __shfl_xor(di, 32);
    di *= sm[SM_SC + gb + t];
    const float bm = sm[SM_BM + gb + t];
    float ds = 0.f;
    bf16x8 kfc[8];
#pragma unroll
    for (int ks = 0; ks < 8; ++ks) kfc[ks] = *(const bf16x8*)(Kb + ((size_t)h * M + tok0 + fr) * 256 + ks * 32 + fq * 8);
    u32x2 niw[16];
#pragma unroll
    for (int e = 0; e < 16; ++e) niw[e] = c > 0 ? *(const u32x2*)(NUMI + tok * D + h * 256 + e * 16 + fq * 4) : (u32x2){0u, 0u};
    for (int st = 0; st <= tt; ++st) {
        bf16x8 kfn[8];
        const int stn = st < tt ? st + 1 : st;
#pragma unroll
        for (int ks = 0; ks < 8; ++ks) kfn[ks] = *(const bf16x8*)(Kb + ((size_t)h * M + tok0 + stn * 16 + fr) * 256 + ks * 32 + fq * 8);
        f32x4 sa = (f32x4){0.f, 0.f, 0.f, 0.f};
#pragma unroll
        for (int ks = 0; ks < 8; ++ks) sa = MFMA16(kfc[ks], qf[ks], sa);
        const f32x4 gib = *(const f32x4*)(sm + SM_GIB + gb + st * 16 + fq * 4);
        float vv[4];
#pragma unroll
        for (int j = 0; j < 4; ++j) { const int s_ = st * 16 + fq * 4 + j; vv[j] = (s_ <= t) ? sa[j] * fexp_(bm + gib[j]) : 0.f; ds += vv[j]; }
        u32x2 w; w.x = pk2(vv[0], vv[1]); w.y = pk2(vv[2], vv[3]);
        *(LAS u32x2*)(Sl + fr * 72 + st * 16 + fq * 4) = w;
#pragma unroll
        for (int ks = 0; ks < 8; ++ks) kfc[ks] = kfn[ks];
    }
    if ((tt & 1) == 0) { unsigned z0 = 0u; asm volatile("" : "+v"(z0)); *(LAS u32x2*)(Sl + fr * 72 + (tt + 1) * 16 + fq * 4) = (u32x2){z0, z0}; }
    ds += __shfl_xor(ds, 16); ds += __shfl_xor(ds, 32);
    const float den = ds + di;
    const float inv = 1.0f / fmaxf(fabsf(den), fexp_(-sm[SM_MM + gb + t]));
    asm volatile("s_waitcnt lgkmcnt(0)" ::: "memory");
    f32x4 acc[16];
#pragma unroll
    for (int e = 0; e < 16; ++e) acc[e] = (f32x4){0.f, 0.f, 0.f, 0.f};
    const int nks = tt < 2 ? 1 : 2;
    {
        bf16x8 vf0[16], vf1[16];
#pragma unroll
        for (int e = 0; e < 16; ++e) vf0[e] = *(const bf16x8*)(VT + ((size_t)(bh * 32 + c) * 256 + e * 16 + fr) * 64 + fq * 8);
        if (nks == 2) {
#pragma unroll
            for (int e = 0; e < 16; ++e) vf1[e] = *(const bf16x8*)(VT + ((size_t)(bh * 32 + c) * 256 + e * 16 + fr) * 64 + 32 + fq * 8);
        }
        const bf16x8 sf0 = *(const LAS bf16x8*)(Sl + fr * 72 + fq * 8);
#pragma unroll
        for (int e = 0; e < 16; ++e) acc[e] = MFMA16(vf0[e], sf0, acc[e]);
        if (nks == 2) { const bf16x8 sf1 = *(const LAS bf16x8*)(Sl + fr * 72 + 32 + fq * 8);
#pragma unroll
            for (int e = 0; e < 16; ++e) acc[e] = MFMA16(vf1[e], sf1, acc[e]); }
    }
    asm volatile("s_waitcnt lgkmcnt(0)" ::: "memory");
    float hq = 0.f;
#pragma unroll
    for (int e = 0; e < 16; ++e) { const float ni[4] = {bflo(niw[e].x), bfhi(niw[e].x), bflo(niw[e].y), bfhi(niw[e].y)};
#pragma unroll
        for (int j = 0; j < 4; ++j) { const float hv = (acc[e][j] + ni[j]) * inv; acc[e][j] = hv; hq += hv * hv; } }
    hq += __shfl_xor(hq, 16); hq += __shfl_xor(hq, 32);
    const float rs = __builtin_amdgcn_rsqf(hq * (1.f / 256.f) + EPS);
#pragma unroll
    for (int e = 0; e < 16; ++e) { const int ch = h * 256 + e * 16 + fq * 4;
        const f32x4 mg = *(const f32x4*)(INP(25) + ch); const f32x4 cr = *(const f32x4*)(sm + SM_CARRY + (b * 32 + c) * D + ch);
        const u32x2 ow = *(const u32x2*)(Z + tok * NZ + 2048 + ch), glw = *(const u32x2*)(Z + tok * NZ + 3072 + ch), gmw = *(const u32x2*)(Z + tok * NZ + 4096 + ch);
        const u32x2 hlw = *(const u32x2*)(HL + tok * D + ch), caw = *(const u32x2*)(CA + tok * D + ch);
        const float ov[4] = {bflo(ow.x), bfhi(ow.x), bflo(ow.y), bfhi(ow.y)}, gl[4] = {bflo(glw.x), bfhi(glw.x), bflo(glw.y), bfhi(glw.y)}, gm[4] = {bflo(gmw.x), bfhi(gmw.x), bflo(gmw.y), bfhi(gmw.y)};
        const float hl[4] = {bflo(hlw.x), bfhi(hlw.x), bflo(hlw.y), bfhi(hlw.y)}, ca[4] = {bflo(caw.x), bfhi(caw.x), bflo(caw.y), bfhi(caw.y)};
        float o[4];
#pragma unroll
        for (int j = 0; j < 4; ++j) { const float ym = acc[e][j] * rs * mg[j] * sigmoidf_(ov[j]); const float yl = hl[j] + ca[j] * cr[j];
            o[j] = sigmoidf_(gl[j]) * yl + sigmoidf_(gm[j]) * ym; }
        u32x2 w; w.x = pk2(o[0], o[1]); w.y = pk2(o[2], o[3]);
        *(u32x2*)(MG + tok * D + ch) = w; }
}

__device__ __forceinline__ void p9_final(const Args& a, int G) {
    int tid = threadIdx.x; asm volatile("" : "+v"(tid)); const int lane = tid & 63, wave = tid >> 6;
    const float* sm = (const float*)(a.ws + WS_SMALL); const bf16_t* X = (const bf16_t*)(a.ws + WS_X1B);
    const int gw = blockIdx.x * 8 + wave, NGW = G * 8;
    f32x4 g4[4];
#pragma unroll
    for (int j = 0; j < 4; ++j) g4[j] = *((const f32x4*)INP(34) + lane + 64 * j);
    for (int row = gw; row < MR; row += NGW) {
        const float rs = 1.0f / sqrtf(sm[SM_SS3 + row] * (1.f / D) + EPS);
        const u32x2* xr = (const u32x2*)(X + (size_t)row * D) + lane;
        f32x4* o = (f32x4*)(a.out + (row < MP ? O_YP + (size_t)row * D : O_YS + (size_t)(row - MP) * D)) + lane;
#pragma unroll
        for (int j = 0; j < 4; ++j) { const u32x2 w = xr[64 * j]; const f32x4 v = (f32x4){bflo(w.x), bfhi(w.x), bflo(w.y), bfhi(w.y)}; o[64 * j] = v * rs * g4[j]; }
    }
}

template <int KS, int MT>
__device__ __forceinline__ void skinny_job(const Args& a, LAS unsigned char* lds, int kind, int G) {
    int tid = threadIdx.x; asm volatile("" : "+v"(tid)); const int lane = tid & 63, wave = tid >> 6, fr = lane & 15, fq = lane >> 4;
    unsigned char* ws = a.ws + opq0(); float* sm = (float*)(ws + WS_SMALL);
    const bf16_t* A; const bf16_t* Bt; int lda, ldb, K, ncol;
    switch (kind) {
    case 0: A = (const bf16_t*)(ws + WS_XB); lda = D; Bt = (const bf16_t*)(ws + WS_W1T); ldb = D; K = D; ncol = NZ / 16; break;
    case 1: A = (const bf16_t*)(ws + WS_XC); lda = D; Bt = (const bf16_t*)(ws + WS_WQKT); ldb = HD; K = HD; ncol = NH * 32; break;
    case 3: A = (const bf16_t*)(ws + WS_Z) + 1024; lda = NZ; Bt = (const bf16_t*)(ws + WS_WVT); ldb = HD; K = HD; ncol = NH * 16; break;
    case 4: A = (const bf16_t*)(ws + WS_XB); lda = D; Bt = (const bf16_t*)(ws + WS_WOT); ldb = D; K = D; ncol = D / 16; break;
    case 5: A = (const bf16_t*)(ws + WS_X1B); lda = D; Bt = (const bf16_t*)(ws + WS_WGUT); ldb = D; K = D; ncol = (DFF / 128) * 8; break;
    case 6: A = (const bf16_t*)(ws + WS_Z); lda = DFF; Bt = (const bf16_t*)(ws + WS_WDT); ldb = DFF; K = DFF; ncol = D / 16; break;
    case 7: A = (const bf16_t*)(ws + WS_PB); lda = PD; Bt = (const bf16_t*)(ws + WS_WPT); ldb = PD; K = PD; ncol = D / 16; break;
    default: A = (const bf16_t*)(ws + WS_X2B); lda = D; Bt = (const bf16_t*)(ws + WS_WPGT); ldb = D; K = D; ncol = D / 16; break;
    }
    constexpr int NG = 8 / MT;
    const int nksw = K / 256, kw = wave * (K / 8), nunits = ncol * NG;
    LAS f32x4* red0 = (LAS f32x4*)lds; LAS f32x4* red1 = (LAS f32x4*)(lds + 65536);
    for (int uu = blockIdx.x; uu < nunits; uu += G) {
        const int u = uu / NG, mbase = (uu % NG) * MT;
        int acol = 0, brow0 = u * 16, brow1 = u * 16, z = 0; size_t boff = 0;
        if (kind == 1) { z = u >> 5; acol = z * 256; brow0 = (u & 31) * 16; brow1 = brow0; boff = (size_t)z * 512 * 256; }
        if (kind == 3) { z = u >> 4; acol = z * 256; brow0 = (u & 15) * 16; brow1 = brow0; boff = (size_t)z * 65536; }
        if (kind == 5) { brow0 = (u >> 3) * 256 + (u & 7) * 16; brow1 = brow0 + 128; }
        const bf16_t* Ap = A + (size_t)(MP + mbase * 16 + fr) * lda + acol + kw + fq * 8;
        const bf16_t* B0p = Bt + boff + (size_t)(brow0 + fr) * ldb + kw + fq * 8;
        const bf16_t* B1p = Bt + boff + (size_t)(brow1 + fr) * ldb + kw + fq * 8;
        bf16x8 b0[KS], b1[KS], af[KS][MT];
#pragma unroll
        for (int i = 0; i < KS; ++i) if (i < nksw) { b0[i] = *(const bf16x8*)(B0p + i * 32); if (kind == 5) b1[i] = *(const bf16x8*)(B1p + i * 32);
#pragma unroll
            for (int m = 0; m < MT; ++m) af[i][m] = *(const bf16x8*)(Ap + (size_t)m * 16 * lda + i * 32); }
        f32x4 p0[MT], p1[MT];
#pragma unroll
        for (int m = 0; m < MT; ++m) { p0[m] = (f32x4){0.f, 0.f, 0.f, 0.f}; p1[m] = (f32x4){0.f, 0.f, 0.f, 0.f}; }
#pragma unroll
        for (int i = 0; i < KS; ++i) if (i < nksw) {
#pragma unroll
            for (int m = 0; m < MT; ++m) { p0[m] = MFMA16(b0[i], af[i][m], p0[m]); if (kind == 5) p1[m] = MFMA16(b1[i], af[i][m], p1[m]); } }
#pragma unroll
        for (int m = 0; m < MT; ++m) { red0[(wave * MT + m) * 64 + lane] = p0[m]; if (kind == 5) red1[(wave * MT + m) * 64 + lane] = p1[m]; }
        __syncthreads();
        if (wave < MT) {
        const int row = MP + (mbase + wave) * 16 + fr;
        f32x4 acc0 = (f32x4){0.f, 0.f, 0.f, 0.f}, acc1 = (f32x4){0.f, 0.f, 0.f, 0.f};
#pragma unroll
        for (int w = 0; w < 8; ++w) { acc0 += red0[(w * MT + wave) * 64 + lane]; if (kind == 5) acc1 += red1[(w * MT + wave) * 64 + lane]; }
        switch (kind) {
        case 0: { const float s = 1.f; u32x2 w; w.x = pk2(acc0[0] * s, acc0[1] * s); w.y = pk2(acc0[2] * s, acc0[3] * s);
                  *(u32x2*)((bf16_t*)(ws + WS_Z) + (size_t)row * NZ + u * 16 + fq * 4) = w; } break;
        case 1: { const int col = brow0 + fq * 4; bf16_t* dst = (col < 256 ? (bf16_t*)(ws + WS_Q) + col : (bf16_t*)(ws + WS_K) + col - 256) + ((size_t)z * M + row) * 256;
                  u32x2 w; w.x = pk2(acc0[0], acc0[1]); w.y = pk2(acc0[2], acc0[3]); *(u32x2*)dst = w; } break;
        case 3: { u32x2 w; w.x = pk2(acc0[0], acc0[1]); w.y = pk2(acc0[2], acc0[3]); *(u32x2*)((bf16_t*)(ws + WS_VS) + (size_t)(row - MP) * D + z * 256 + brow0 + fq * 4) = w; } break;
        case 4: case 6: { const int col = u * 16 + fq * 4; f32x4 b;
                  if (kind == 4) b = *(const f32x4*)(INP(1) + (size_t)(row - MP) * D + col);
                  else { const u32x2 w = *(const u32x2*)((const bf16_t*)(ws + WS_X1B) + (size_t)row * D + col); b = (f32x4){bflo(w.x), bfhi(w.x), bflo(w.y), bfhi(w.y)}; }
                  const f32x4 v = acc0 + b; u32x2 w; w.x = pk2(v[0], v[1]); w.y = pk2(v[2], v[3]);
                  *(u32x2*)((bf16_t*)(ws + (kind == 4 ? WS_X1B : WS_X2B)) + (size_t)row * D + col) = w;
                  float q = (v[0] * v[0] + v[1] * v[1]) + (v[2] * v[2] + v[3] * v[3]); q += __shfl_xor(q, 16); q += __shfl_xor(q, 32);
                  if (fq == 0) atomicAdd(sm + (kind == 4 ? SM_SS1 : SM_SS2) + row, q); } break;
        case 5: { const float s = __builtin_amdgcn_rsqf(sm[SM_SS1 + row] * (1.f / D) + EPS); float o[4];
#pragma unroll
                  for (int j = 0; j < 4; ++j) { const float gv = acc0[j] * s, uv = acc1[j] * s; o[j] = gv * sigmoidf_(gv) * uv; }
                  u32x2 w; w.x = pk2(o[0], o[1]); w.y = pk2(o[2], o[3]);
                  *(u32x2*)((bf16_t*)(ws + WS_Z) + (size_t)row * DFF + (u >> 3) * 128 + (u & 7) * 16 + fq * 4) = w; } break;
        case 7: { u32x2 w; w.x = pk2(acc0[0], acc0[1]); w.y = pk2(acc0[2], acc0[3]); *(u32x2*)((bf16_t*)(ws + WS_PE) + (size_t)row * D + u * 16 + fq * 4) = w; } break;
        default: { const int col = u * 16 + fq * 4; const float s = __builtin_amdgcn_rsqf(sm[SM_SS2 + row] * (1.f / D) + EPS);
                  const u32x2 xw = *(const u32x2*)((const bf16_t*)(ws + WS_X2B) + (size_t)row * D + col), pw = *(const u32x2*)((const bf16_t*)(ws + WS_PE) + (size_t)row * D + col);
                  const float xb[4] = {bflo(xw.x), bfhi(xw.x), bflo(xw.y), bfhi(xw.y)}, pe[4] = {bflo(pw.x), bfhi(pw.x), bflo(pw.y), bfhi(pw.y)};
                  float v[4], q = 0.f;
#pragma unroll
                  for (int j = 0; j < 4; ++j) { v[j] = xb[j] + sigmoidf_(acc0[j] * s) * pe[j]; q += v[j] * v[j]; }
                  u32x2 w; w.x = pk2(v[0], v[1]); w.y = pk2(v[2], v[3]); *(u32x2*)((bf16_t*)(ws + WS_X1B) + (size_t)row * D + col) = w;
                  q += __shfl_xor(q, 16); q += __shfl_xor(q, 32);
                  if (fq == 0) atomicAdd(sm + SM_SS3 + row, q); } break;
        }
        }
        __syncthreads();
    }
}
__device__ __forceinline__ int skinny_kind(int ph, int j) {
    if (ph == 1) return j == 0 ? 0 : -1;
    if (ph == 3) return j == 0 ? 1 : (j == 1 ? 3 : -1);
    if (ph == 6) return j == 0 ? 4 : -1;
    if (ph == 7) return j == 0 ? 5 : -1;
    if (ph == 8) return j == 0 ? 6 : -1;
    if (ph == 9) return j == 0 ? 7 : (j == 1 ? 8 : -1);
    return -1;
}

#define XB_TMO      128
#define XB_XCNT(j)  (256  + 64 * (j))
#define XB_XSUB(j)  (1280 + 64 * (j))
#define XB_XGEN(j)  (2304 + 64 * (j))
#define XB_TOP      3328
#define XB_TOPGEN   3392
#define XCD_BAR_WORDS 3456
#define XB_SPIN_CAP (1u << 18)
__device__ __forceinline__ unsigned xb_ld(unsigned* p)              { return __hip_atomic_load(p, __ATOMIC_RELAXED, __HIP_MEMORY_SCOPE_AGENT); }
__device__ __forceinline__ unsigned xb_add(unsigned* p, unsigned v) { return __hip_atomic_fetch_add(p, v, __ATOMIC_RELAXED, __HIP_MEMORY_SCOPE_AGENT); }
__device__ __forceinline__ unsigned xb_xcc_id() { return (unsigned)__builtin_amdgcn_s_getreg((3 << 11) | 20) & 0xFu; }
#define XB_SPIN(cond, bar) do { unsigned _sp = 0; while (cond) { __builtin_amdgcn_s_sleep(1); \
    if ((++_sp & 255u) == 0u) { if (xb_ld(&(bar)[XB_TMO])) break; if (_sp > XB_SPIN_CAP) { atomicAdd(&(bar)[XB_TMO], 1u); break; } } } } while (0)
struct XcdBarrier { unsigned* bar; unsigned x; volatile LAS unsigned* st; };
__device__ __forceinline__ XcdBarrier xcd_barrier_post(unsigned* bar, volatile LAS unsigned* st) {
    XcdBarrier b; b.bar = bar; b.x = xb_xcc_id(); b.st = st;
    if (threadIdx.x == 0) (void)xb_add(&bar[XB_XCNT(b.x)], 1u);
    return b;
}
__device__ __forceinline__ void xcd_barrier_complete(unsigned* bar, unsigned x, unsigned& nloc, unsigned& nx) {
    const unsigned G = gridDim.x * gridDim.y * gridDim.z;
    unsigned sum, cnt, mine, sp = 0u;
    for (;;) {
        sum = 0u; cnt = 0u; mine = 0u;
#pragma unroll
        for (unsigned j = 0; j < 16; ++j) { const unsigned c = xb_ld(&bar[XB_XCNT(j)]); sum += c; cnt += (c > 0u) ? 1u : 0u; mine = (j == x) ? c : mine; }
        if (sum == G) break;
        __builtin_amdgcn_s_sleep(1);
        if ((++sp & 255u) == 0u) { if (xb_ld(&bar[XB_TMO])) break; if (sp > XB_SPIN_CAP) { atomicAdd(&bar[XB_TMO], 1u); break; } }
    }
    nloc = mine > 0u ? mine : 1u; nx = cnt > 0u ? cnt : 1u;
}
__device__ __forceinline__ void xcd_barrier(const XcdBarrier& b) {
    asm volatile("s_waitcnt vmcnt(0)" ::: "memory");
    __syncthreads();
    if (threadIdx.x == 0) {
        unsigned* bar = b.bar;
        __builtin_amdgcn_s_waitcnt(0);
        unsigned nloc = b.st[0], nx = b.st[1];
        if (nloc == 0u) { xcd_barrier_complete(bar, b.x, nloc, nx); b.st[0] = nloc; b.st[1] = nx; }
        const unsigned old = xb_add(&bar[XB_XSUB(b.x)], 1u);
        const unsigned gen = old / nloc;
        if (old + 1u == (gen + 1u) * nloc) {
            __builtin_amdgcn_fence(__ATOMIC_RELEASE, "agent");
            asm volatile("s_waitcnt vmcnt(0)" ::: "memory");
            const unsigned og = xb_add(&bar[XB_TOP], 1u);
            const unsigned tg = og / nx;
            if (og + 1u == (tg + 1u) * nx) xb_add(&bar[XB_TOPGEN], 1u);
            else XB_SPIN(xb_ld(&bar[XB_TOPGEN]) == tg, bar);
            __builtin_amdgcn_fence(__ATOMIC_ACQUIRE, "agent");
            xb_add(&bar[XB_XGEN(b.x)], 1u);
            asm volatile("s_waitcnt vmcnt(0)" ::: "memory");
        } else {
            XB_SPIN(xb_ld(&bar[XB_XGEN(b.x)]) == gen, bar);
            __builtin_amdgcn_fence(__ATOMIC_ACQUIRE, "agent");
            asm volatile("s_waitcnt vmcnt(0)" ::: "memory");
        }
    }
    __syncthreads();
}

namespace pg8 {
struct EpiAny {
    int kind; unsigned char* ws; const float* xp; const float* xs;
    __device__ __forceinline__ void operator()(const f32x4 (&acc)[2][2][4][2], const Unit& u, int wr, int wc, int fr, int fq) const {
        float* sm = (float*)(ws + WS_SMALL);
        switch (kind) {
        case 0: { EpiZ E{(bf16_t*)(ws + WS_Z), sm + SM_RSTD0}; E(acc, u, wr, wc, fr, fq); } break;
        case 1: { EpiQK E{(bf16_t*)(ws + WS_Q), (bf16_t*)(ws + WS_K)}; E(acc, u, wr, wc, fr, fq); } break;
        case 2: { EpiT E{(bf16_t*)(ws + WS_KT), sm + SM_WK}; E(acc, u, wr, wc, fr, fq); } break;
        case 3: { EpiT E{(bf16_t*)(ws + WS_VT), nullptr}; E(acc, u, wr, wc, fr, fq); } break;
        case 4: { EpiRes<0> E{xp, xs, nullptr, (bf16_t*)(ws + WS_X1B), sm + SM_SS1}; E(acc, u, wr, wc, fr, fq); } break;
        case 5: { EpiGU E{(bf16_t*)(ws + WS_Z), sm + SM_SS1}; E(acc, u, wr, wc, fr, fq); } break;
        case 6: { EpiRes<1> E{nullptr, nullptr, (const bf16_t*)(ws + WS_X1B), (bf16_t*)(ws + WS_X2B), sm + SM_SS2}; E(acc, u, wr, wc, fr, fq); } break;
        case 7: { EpiPlain E{(bf16_t*)(ws + WS_PE), D}; E(acc, u, wr, wc, fr, fq); } break;
        default: { EpiPle E{(const bf16_t*)(ws + WS_X2B), (bf16_t*)(ws + WS_X1B), (const bf16_t*)(ws + WS_PE), sm + SM_SS2, sm + SM_SS3}; E(acc, u, wr, wc, fr, fq); } break;
        }
    }
};
}

__device__ __forceinline__ bool gemm_job(unsigned char* ws, int ph, int j, pg8::Gemm& g, int& nM, int& nN, int& nZ, int& kind) {
    using namespace pg8;
    const bf16_t* w = (const bf16_t*)ws;
#define WSB(off) ((const bf16_t*)(ws + (off)))
    if (ph == 1 && j == 0) { g = Gemm{WSB(WS_XB), WSB(WS_W1T), D, D, D, 0, 0}; nM = MP / 256; nN = NZ / 256; nZ = 1; kind = 0; return true; }
    if (ph == 3 && j == 0) { g = Gemm{WSB(WS_XC), WSB(WS_WQKT), D, HD, HD, 512, (size_t)512 * 256 * 2}; nM = MP / 256; nN = 2; nZ = NH; kind = 1; return true; }
    if (ph == 3 && j == 1) { g = Gemm{WSB(WS_WQKT) + 65536, WSB(WS_XC), HD, D, HD, (size_t)512 * 256 * 2, 512}; nM = 1; nN = MP / 256; nZ = NH; kind = 2; return true; }
    if (ph == 3 && j == 2) { g = Gemm{WSB(WS_WVT), WSB(WS_Z) + 1024, HD, NZ, HD, (size_t)65536 * 2, 512}; nM = 1; nN = MP / 256; nZ = NH; kind = 3; return true; }
    if (ph == 6 && j == 0) { g = Gemm{WSB(WS_XB), WSB(WS_WOT), D, D, D, 0, 0}; nM = MP / 256; nN = D / 256; nZ = 1; kind = 4; return true; }
    if (ph == 7 && j == 0) { g = Gemm{WSB(WS_X1B), WSB(WS_WGUT), D, D, D, 0, 0}; nM = MP / 256; nN = NGU / 256; nZ = 1; kind = 5; return true; }
    if (ph == 8 && j == 0) { g = Gemm{WSB(WS_Z), WSB(WS_WDT), DFF, DFF, DFF, 0, 0}; nM = MP / 256; nN = D / 256; nZ = 1; kind = 6; return true; }
    if (ph == 7 && j == 1) { g = Gemm{WSB(WS_PB), WSB(WS_WPT), PD, PD, PD, 0, 0}; nM = MP / 256; nN = D / 256; nZ = 1; kind = 7; return true; }
    if (ph == 9 && j == 0) { g = Gemm{WSB(WS_X2B), WSB(WS_WPGT), D, D, D, 0, 0}; nM = MP / 256; nN = D / 256; nZ = 1; kind = 8; return true; }
#undef WSB
    (void)w; return false;
}

#ifndef REPMASK
#define REPMASK 0
#endif
constexpr int NPHASE = 11;
__global__ void __launch_bounds__(NT, 2) hawk_fwd(Args a) {
    extern __shared__ __attribute__((aligned(16))) unsigned char lds_raw[];
    LAS unsigned char* lds = (LAS unsigned char*)lds_raw;
    cg::grid_group grid = cg::this_grid();
    const int G = gridDim.x, bx = blockIdx.x;
    volatile LAS unsigned* bst = (volatile LAS unsigned*)(lds + LDS_BYTES - 64);
    if (threadIdx.x == 0) { bst[0] = 0u; bst[1] = 0u; }
    __syncthreads();
    const XcdBarrier xbar = xcd_barrier_post((unsigned*)(a.ws + WS_BAR), bst);
    if (a.ph_hi < 0) grid.sync();
    for (int ph = a.ph_lo; ph < a.ph_hi; ++ph) {
        for (int rep = 0; rep < 1 + ((REPMASK >> ph) & 1); ++rep) {
            if (rep) xcd_barrier(xbar);
            switch (ph) {
            case 0: p0_prologue(a, lds, G); break;
            case 2: p2_phase(a, lds, G); __syncthreads();
                    for (int it = 2048 + (bx + G - G / 2) % G; it < 2048 + MS; it += G) p2a_item(a, lds, it);
                    __syncthreads();
                    for (int bh = G - 1 - bx; bh < 32; bh += G) gate_scan(a, lds, bh); break;
            case 4: carry_scan(a, G);
                    for (int it = bx; it < 256; it += G) p3_item(a, lds, ((it & 7) << 5) | (it >> 3)); break;
            case 5: { int tw = threadIdx.x; asm volatile("" : "+v"(tw)); for (int it = bx * 8 + (tw >> 6); it < 4096; it += G * 8) p4w_item(a, lds, it); } break;
            case 10: p9_final(a, G); break;
            default: break;
            }
            for (int sj = 0; sj < 2; ++sj) { const int sk = skinny_kind(ph, sj); if (sk < 0) break; if (sk == 6) skinny_job<11, 2>(a, lds, sk, G); else skinny_job<4, 4>(a, lds, sk, G); __syncthreads(); }
            __syncthreads();
            for (int j = 0; j < 3; ++j) {
                pg8::Gemm g; int nM, nN, nZ, kind;
                if (!gemm_job(a.ws, ph, j, g, nM, nN, nZ, kind)) break;
                pg8::Order S; S.init(nM, nN, nZ, G, bx);
                if (kind == 7) { if (G != 256) S.init(nM, nN, nZ, G, bx); else if (bx < 128) continue; else S.init(nM, nN, nZ, 128, bx - 128); }
                pg8::EpiAny E{kind, a.ws, a.in[0], a.in[1]};
                pg8::gemm_phase(lds, g, S, E);
            }
        }
        if (ph + 1 < a.ph_hi) xcd_barrier(xbar);
    }
}

#ifndef N_LAUNCH_SPLIT
#define N_LAUNCH_SPLIT 0
#endif
extern "C" void kernel_launch(void* const* d_in, const int* in_sizes, int n_in, void* d_out, int out_size, void* d_ws, size_t ws_size, hipStream_t stream) {
    static int grid = 0;
    if (grid == 0) {
        int dev = 0, cus = 0, per_cu = 0;
        hipGetDevice(&dev);
        hipDeviceGetAttribute(&cus, hipDeviceAttributeMultiprocessorCount, dev);
        hipFuncSetAttribute((const void*)hawk_fwd, hipFuncAttributeMaxDynamicSharedMemorySize, LDS_BYTES);
        hipOccupancyMaxActiveBlocksPerMultiprocessor(&per_cu, (const void*)hawk_fwd, NT, LDS_BYTES);
        if (per_cu < 1) { fprintf(stderr, "kernel_launch: occupancy query says %d blocks per CU\n", per_cu); per_cu = 1; }
        grid = cus * per_cu;
        if (n_in != 35 || ws_size < WS_END || (size_t)out_size != O_END) fprintf(stderr, "kernel_launch: unexpected sizes n_in %d ws %zu out %d\n", n_in, ws_size, out_size);
    }
    Args a{};
    for (int i = 0; i < 35; ++i) a.in[i] = (const float*)d_in[i];
    a.out = (float*)d_out; a.ws = (unsigned char*)d_ws;
#if N_LAUNCH_SPLIT
    for (int p = 0; p < NPHASE; ++p) { a.ph_lo = p; a.ph_hi = p + 1; hipLaunchKernelGGL(hawk_fwd, dim3(grid), dim3(NT), LDS_BYTES, stream, a); }
#else
    a.ph_lo = 0; a.ph_hi = NPHASE;
    hipMemsetAsync((char*)d_ws + WS_BAR, 0, 16384, stream);
    void* args[] = {&a};
    hipError_t e = hipLaunchCooperativeKernel((const void*)hawk_fwd, dim3(grid), dim3(NT), args, LDS_BYTES, stream);
    if (e != hipSuccess) fprintf(stderr, "cooperative launch failed: %s (grid %d)\n", hipGetErrorString(e), grid);
#endif
}
```

```cpp
#include <hip/hip_runtime.h>
#include <hip/hip_cooperative_groups.h>
#include <cstdio>
#include <cstdint>
namespace cg = cooperative_groups;

#define LAS __attribute__((address_space(3)))
typedef unsigned short bf16_t;
typedef short bf16x8 __attribute__((ext_vector_type(8)));
typedef float f32x4 __attribute__((ext_vector_type(4)));
typedef float f32x2 __attribute__((ext_vector_type(2)));
typedef unsigned u32x4 __attribute__((ext_vector_type(4)));
typedef unsigned u32x2 __attribute__((ext_vector_type(2)));

constexpr int D = 1024, NB = 8, T = 2048, MP = NB * T, MS = 128, MR = MP + MS, M = 16640  ;
constexpr int NZ = 5120, DFF = 2816, NGU = 2 * DFF, PD = 256, NIN = 5128, NH = 4, HD = 256, NCH = T / 64;
constexpr float EPS = 1e-6f;
constexpr float M_INIT = -1e30f;

constexpr size_t MiB = 1u << 20;
constexpr size_t WS_W1T = 0;
constexpr size_t WS_WOT = 10 * MiB;
constexpr size_t WS_WGUT = 12 * MiB;
constexpr size_t WS_WDT = 23 * MiB;
constexpr size_t WS_WPGT = 57 * MiB / 2;
constexpr size_t WS_WPT = 61 * MiB / 2;
constexpr size_t WS_WQKT = 31 * MiB;
constexpr size_t WS_WVT = 32 * MiB;
constexpr size_t WS_WLRUT = 65 * MiB / 2;
constexpr size_t WS_BAR = 40 * MiB - 16384;
constexpr size_t WS_SMALL = 33 * MiB;
constexpr size_t WS_XB = 40 * MiB;
constexpr size_t WS_PB = 73 * MiB;
constexpr size_t WS_Z = 82 * MiB;
constexpr size_t WS_XC = 245 * MiB;
constexpr size_t WS_Q = 278 * MiB;
constexpr size_t WS_K = 311 * MiB;
constexpr size_t WS_KT = 344 * MiB;
constexpr size_t WS_VT = 377 * MiB;
constexpr size_t WS_HLOC = 410 * MiB;
constexpr size_t WS_CUMA = 443 * MiB;
constexpr size_t WS_VS = 476 * MiB;
constexpr size_t WS_END = 477 * MiB;
constexpr size_t WS_X1 = WS_Q;
constexpr size_t WS_X1B = WS_KT;
constexpr size_t WS_X2B = WS_VT;
constexpr size_t WS_PE = WS_HLOC;
constexpr int SM_RSTD0 = 0;
constexpr int SM_SS1 = SM_RSTD0 + M;
constexpr int SM_SS2 = SM_SS1 + M;
constexpr int SM_SS3 = SM_SS2 + M;
constexpr int SM_GI = SM_SS3 + M;
constexpr int SM_GF = SM_GI + 4 * M;
constexpr int SM_BM = SM_GF + 4 * M;
constexpr int SM_GIB = SM_BM + 32 * T;
constexpr int SM_SC = SM_GIB + 32 * T;
constexpr int SM_WK = SM_SC + 32 * T;
constexpr int SM_MM = SM_WK + 32 * T;
constexpr int SM_DEC = SM_MM + 32 * T;
constexpr int SM_NST = SM_DEC + 1024;
constexpr int SM_LRA = SM_NST + 32 * 32 * 256;
constexpr int SM_LRH = SM_LRA + 8 * 32 * 1024;
constexpr int SM_XLS = SM_LRH + 8 * 32 * 1024;
constexpr int SM_CARRY = SM_XLS + 128 * 1024;
constexpr int SM_END = SM_CARRY + 8 * 32 * 1024;
static_assert((size_t)SM_END * 4 <= 7 * MiB - 16384, "small arrays");
static_assert(WS_END <= 512 * MiB, "workspace");

constexpr size_t O_YP = 0, O_YS = O_YP + (size_t)MP * D, O_PLC = O_YS + (size_t)MS * D, O_PLH = O_PLC + 8 * 3 * 1024, O_PMC = O_PLH + 8 * 1024,
                 O_PC = O_PMC + 8 * 3 * 1024, O_PN = O_PC + (size_t)8 * 4 * 65536, O_PM = O_PN + 8 * 4 * 256, O_SLC = O_PM + 32, O_SLH = O_SLC + (size_t)128 * 3 * 1024,
                 O_SMC = O_SLH + 128 * 1024, O_SC = O_SMC + (size_t)128 * 3 * 1024, O_SN = O_SC + (size_t)128 * 4 * 65536, O_SM = O_SN + 128 * 4 * 256, O_END = O_SM + 512;

constexpr int LDS_BYTES = 147456;
constexpr int NT = 512;

struct Args {
    const float* in[35];
    float* out;
    unsigned char* ws;
    int ph_lo, ph_hi;
};

__device__ __forceinline__ size_t opq0() { size_t z = 0; asm volatile("" : "+s"(z)); return z; }
#define INP(k) (a.in[k] + opq0())
__device__ __forceinline__ unsigned f2bf(float f) { unsigned u = __builtin_bit_cast(unsigned, f); return (u + 0x7fffu + ((u >> 16) & 1u)) >> 16; }
__device__ __forceinline__ unsigned pk2(float lo, float hi) { return f2bf(lo) | (f2bf(hi) << 16); }
__device__ __forceinline__ float bf2f(unsigned short h) { return __builtin_bit_cast(float, (unsigned)h << 16); }
__device__ __forceinline__ float bflo(unsigned w) { return __builtin_bit_cast(float, w << 16); }
__device__ __forceinline__ float bfhi(unsigned w) { return __builtin_bit_cast(float, w & 0xffff0000u); }
__device__ __forceinline__ float sigmoidf_(float x) { return __builtin_amdgcn_rcpf(1.f + __builtin_amdgcn_exp2f(-1.4426950408889634f * x)); }
__device__ __forceinline__ float fexp_(float x) { return __builtin_amdgcn_exp2f(1.4426950408889634f * x); }
__device__ __forceinline__ void unpack8x(const u32x4 w, float (&o)[8]) { o[0] = bflo(w.x); o[1] = bfhi(w.x); o[2] = bflo(w.y); o[3] = bfhi(w.y); o[4] = bflo(w.z); o[5] = bfhi(w.z); o[6] = bflo(w.w); o[7] = bfhi(w.w); }
__device__ __forceinline__ float wave_sum(float v) {
#pragma unroll
    for (int o = 1; o < 64; o <<= 1) v += __shfl_xor(v, o);
    return v;
}
__device__ __forceinline__ const float* xrow_ptr(const Args& a, int row) {
    return row < MP ? INP(0) + (size_t)row * D : INP(1) + (size_t)(row - MP) * D;
}

namespace pg8 {
constexpr int BM = 256, BK = 64, HALF = 128, HTB = HALF * BK * 2, STAGE_BYTES = 8 * HTB, NXCD = 8, WGM = 8;
__device__ __forceinline__ int lds_byte(int r, int c) { const int st = (r >> 4) * 2 + (c >> 5), rr = r & 15, cc = c & 31, ob = rr * 64 + cc * 2; return st * 1024 + (ob ^ (((ob >> 9) & 1) << 5)); }
__device__ __forceinline__ void stage_rc(int b, int& R, int& C) { const int st = b / 1024, sb = b % 1024, swz = sb ^ (((sb >> 9) & 1) << 5); R = (st >> 1) * 16 + swz / 64; C = (st & 1) * 32 + (swz % 64) / 2; }
__device__ __forceinline__ int perm32(int rho) { const int n = rho >> 4, i = rho & 15; return 8 * (i >> 2) + 4 * n + (i & 3); }

struct Unit { int pm, pn, z; };
struct Gemm { const bf16_t* A; const bf16_t* Bt; int lda, ldb, K; size_t zA, zB; };

struct Order {
    int nM, nN, nwg, total, G, c;
    __device__ void init(int nM_, int nN_, int nZ_, int G_, int c_) { nM = nM_; nN = nN_; nwg = nM * nN; total = nwg * nZ_; G = G_; c = c_; }
    __device__ bool next(int i, Unit& u) const {
        const long L = (long)i * G + c; if (L >= total) return false;
        u.z = (int)(L / nwg); int wgid = (int)(L % nwg);
        { const int q = nwg / NXCD, r = nwg % NXCD, xcd = wgid % NXCD, off = wgid / NXCD; wgid = (xcd < r ? xcd * (q + 1) : r * (q + 1) + (xcd - r) * q) + off; }
        const int nig = WGM * nN, gid = wgid / nig, fm = gid * WGM, gsz = (nM - fm) < WGM ? (nM - fm) : WGM;
        u.pm = fm + ((wgid % nig) % gsz); u.pn = (wgid % nig) / gsz; return true;
    }
};

__device__ __forceinline__ unsigned cvt_pk_bf16(float lo, float hi) { unsigned r; asm volatile("v_cvt_pk_bf16_f32 %0, %1, %2" : "=v"(r) : "v"(lo), "v"(hi)); return r; }

template <class Epi>
__device__ __forceinline__ void gemm_phase(LAS unsigned char* lds, const Gemm g, const Order& S, const Epi& E) {
    int tid = threadIdx.x; asm volatile("" : "+v"(tid));
    const int wid = __builtin_amdgcn_readfirstlane(tid >> 6), lane = tid & 63, wr = wid >> 2, wc = wid & 3, fr = lane & 15, fq = lane >> 4;
    const int K = g.K, nt = K / BK;
    unsigned voffA[2], voffB[2];
#pragma unroll
    for (int i = 0; i < 2; ++i) { int R, C; stage_rc(tid * 16 + i * 8192, R, C); const int Rb = (R & ~31) + perm32(R & 31);
        voffA[i] = (unsigned)(R * g.lda + C) * 2u; voffB[i] = (unsigned)(Rb * g.ldb + C) * 2u; }
    const size_t kstep = (size_t)(BK * 2);
    const size_t hstepA = (size_t)HALF * g.lda * 2, hstepB = (size_t)HALF * g.ldb * 2;
    const size_t tstepA = 2 * hstepA, tstepB = 2 * hstepB;
    const unsigned ldsw = (unsigned)wid * 1024u;
    const int aoff = lds_byte(wr * 64 + fr, fq * 8), boff = lds_byte(wc * 32 + fr, fq * 8);
#define PG8_SA(b, h) (((b) * 2 + (h)) * HTB)
#define PG8_SB(b, h) ((4 + (b) * 2 + (h)) * HTB)
#define PG8_STAGE(bufoff, gbase, voff) do { _Pragma("unroll") for (int _i = 0; _i < 2; ++_i) \
        __builtin_amdgcn_global_load_lds((const unsigned*)((const char*)(gbase) + (voff)[_i]), (LAS unsigned*)(lds + (bufoff) + ldsw + _i * 8192), 16, 0, 0); } while (0)
#define PG8_LDA(dst, b, h) do { _Pragma("unroll") for (int m = 0; m < 4; ++m) _Pragma("unroll") for (int k = 0; k < 2; ++k) dst[m][k] = *(const LAS bf16x8*)(lds + PG8_SA(b, h) + aoff + m * 2048 + k * 1024); } while (0)
#define PG8_LDB(dst, b, h) do { _Pragma("unroll") for (int n = 0; n < 2; ++n) _Pragma("unroll") for (int k = 0; k < 2; ++k) dst[n][k] = *(const LAS bf16x8*)(lds + PG8_SB(b, h) + boff + n * 2048 + k * 1024); } while (0)
#define PG8_MMA(ai, bj, At, Bt) do { __builtin_amdgcn_s_setprio(1); _Pragma("unroll") for (int m = 0; m < 4; ++m) _Pragma("unroll") for (int n = 0; n < 2; ++n) _Pragma("unroll") for (int k = 0; k < 2; ++k) \
        acc[ai][bj][m][n] = __builtin_amdgcn_mfma_f32_16x16x32_bf16(Bt[n][k], At[m][k], acc[ai][bj][m][n], 0, 0, 0); __builtin_amdgcn_s_setprio(0); } while (0)
#define PG8_WAIT_V(n) asm volatile("s_waitcnt vmcnt(" #n ")" ::: "memory")
#define PG8_WAIT_L(n) asm volatile("s_waitcnt lgkmcnt(" #n ")" ::: "memory")
#define PG8_BAR __builtin_amdgcn_s_barrier()
#define PG8_SCHED __builtin_amdgcn_sched_barrier(0)
    Unit cur, nxt; int ui = 0;
    if (!S.next(0, cur)) return;
    f32x4 acc[2][2][4][2];
#pragma unroll
    for (int a = 0; a < 2; ++a)
#pragma unroll
        for (int b = 0; b < 2; ++b)
#pragma unroll
            for (int m = 0; m < 4; ++m)
#pragma unroll
                for (int n = 0; n < 2; ++n) acc[a][b][m][n] = (f32x4){0.f, 0.f, 0.f, 0.f};
    bf16x8 At[4][2], B0[2][2], B1[2][2];
    const char* cA = (const char*)g.A + (size_t)cur.pm * tstepA + (size_t)cur.z * g.zA; const char* cB = (const char*)g.Bt + (size_t)cur.pn * tstepB + (size_t)cur.z * g.zB;
    PG8_STAGE(PG8_SB(0, 0), cB, voffB); PG8_STAGE(PG8_SB(0, 1), cB + hstepB, voffB); PG8_STAGE(PG8_SA(0, 0), cA, voffA); PG8_STAGE(PG8_SA(0, 1), cA + hstepA, voffA);
    if (wr == 1) PG8_BAR;
    PG8_WAIT_V(2); PG8_BAR;
    PG8_STAGE(PG8_SB(1, 0), cB + kstep, voffB); PG8_STAGE(PG8_SA(1, 0), cA + kstep, voffA); PG8_STAGE(PG8_SB(1, 1), cB + hstepB + kstep, voffB);
    PG8_WAIT_V(6); PG8_BAR;
    for (;;) {
        const bool has_next = S.next(ui + 1, nxt);
        const char* nA = has_next ? (const char*)g.A + (size_t)nxt.pm * tstepA + (size_t)nxt.z * g.zA : cA;
        const char* nB = has_next ? (const char*)g.Bt + (size_t)nxt.pn * tstepB + (size_t)nxt.z * g.zB : cB;
        for (int t = 0; t < nt; t += 2) {
            const bool last = (t == nt - 2);
            const char* a1 = cA + (size_t)(t + 1) * kstep;
            const char* a2 = last ? nA : cA + (size_t)(t + 2) * kstep; const char* b2 = last ? nB : cB + (size_t)(t + 2) * kstep;
            const char* a3 = a2 + kstep; const char* b3 = b2 + kstep;
            PG8_LDB(B0, 0, 0); PG8_LDB(B1, 0, 1); PG8_SCHED; PG8_LDA(At, 0, 0); PG8_STAGE(PG8_SA(1, 1), a1 + hstepA, voffA);
            PG8_WAIT_V(8); PG8_WAIT_L(0); PG8_BAR; PG8_MMA(0, 0, At, B0); PG8_MMA(0, 1, At, B1); PG8_BAR; PG8_SCHED;
            PG8_LDA(At, 0, 1); PG8_STAGE(PG8_SB(0, 0), b2, voffB); PG8_STAGE(PG8_SB(0, 1), b2 + hstepB, voffB); PG8_STAGE(PG8_SA(0, 0), a2, voffA);
            PG8_WAIT_V(8); PG8_WAIT_L(0); PG8_BAR; PG8_MMA(1, 0, At, B0); PG8_MMA(1, 1, At, B1); PG8_BAR; PG8_SCHED;
            PG8_LDB(B0, 1, 0); PG8_LDB(B1, 1, 1); PG8_SCHED; PG8_LDA(At, 1, 0); PG8_STAGE(PG8_SA(0, 1), a2 + hstepA, voffA);
            PG8_WAIT_V(8); PG8_WAIT_L(0); PG8_BAR; PG8_MMA(0, 0, At, B0); PG8_MMA(0, 1, At, B1); PG8_BAR; PG8_SCHED;
            PG8_LDA(At, 1, 1); PG8_STAGE(PG8_SB(1, 0), b3, voffB); PG8_STAGE(PG8_SB(1, 1), b3 + hstepB, voffB); PG8_STAGE(PG8_SA(1, 0), a3, voffA);
            PG8_WAIT_V(8); PG8_WAIT_L(0); PG8_BAR; PG8_MMA(1, 0, At, B0); PG8_MMA(1, 1, At, B1); PG8_BAR; PG8_SCHED;
        }
        if (wr == 0) PG8_BAR;
        E(acc, cur, wr, wc, fr, fq);
        if (!has_next) break;
#pragma unroll
        for (int a = 0; a < 2; ++a)
#pragma unroll
            for (int b = 0; b < 2; ++b)
#pragma unroll
                for (int m = 0; m < 4; ++m)
#pragma unroll
                    for (int n = 0; n < 2; ++n) acc[a][b][m][n] = (f32x4){0.f, 0.f, 0.f, 0.f};
        cur = nxt; cA = nA; cB = nB; ++ui;
        if (wr == 1) PG8_BAR;
    }
    PG8_WAIT_V(0);
    PG8_BAR;
#undef PG8_SA
#undef PG8_SB
#undef PG8_STAGE
#undef PG8_LDA
#undef PG8_LDB
#undef PG8_MMA
#undef PG8_WAIT_V
#undef PG8_WAIT_L
#undef PG8_BAR
#undef PG8_SCHED
}

#define EPI_ROW0(u) ((u).pm * BM + wr * 64 + fr)
#define EPI_COL0(u) ((u).pn * BM + wc * 32 + 8 * fq)

struct EpiZ {
    bf16_t* Zp; const float* rstd;
    __device__ __forceinline__ void operator()(const f32x4 (&acc)[2][2][4][2], const Unit& u, int wr, int wc, int fr, int fq) const {
        const int row0 = EPI_ROW0(u), col0 = EPI_COL0(u);
#pragma unroll
        for (int ai = 0; ai < 2; ++ai)
#pragma unroll
            for (int m = 0; m < 4; ++m) { const int row = row0 + ai * HALF + m * 16; const float s = 1.f; bf16_t* rp = Zp + (size_t)row * NZ + col0;
#pragma unroll
                for (int bj = 0; bj < 2; ++bj) { const f32x4 v0 = acc[ai][bj][m][0] * s, v1 = acc[ai][bj][m][1] * s; u32x4 w;
                    w.x = cvt_pk_bf16(v0[0], v0[1]); w.y = cvt_pk_bf16(v0[2], v0[3]); w.z = cvt_pk_bf16(v1[0], v1[1]); w.w = cvt_pk_bf16(v1[2], v1[3]);
                    *(u32x4*)(rp + bj * HALF) = w; } }
    }
};
struct EpiQK {
    bf16_t* Qp; bf16_t* Kp;
    __device__ __forceinline__ void operator()(const f32x4 (&acc)[2][2][4][2], const Unit& u, int wr, int wc, int fr, int fq) const {
        const int row0 = EPI_ROW0(u), col0 = wc * 32 + 8 * fq; bf16_t* base = (u.pn ? Kp : Qp) + (size_t)u.z * M * 256;
#pragma unroll
        for (int ai = 0; ai < 2; ++ai)
#pragma unroll
            for (int m = 0; m < 4; ++m) { const int row = row0 + ai * HALF + m * 16; bf16_t* rp = base + (size_t)row * 256 + col0;
#pragma unroll
                for (int bj = 0; bj < 2; ++bj) { const f32x4 v0 = acc[ai][bj][m][0], v1 = acc[ai][bj][m][1]; u32x4 w;
                    w.x = cvt_pk_bf16(v0[0], v0[1]); w.y = cvt_pk_bf16(v0[2], v0[3]); w.z = cvt_pk_bf16(v1[0], v1[1]); w.w = cvt_pk_bf16(v1[2], v1[3]);
                    *(u32x4*)(rp + bj * HALF) = w; } }
    }
};
struct EpiT {
    bf16_t* Op; const float* wk;
    __device__ __forceinline__ void operator()(const f32x4 (&acc)[2][2][4][2], const Unit& u, int wr, int wc, int fr, int fq) const {
        const int row0 = wr * 64 + fr, col0 = EPI_COL0(u);
#pragma unroll
        for (int ai = 0; ai < 2; ++ai)
#pragma unroll
            for (int m = 0; m < 4; ++m) { const int row = row0 + ai * HALF + m * 16;
#pragma unroll
                for (int bj = 0; bj < 2; ++bj) { const int tok = col0 + bj * HALF, b = tok >> 11, c = (tok >> 6) & 31, s_ = tok & 63;
                    bf16_t* rp = Op + ((((size_t)(b * 4 + u.z) * 32 + c) * 256 + row) * 64 + s_);
                    f32x4 v0 = acc[ai][bj][m][0], v1 = acc[ai][bj][m][1]; u32x4 w;
                    if (wk) { const float* wp = wk + (size_t)(b * 4 + u.z) * T + (tok & (T - 1)); v0 = v0 * *(const f32x4*)wp; v1 = v1 * *(const f32x4*)(wp + 4); }
                    w.x = cvt_pk_bf16(v0[0], v0[1]); w.y = cvt_pk_bf16(v0[2], v0[3]); w.z = cvt_pk_bf16(v1[0], v1[1]); w.w = cvt_pk_bf16(v1[2], v1[3]);
                    *(u32x4*)rp = w; } }
    }
};
struct EpiPlain {
    bf16_t* Op; int ldc;
    __device__ __forceinline__ void operator()(const f32x4 (&acc)[2][2][4][2], const Unit& u, int wr, int wc, int fr, int fq) const {
        const int row0 = EPI_ROW0(u), col0 = EPI_COL0(u);
#pragma unroll
        for (int ai = 0; ai < 2; ++ai)
#pragma unroll
            for (int m = 0; m < 4; ++m) { const int row = row0 + ai * HALF + m * 16; bf16_t* rp = Op + (size_t)row * ldc + col0;
#pragma unroll
                for (int bj = 0; bj < 2; ++bj) { const f32x4 v0 = acc[ai][bj][m][0], v1 = acc[ai][bj][m][1]; u32x4 w;
                    w.x = cvt_pk_bf16(v0[0], v0[1]); w.y = cvt_pk_bf16(v0[2], v0[3]); w.z = cvt_pk_bf16(v1[0], v1[1]); w.w = cvt_pk_bf16(v1[2], v1[3]);
                    *(u32x4*)(rp + bj * HALF) = w; } }
    }
};
template <int MODE> struct EpiRes {
    const float* xp; const float* xs; const bf16_t* XI; bf16_t* XO; float* ss;
    __device__ __forceinline__ void operator()(const f32x4 (&acc)[2][2][4][2], const Unit& u, int wr, int wc, int fr, int fq) const {
        const int row0 = EPI_ROW0(u), col0 = EPI_COL0(u);
#pragma unroll
        for (int ai = 0; ai < 2; ++ai)
#pragma unroll
            for (int m = 0; m < 4; ++m) { const int row = row0 + ai * HALF + m * 16;
                float q = 0.f;
                if (row < MR) {
#pragma unroll
                    for (int bj = 0; bj < 2; ++bj) { const int c = col0 + bj * HALF;
                        f32x4 b0, b1;
                        if (MODE == 0) { const float* bp = row < MP ? xp + (size_t)row * D : xs + (size_t)(row - MP) * D; b0 = *(const f32x4*)(bp + c); b1 = *(const f32x4*)(bp + c + 4); }
                        else { const u32x4 w = *(const u32x4*)(XI + (size_t)row * D + c); b0 = (f32x4){bflo(w.x), bfhi(w.x), bflo(w.y), bfhi(w.y)}; b1 = (f32x4){bflo(w.z), bfhi(w.z), bflo(w.w), bfhi(w.w)}; }
                        const f32x4 v0 = acc[ai][bj][m][0] + b0, v1 = acc[ai][bj][m][1] + b1;
                        u32x4 w; w.x = cvt_pk_bf16(v0[0], v0[1]); w.y = cvt_pk_bf16(v0[2], v0[3]); w.z = cvt_pk_bf16(v1[0], v1[1]); w.w = cvt_pk_bf16(v1[2], v1[3]);
                        *(u32x4*)(XO + (size_t)row * D + c) = w;
                        q += (v0[0] * v0[0] + v0[1] * v0[1]) + (v0[2] * v0[2] + v0[3] * v0[3]) + (v1[0] * v1[0] + v1[1] * v1[1]) + (v1[2] * v1[2] + v1[3] * v1[3]); }
                }
                q += __shfl_xor(q, 16); q += __shfl_xor(q, 32);
                if (fq == 0 && row < MR) atomicAdd(ss + row, q);
            }
    }
};
struct EpiGU {
    bf16_t* Hp; const float* ss;
    __device__ __forceinline__ void operator()(const f32x4 (&acc)[2][2][4][2], const Unit& u, int wr, int wc, int fr, int fq) const {
        const int row0 = EPI_ROW0(u), col0 = u.pn * HALF + wc * 32 + 8 * fq;
#pragma unroll
        for (int ai = 0; ai < 2; ++ai)
#pragma unroll
            for (int m = 0; m < 4; ++m) { const int row = row0 + ai * HALF + m * 16; const float s = __builtin_amdgcn_rsqf(ss[row] * (1.f / D) + EPS);
                float o[8];
#pragma unroll
                for (int n = 0; n < 2; ++n)
#pragma unroll
                    for (int i = 0; i < 4; ++i) { const float gv = acc[ai][0][m][n][i] * s, uv = acc[ai][1][m][n][i] * s; o[n * 4 + i] = gv * sigmoidf_(gv) * uv; }
                u32x4 w; w.x = cvt_pk_bf16(o[0], o[1]); w.y = cvt_pk_bf16(o[2], o[3]); w.z = cvt_pk_bf16(o[4], o[5]); w.w = cvt_pk_bf16(o[6], o[7]);
                *(u32x4*)(Hp + (size_t)row * DFF + col0) = w; }
    }
};
struct EpiPle {
    const bf16_t* XI; bf16_t* XO; const bf16_t* PEp; const float* ss2; float* ss3;
    __device__ __forceinline__ void operator()(const f32x4 (&acc)[2][2][4][2], const Unit& u, int wr, int wc, int fr, int fq) const {
        const int row0 = EPI_ROW0(u), col0 = EPI_COL0(u);
#pragma unroll
        for (int ai = 0; ai < 2; ++ai)
#pragma unroll
            for (int m = 0; m < 4; ++m) { const int row = row0 + ai * HALF + m * 16;
                float q = 0.f;
                if (row < MR) {
                    const float s = __builtin_amdgcn_rsqf(ss2[row] * (1.f / D) + EPS);
#pragma unroll
                    for (int bj = 0; bj < 2; ++bj) { const int c = col0 + bj * HALF;
                        float xb[8], pe[8];
                        unpack8x(*(const u32x4*)(XI + (size_t)row * D + c), xb); unpack8x(*(const u32x4*)(PEp + (size_t)row * D + c), pe);
                        float v[8];
#pragma unroll
                        for (int i = 0; i < 4; ++i) { v[i] = xb[i] + sigmoidf_(acc[ai][bj][m][0][i] * s) * pe[i]; v[4 + i] = xb[4 + i] + sigmoidf_(acc[ai][bj][m][1][i] * s) * pe[4 + i]; }
                        u32x4 w; w.x = cvt_pk_bf16(v[0], v[1]); w.y = cvt_pk_bf16(v[2], v[3]); w.z = cvt_pk_bf16(v[4], v[5]); w.w = cvt_pk_bf16(v[6], v[7]);
                        *(u32x4*)(XO + (size_t)row * D + c) = w;
#pragma unroll
                        for (int i = 0; i < 8; ++i) q += v[i] * v[i]; }
                }
                q += __shfl_xor(q, 16); q += __shfl_xor(q, 32);
                if (fq == 0 && row < MR) atomicAdd(ss3 + row, q);
            }
    }
};
}

#define MFMA16(a, b, c) __builtin_amdgcn_mfma_f32_16x16x32_bf16((a), (b), (c), 0, 0, 0)
__device__ __forceinline__ float log_sigmoid_(float f) { return fminf(f, 0.f) - log1pf(__expf(-fabsf(f))); }
__device__ __forceinline__ void unpack8(const u32x4 w, float (&o)[8]) { o[0] = bflo(w.x); o[1] = bfhi(w.x); o[2] = bflo(w.y); o[3] = bfhi(w.y); o[4] = bflo(w.z); o[5] = bfhi(w.z); o[6] = bflo(w.w); o[7] = bfhi(w.w); }
__device__ __forceinline__ u32x4 pack8(const float (&o)[8]) { u32x4 w; w.x = pk2(o[0], o[1]); w.y = pk2(o[2], o[3]); w.z = pk2(o[4], o[5]); w.w = pk2(o[6], o[7]); return w; }

struct TJob { const float* W; int ldw, col0; bf16_t* WT; int drow0, ldt; const float* gk; float scal; int k0; };
__device__ __forceinline__ void transpose_load(const TJob& j, float (&wv)[32], float& g0, int lane) {
#pragma unroll
    for (int i = 0; i < 32; ++i) { const int kk = 2 * i + (lane >> 5); wv[i] = j.W[(size_t)(j.k0 + kk) * j.ldw + j.col0 + (lane & 31)]; }
    g0 = j.gk ? j.gk[j.k0 + (lane >> 5) + 2 * (lane & 31)] : 1.f;
}
__device__ __forceinline__ void transpose_finish(const TJob& j, const float (&wv)[32], float g0, LAS float* scr, int lane) {
#pragma unroll
    for (int i = 0; i < 32; ++i) { const int kk = 2 * i + (lane >> 5); const float gg = __shfl(g0, (lane & 32) + i) * j.scal;
        scr[kk * 33 + (lane & 31)] = wv[i] * gg; }
    asm volatile("s_waitcnt lgkmcnt(0)" ::: "memory");
    const int c = lane & 7;
#pragma unroll
    for (int q = 0; q < 4; ++q) { const int n = (lane >> 3) + 8 * q; const LAS float* sp = scr + (8 * c) * 33 + n;
        u32x4 o; o.x = pk2(sp[0 * 33], sp[1 * 33]); o.y = pk2(sp[2 * 33], sp[3 * 33]); o.z = pk2(sp[4 * 33], sp[5 * 33]); o.w = pk2(sp[6 * 33], sp[7 * 33]);
        *(u32x4*)(j.WT + (size_t)(j.drow0 + n) * j.ldt + j.k0 + 8 * c) = o; }
    asm volatile("s_waitcnt lgkmcnt(0)" ::: "memory");
}

__device__ __forceinline__ void p0_prologue(const Args& a, LAS unsigned char* lds, int G) {
    int tid = threadIdx.x; asm volatile("" : "+v"(tid)); const int lane = tid & 63, wave = tid >> 6;
    unsigned char* ws = a.ws + opq0();
    float* sm = (float*)(ws + WS_SMALL);
    const int gw = blockIdx.x * 8 + wave, NGW = G * 8;
    LAS float* scr = (LAS float*)(lds + wave * 16384);
    constexpr int I0 = 16 * 96, I1 = 16 * 64, I2 = 16 * 32, I3 = 16 * 88, I4 = I3, I5 = 44 * 32, I6 = 16 * 32, I7 = 4 * 32, I8 = 4 * 32, I9 = I8, I10 = I8, I11 = 8 * 8, I12 = I11;
    constexpr int NIT = I0 + I1 + I2 + I3 + I4 + I5 + I6 + I7 + I8 + I9 + I10 + I11 + I12;
    auto decode = [&](int it) -> TJob {
        int r = it;
        if (r < I0) { const int kb = r / 96, nb = r % 96; return TJob{INP(11), NIN, nb * 32, (bf16_t*)(ws + WS_W1T), nb * 32, D, INP(10), 1.f, kb * 64}; } r -= I0;
        if (r < I1) { const int kb = r / 64, nb = r % 64; return TJob{INP(11), NIN, 3080 + nb * 32, (bf16_t*)(ws + WS_W1T), 3072 + nb * 32, D, INP(10), 1.f, kb * 64}; } r -= I1;
        if (r < I2) { const int kb = r / 32, nb = r % 32; return TJob{INP(26), D, nb * 32, (bf16_t*)(ws + WS_WOT), nb * 32, D, nullptr, 1.f, kb * 64}; } r -= I2;
        if (r < I3) { const int kb = r / 88, nb = r % 88, n0 = nb * 32; return TJob{INP(28), DFF, n0, (bf16_t*)(ws + WS_WGUT), (n0 / 128) * 256 + (n0 % 128), D, INP(27), 1.f, kb * 64}; } r -= I3;
        if (r < I4) { const int kb = r / 88, nb = r % 88, n0 = nb * 32; return TJob{INP(29), DFF, n0, (bf16_t*)(ws + WS_WGUT), (n0 / 128) * 256 + 128 + (n0 % 128), D, INP(27), 1.f, kb * 64}; } r -= I4;
        if (r < I5) { const int kb = r / 32, nb = r % 32; return TJob{INP(30), D, nb * 32, (bf16_t*)(ws + WS_WDT), nb * 32, DFF, nullptr, 1.f, kb * 64}; } r -= I5;
        if (r < I6) { const int kb = r / 32, nb = r % 32; return TJob{INP(32), D, nb * 32, (bf16_t*)(ws + WS_WPGT), nb * 32, D, INP(31), 1.f, kb * 64}; } r -= I6;
        if (r < I7) { const int kb = r / 32, nb = r % 32; return TJob{INP(33), D, nb * 32, (bf16_t*)(ws + WS_WPT), nb * 32, PD, nullptr, 1.f, kb * 64}; } r -= I7;
        if (r < I8) { const int h = r / 32, q = r % 32, kb = q / 8, nb = q % 8; return TJob{INP(22) + (size_t)h * 65536, HD, nb * 32, (bf16_t*)(ws + WS_WQKT) + (size_t)h * 512 * 256, nb * 32, HD, nullptr, 0.0625f, kb * 64}; } r -= I8;
        if (r < I9) { const int h = r / 32, q = r % 32, kb = q / 8, nb = q % 8; return TJob{INP(23) + (size_t)h * 65536, HD, nb * 32, (bf16_t*)(ws + WS_WQKT) + (size_t)h * 512 * 256, 256 + nb * 32, HD, nullptr, 1.f, kb * 64}; } r -= I9;
        if (r < I10) { const int h = r / 32, q = r % 32, kb = q / 8, nb = q % 8; return TJob{INP(24) + (size_t)h * 65536, HD, nb * 32, (bf16_t*)(ws + WS_WVT) + (size_t)h * 65536, nb * 32, HD, nullptr, 1.f, kb * 64}; } r -= I10;
        if (r < I11) { const int bl = r / 8, q = r % 8, kb = q / 4, nb = q % 4; return TJob{INP(15) + (size_t)bl * 16384, 128, nb * 32, (bf16_t*)(ws + WS_WLRUT) + (size_t)bl * 256 * 128, nb * 32, 128, nullptr, 1.f, kb * 64}; } r -= I11;
        { const int bl = r / 8, q = r % 8, kb = q / 4, nb = q % 4; return TJob{INP(17) + (size_t)bl * 16384, 128, nb * 32, (bf16_t*)(ws + WS_WLRUT) + (size_t)bl * 256 * 128, 128 + nb * 32, 128, nullptr, 1.f, kb * 64}; }
    };
    for (int it = gw; it < NIT; it += 2 * NGW) {
        const bool has1 = it + NGW < NIT;
        const TJob ja = decode(it), jb = decode(has1 ? it + NGW : it);
        float wa_[32], wb_[32], ga, gb;
        transpose_load(ja, wa_, ga, lane);
        if (has1) transpose_load(jb, wb_, gb, lane);
        transpose_finish(ja, wa_, ga, scr, lane);
        if (has1) transpose_finish(jb, wb_, gb, scr, lane);
    }
    __syncthreads();
    LAS float* gwL = (LAS float*)lds;
    for (int i = tid; i < 8192; i += NT) { const int j = i >> 10, k = i & 1023; gwL[i] = INP(10)[k] * INP(11)[(size_t)k * NIN + 3072 + j]; }
    __syncthreads();
    bf16_t* XB = (bf16_t*)(ws + WS_XB);
    {
        float bg[8];
#pragma unroll
        for (int jj = 0; jj < 8; ++jj) bg[jj] = INP(12)[jj];
        constexpr int RB = 3;
        f32x4 cur[RB][4], nxt[RB][4];
#pragma unroll
        for (int q = 0; q < RB; ++q) { const int row = gw + q * NGW;
            if (row < MR) { const f32x4* xr = (const f32x4*)xrow_ptr(a, row) + lane;
#pragma unroll
                for (int j = 0; j < 4; ++j) cur[q][j] = xr[64 * j]; } }
        for (int r0 = gw; r0 < M; r0 += RB * NGW) {
#pragma unroll
            for (int q = 0; q < RB; ++q) { const int row = r0 + (RB + q) * NGW;
                if (row < MR) { const f32x4* xr = (const f32x4*)xrow_ptr(a, row) + lane;
#pragma unroll
                    for (int j = 0; j < 4; ++j) nxt[q][j] = xr[64 * j]; } }
#pragma unroll
            for (int q = 0; q < RB; ++q) { const int row = r0 + q * NGW;
                if (row < M) {
                    unsigned long long* o8 = (unsigned long long*)(XB + (size_t)row * D) + lane;
                    if (row >= MR) {
#pragma unroll
                        for (int j = 0; j < 4; ++j) o8[64 * j] = 0ull;
                        if (lane == 0) sm[SM_RSTD0 + row] = 0.f;
                    } else {
                        float s = 0.f;
#pragma unroll
                        for (int j = 0; j < 4; ++j) s += (cur[q][j].x * cur[q][j].x + cur[q][j].y * cur[q][j].y) + (cur[q][j].z * cur[q][j].z + cur[q][j].w * cur[q][j].w);
                        float dt[8];
#pragma unroll
                        for (int jj = 0; jj < 8; ++jj) { float d = 0.f;
#pragma unroll
                            for (int j = 0; j < 4; ++j) { const f32x4 w = *(const LAS f32x4*)(gwL + jj * 1024 + j * 256 + lane * 4); d += (cur[q][j].x * w.x + cur[q][j].y * w.y) + (cur[q][j].z * w.z + cur[q][j].w * w.w); }
                            dt[jj] = wave_sum(d); }
                        s = wave_sum(s);
                        const float rstd = 1.0f / sqrtf(s * (1.f / D) + EPS);
#pragma unroll
                        for (int j = 0; j < 4; ++j) o8[64 * j] = (unsigned long long)pk2(cur[q][j].x * rstd, cur[q][j].y * rstd) | ((unsigned long long)pk2(cur[q][j].z * rstd, cur[q][j].w * rstd) << 32);
                        if (lane == 0) { sm[SM_RSTD0 + row] = rstd;
#pragma unroll
                            for (int jj = 0; jj < 4; ++jj) { sm[SM_GI + row * 4 + jj] = dt[jj] * rstd + bg[jj]; sm[SM_GF + row * 4 + jj] = dt[4 + jj] * rstd + bg[4 + jj]; } }
                    }
                }
            }
#pragma unroll
            for (int q = 0; q < RB; ++q)
#pragma unroll
                for (int j = 0; j < 4; ++j) cur[q][j] = nxt[q][j];
        }
    }
    const int gt = blockIdx.x * NT + tid, NGT = G * NT;
    bf16_t* PB = (bf16_t*)(ws + WS_PB);
    for (int i0 = gt; i0 < M * (PD / 4); i0 += 4 * NGT) { asm volatile("" : "+v"(i0));
        f32x4 pv[4];
#pragma unroll
        for (int q = 0; q < 4; ++q) { const int i = i0 + q * NGT, row = i >> 6, c4 = (i & 63) * 4; pv[q] = (f32x4){0.f, 0.f, 0.f, 0.f};
            if (row < MP) pv[q] = *(const f32x4*)(INP(8) + (size_t)row * PD + c4); else if (row < MR) pv[q] = *(const f32x4*)(INP(9) + (size_t)(row - MP) * PD + c4); }
#pragma unroll
        for (int q = 0; q < 4; ++q) { const int i = i0 + q * NGT, row = i >> 6, c4 = (i & 63) * 4;
            if (row < M) *(unsigned long long*)(PB + (size_t)row * PD + c4) = (unsigned long long)pk2(pv[q].x, pv[q].y) | ((unsigned long long)pk2(pv[q].z, pv[q].w) << 32); } }
    for (int i = gt; i < 3 * M; i += NGT) { sm[SM_SS1 + i] = 0.f; asm volatile("" : "+v"(i)); }
}

#define LBAR() do { asm volatile("s_waitcnt lgkmcnt(0)" ::: "memory"); __builtin_amdgcn_s_barrier(); asm volatile("" ::: "memory"); } while (0)
__device__ __forceinline__ void p2a_item(const Args& a, LAS unsigned char* lds, int idx) {
    int tid = threadIdx.x; asm volatile("" : "+v"(tid)); const int lane = tid & 63, wave = tid >> 6;
    unsigned char* ws = a.ws + opq0(); float* sm = (float*)(ws + WS_SMALL);
    const bf16_t* Z = (const bf16_t*)(ws + WS_Z); bf16_t* XC = (bf16_t*)(ws + WS_XC);
    if (idx >= 2048) {
        const int sb = idx - 2048, row = MP + sb;
#pragma unroll
        for (int cc = 0; cc < 2; ++cc) { const int ch = tid * 2 + cc;
            { const float s0 = INP(2)[((size_t)sb * 3 + 0) * D + ch], s1 = INP(2)[((size_t)sb * 3 + 1) * D + ch], s2 = INP(2)[((size_t)sb * 3 + 2) * D + ch], xv = bf2f(Z[(size_t)row * NZ + ch]);
              const float o = INP(14)[ch] + INP(13)[ch] * s0 + INP(13)[D + ch] * s1 + INP(13)[2 * D + ch] * s2 + INP(13)[3 * D + ch] * xv;
              sm[SM_XLS + sb * D + ch] = o;
              a.out[O_SLC + ((size_t)sb * 3 + 0) * D + ch] = s1; a.out[O_SLC + ((size_t)sb * 3 + 1) * D + ch] = s2; a.out[O_SLC + ((size_t)sb * 3 + 2) * D + ch] = xv; }
            { const float s0 = INP(4)[((size_t)sb * 3 + 0) * D + ch], s1 = INP(4)[((size_t)sb * 3 + 1) * D + ch], s2 = INP(4)[((size_t)sb * 3 + 2) * D + ch], xv = bf2f(Z[(size_t)row * NZ + 1024 + ch]);
              const float o = INP(21)[ch] + INP(20)[ch] * s0 + INP(20)[D + ch] * s1 + INP(20)[2 * D + ch] * s2 + INP(20)[3 * D + ch] * xv;
              XC[(size_t)row * D + ch] = (bf16_t)f2bf(o * sigmoidf_(o));
              a.out[O_SMC + ((size_t)sb * 3 + 0) * D + ch] = s1; a.out[O_SMC + ((size_t)sb * 3 + 1) * D + ch] = s2; a.out[O_SMC + ((size_t)sb * 3 + 2) * D + ch] = xv; }
        }
        return;
    }
    const int cb = idx & 7, tt = (idx >> 3) & 31, b = idx >> 8;
    LAS bf16_t* AL = (LAS bf16_t*)lds;
    LAS float* U = (LAS float*)(lds + 17408);
    LAS float* AA = (LAS float*)(lds + 17408 + 32768);
    const int t0 = tt * 64, tokb = b * T;
    {
        const int c8 = tid & 15, rs = tid >> 4, chl = cb * 128 + c8 * 8;
        float wl[4][8], wm[4][8], bl[8], bm[8];
#pragma unroll
        for (int j = 0; j < 4; ++j)
#pragma unroll
            for (int i = 0; i < 8; ++i) { wl[j][i] = INP(13)[j * D + chl + i]; wm[j][i] = INP(20)[j * D + chl + i]; }
#pragma unroll
        for (int i = 0; i < 8; ++i) { bl[i] = INP(14)[chl + i]; bm[i] = INP(21)[chl + i]; }
#pragma unroll
        for (int rr = 0; rr < 2; ++rr) { const int tl = rs + 32 * rr, tg = t0 + tl;
            float ol[8], om[8], xl3[8], xm3[8];
#pragma unroll
            for (int i = 0; i < 8; ++i) { ol[i] = bl[i]; om[i] = bm[i]; xl3[i] = 0.f; xm3[i] = 0.f; }
#pragma unroll
            for (int j = 0; j < 4; ++j) { const int ts = tg - 3 + j;
                if (ts >= 0) { float xl[8], xm[8];
                    unpack8(*(const u32x4*)(Z + (size_t)(tokb + ts) * NZ + chl), xl); unpack8(*(const u32x4*)(Z + (size_t)(tokb + ts) * NZ + 1024 + chl), xm);
#pragma unroll
                    for (int i = 0; i < 8; ++i) { ol[i] += wl[j][i] * xl[i]; om[i] += wm[j][i] * xm[i]; if (j == 3) { xl3[i] = xl[i]; xm3[i] = xm[i]; } } } }
            *(LAS u32x4*)(AL + tl * 136 + c8 * 8) = pack8(ol);
            *(LAS f32x4*)(U + tl * 128 + c8 * 8) = (f32x4){ol[0], ol[1], ol[2], ol[3]}; *(LAS f32x4*)(U + tl * 128 + c8 * 8 + 4) = (f32x4){ol[4], ol[5], ol[6], ol[7]};
            float xs[8];
#pragma unroll
            for (int i = 0; i < 8; ++i) xs[i] = om[i] * sigmoidf_(om[i]);
            *(u32x4*)(XC + (size_t)(tokb + tg) * D + chl) = pack8(xs);
            if (tg >= T - 3) { const int j3 = tg - (T - 3);
#pragma unroll
                for (int i = 0; i < 8; ++i) { a.out[O_PLC + ((size_t)b * 3 + j3) * D + chl + i] = xl3[i]; a.out[O_PMC + ((size_t)b * 3 + j3) * D + chl + i] = xm3[i]; } }
        }
    }
    __syncthreads();
    {
        const int fr = lane & 15, fq = lane >> 4;
        const bf16_t* Wl = (const bf16_t*)(ws + WS_WLRUT) + (size_t)cb * 256 * 128;
        f32x4 ar[4], ai[4];
#pragma unroll
        for (int m = 0; m < 4; ++m) { ar[m] = (f32x4){0.f, 0.f, 0.f, 0.f}; ai[m] = (f32x4){0.f, 0.f, 0.f, 0.f}; }
#pragma unroll
        for (int ks = 0; ks < 4; ++ks) {
            const bf16x8 br = *(const bf16x8*)(Wl + (size_t)(16 * wave + fr) * 128 + ks * 32 + fq * 8);
            const bf16x8 bi = *(const bf16x8*)(Wl + (size_t)(128 + 16 * wave + fr) * 128 + ks * 32 + fq * 8);
#pragma unroll
            for (int m = 0; m < 4; ++m) { const bf16x8 af = *(const LAS bf16x8*)(AL + (m * 16 + fr) * 136 + ks * 32 + fq * 8);
                ar[m] = MFMA16(af, br, ar[m]); ai[m] = MFMA16(af, bi, ai[m]); }
        }
        const int c = 16 * wave + fr, ch = cb * 128 + c;
        const float ba = INP(16)[ch], bx = INP(18)[ch], lam = INP(19)[ch];
        const float sp = fmaxf(-lam, 0.f) + log1pf(__expf(-fabsf(lam)));
#pragma unroll
        for (int m = 0; m < 4; ++m)
#pragma unroll
            for (int j = 0; j < 4; ++j) { const int t = m * 16 + fq * 4 + j;
                const float r = sigmoidf_(ar[m][j] + ba), ig = sigmoidf_(ai[m][j] + bx);
                const float la = -8.0f * r * sp, av = fexp_(la);
                const float uv = __builtin_amdgcn_sqrtf(fmaxf(1.f - av * av, 0.f)) * ig * U[t * 128 + c];
                AA[t * 128 + c] = av; U[t * 128 + c] = uv; }
    }
    __syncthreads();
    {
        const int c = tid & 127, seg = tid >> 7;
        float h = 0.f, P = 1.f;
#pragma unroll
        for (int i = 0; i < 16; ++i) { const int t = seg * 16 + i; const float av = AA[t * 128 + c], uv = U[t * 128 + c]; h = av * h + uv; P *= av; U[t * 128 + c] = h; AA[t * 128 + c] = P; }
        __syncthreads();
        float hc = 0.f, pc = 1.f;
        for (int s = 0; s < seg; ++s) { const int te = s * 16 + 15; const float pe = AA[te * 128 + c]; hc = pe * hc + U[te * 128 + c]; pc *= pe; }
        __syncthreads();
        if (seg > 0) {
#pragma unroll
            for (int i = 0; i < 16; ++i) { const int t = seg * 16 + i; const float pv = AA[t * 128 + c]; U[t * 128 + c] += pv * hc; AA[t * 128 + c] = pv * pc; }
        }
    }
    __syncthreads();
    {
        const int c8 = tid & 15, rs = tid >> 4, chl = cb * 128 + c8 * 8;
        bf16_t* HL = (bf16_t*)(ws + WS_HLOC); bf16_t* CA = (bf16_t*)(ws + WS_CUMA);
#pragma unroll
        for (int rr = 0; rr < 2; ++rr) { const int tl = rs + 32 * rr; float hv[8], cv[8];
#pragma unroll
            for (int i = 0; i < 8; ++i) { hv[i] = U[tl * 128 + c8 * 8 + i]; cv[i] = AA[tl * 128 + c8 * 8 + i]; }
            *(u32x4*)(HL + (size_t)(tokb + t0 + tl) * D + chl) = pack8(hv); *(u32x4*)(CA + (size_t)(tokb + t0 + tl) * D + chl) = pack8(cv); }
        if (tid < 128) { sm[SM_LRA + (b * 32 + tt) * D + cb * 128 + tid] = AA[63 * 128 + tid]; sm[SM_LRH + (b * 32 + tt) * D + cb * 128 + tid] = U[63 * 128 + tid]; }
    }
    __syncthreads();
}

__device__ __forceinline__ void p2_zload(const bf16_t* Z, int idx, int tid, u32x4 (&zr)[5]) {
    const int cb = idx & 7, tt = (idx >> 3) & 31, b = idx >> 8, t0 = tt * 64, tokb = b * T;
#pragma unroll
    for (int q = 0; q < 5; ++q) { const int p = tid + NT * q, r = p >> 5, pp = p & 31, ts = t0 - 3 + r;
        zr[q] = (u32x4){0u, 0u, 0u, 0u};
        if (r < 67 && ts >= 0) zr[q] = *(const u32x4*)(Z + (size_t)(tokb + ts) * NZ + (pp >> 4) * 1024 + cb * 128 + (pp & 15) * 8); }
}
__device__ __forceinline__ void p2_phase(const Args& a, LAS unsigned char* lds, int G) {
    int tid = threadIdx.x; asm volatile("" : "+v"(tid)); const int lane = tid & 63, wave = tid >> 6, fr = lane & 15, fq = lane >> 4;
    unsigned char* ws = a.ws + opq0(); float* sm = (float*)(ws + WS_SMALL);
    const bf16_t* Z = (const bf16_t*)(ws + WS_Z); bf16_t* XC = (bf16_t*)(ws + WS_XC);
    LAS bf16_t* AL = (LAS bf16_t*)lds;
    LAS float* U = (LAS float*)(lds + 17408);
    LAS float* AA = (LAS float*)(lds + 17408 + 32768);
    LAS bf16_t* ZT = (LAS bf16_t*)(lds + 82944);
    LAS float* CW = (LAS float*)(lds + 117248);
    int idx = blockIdx.x;
    if (idx >= 2048) return;
    u32x4 zr[5];
    p2_zload(Z, idx, tid, zr);
    int cb_prev = -1;
    bf16x8 br[4], bi[4]; float ba = 0.f, bx = 0.f, sp = 0.f;
    for (; idx < 2048; idx += G) {
        const int cb = idx & 7, tt = (idx >> 3) & 31, b = idx >> 8, t0 = tt * 64, tokb = b * T;
#pragma unroll
        for (int q = 0; q < 5; ++q) { const int p = tid + NT * q, r = p >> 5, pp = p & 31; if (r < 67) *(LAS u32x4*)(ZT + ((pp >> 4) * 67 + r) * 128 + (pp & 15) * 8) = zr[q]; }
        if (cb != cb_prev) {
            for (int i = tid; i < 2 * 5 * 128; i += NT) { const int which = i / 640, j = (i % 640) >> 7, c = i & 127, ch = cb * 128 + c;
                CW[i] = which == 0 ? (j < 4 ? INP(13)[j * D + ch] : INP(14)[ch]) : (j < 4 ? INP(20)[j * D + ch] : INP(21)[ch]); }
            const bf16_t* Wl = (const bf16_t*)(ws + WS_WLRUT) + (size_t)cb * 256 * 128;
#pragma unroll
            for (int ks = 0; ks < 4; ++ks) { br[ks] = *(const bf16x8*)(Wl + (size_t)(16 * wave + fr) * 128 + ks * 32 + fq * 8); bi[ks] = *(const bf16x8*)(Wl + (size_t)(128 + 16 * wave + fr) * 128 + ks * 32 + fq * 8); }
            const int ch = cb * 128 + 16 * wave + fr; const float lam = INP(19)[ch];
            ba = INP(16)[ch]; bx = INP(18)[ch]; sp = fmaxf(-lam, 0.f) + log1pf(__expf(-fabsf(lam)));
            cb_prev = cb;
        }
        if (idx + G < 2048) p2_zload(Z, idx + G, tid, zr);
        LBAR();
        {
            const int c8 = tid & 15, rs = tid >> 4, chl = cb * 128 + c8 * 8;
#pragma unroll
            for (int rr = 0; rr < 2; ++rr) { const int tl = rs + 32 * rr, tg = t0 + tl;
                float ol[8], om[8], xl3[8], xm3[8];
#pragma unroll
                for (int i = 0; i < 8; ++i) { ol[i] = CW[4 * 128 + c8 * 8 + i]; om[i] = CW[640 + 4 * 128 + c8 * 8 + i]; }
#pragma unroll
                for (int j = 0; j < 4; ++j) { float xl[8], xm[8];
                    unpack8(*(const LAS u32x4*)(ZT + (tl + j) * 128 + c8 * 8), xl); unpack8(*(const LAS u32x4*)(ZT + (67 + tl + j) * 128 + c8 * 8), xm);
#pragma unroll
                    for (int i = 0; i < 8; ++i) { ol[i] += CW[j * 128 + c8 * 8 + i] * xl[i]; om[i] += CW[640 + j * 128 + c8 * 8 + i] * xm[i]; if (j == 3) { xl3[i] = xl[i]; xm3[i] = xm[i]; } } }
                *(LAS u32x4*)(AL + tl * 136 + c8 * 8) = pack8(ol);
                *(LAS f32x4*)(U + tl * 128 + c8 * 8) = (f32x4){ol[0], ol[1], ol[2], ol[3]}; *(LAS f32x4*)(U + tl * 128 + c8 * 8 + 4) = (f32x4){ol[4], ol[5], ol[6], ol[7]};
                float xs[8];
#pragma unroll
                for (int i = 0; i < 8; ++i) xs[i] = om[i] * sigmoidf_(om[i]);
                *(u32x4*)(XC + (size_t)(tokb + tg) * D + chl) = pack8(xs);
                if (tg >= T - 3) { const int j3 = tg - (T - 3);
#pragma unroll
                    for (int i = 0; i < 8; ++i) { a.out[O_PLC + ((size_t)b * 3 + j3) * D + chl + i] = xl3[i]; a.out[O_PMC + ((size_t)b * 3 + j3) * D + chl + i] = xm3[i]; } }
            }
        }
        LBAR();
        {
            f32x4 ar[4], ai[4];
#pragma unroll
            for (int m = 0; m < 4; ++m) { ar[m] = (f32x4){0.f, 0.f, 0.f, 0.f}; ai[m] = (f32x4){0.f, 0.f, 0.f, 0.f}; }
#pragma unroll
            for (int ks = 0; ks < 4; ++ks)
#pragma unroll
                for (int m = 0; m < 4; ++m) { const bf16x8 af = *(const LAS bf16x8*)(AL + (m * 16 + fr) * 136 + ks * 32 + fq * 8);
                    ar[m] = MFMA16(af, br[ks], ar[m]); ai[m] = MFMA16(af, bi[ks], ai[m]); }
            const int c = 16 * wave + fr;
            float Aq[4][4], Bq[4][4];
#pragma unroll
            for (int m = 0; m < 4; ++m)
#pragma unroll
                for (int j = 0; j < 4; ++j) { const int t = m * 16 + fq * 4 + j;
                    const float r = sigmoidf_(ar[m][j] + ba), ig = sigmoidf_(ai[m][j] + bx);
                    const float la = -8.0f * r * sp, av = fexp_(la);
                    Aq[m][j] = av; Bq[m][j] = __builtin_amdgcn_sqrtf(fmaxf(1.f - av * av, 0.f)) * ig * U[t * 128 + c]; }
            float Ac = 1.f, Bc = 0.f;
#pragma unroll
            for (int m = 0; m < 4; ++m) {
#pragma unroll
                for (int j = 1; j < 4; ++j) { Bq[m][j] = Aq[m][j] * Bq[m][j - 1] + Bq[m][j]; Aq[m][j] = Aq[m][j] * Aq[m][j - 1]; }
                const float Ra = Aq[m][3], Rb = Bq[m][3];
                float Pa = 1.f, Pb = 0.f, Ga = 1.f, Gb = 0.f;
#pragma unroll
                for (int sgrp = 0; sgrp < 4; ++sgrp) { const float xa = __shfl(Ra, fr + 16 * sgrp), xb = __shfl(Rb, fr + 16 * sgrp);
                    if (sgrp < fq) { Pb = xa * Pb + xb; Pa = xa * Pa; }
                    Gb = xa * Gb + xb; Ga = xa * Ga; }
                const float Qb = Pa * Bc + Pb, Qa = Pa * Ac;
#pragma unroll
                for (int j = 0; j < 4; ++j) { const int t = m * 16 + fq * 4 + j; const float hv = Aq[m][j] * Qb + Bq[m][j], pv = Aq[m][j] * Qa;
                    U[t * 128 + c] = hv; AA[t * 128 + c] = pv;
                    if (m == 3 && j == 3 && fq == 3) { sm[SM_LRA + (b * 32 + tt) * D + cb * 128 + c] = pv; sm[SM_LRH + (b * 32 + tt) * D + cb * 128 + c] = hv; } }
                Bc = Ga * Bc + Gb; Ac = Ga * Ac;
            }
        }
        LBAR();
        {
            const int c8 = tid & 15, rs = tid >> 4, chl = cb * 128 + c8 * 8;
            bf16_t* HL = (bf16_t*)(ws + WS_HLOC); bf16_t* CA = (bf16_t*)(ws + WS_CUMA);
#pragma unroll
            for (int rr = 0; rr < 2; ++rr) { const int tl = rs + 32 * rr; float hv[8], cv[8];
#pragma unroll
                for (int i = 0; i < 8; ++i) { hv[i] = U[tl * 128 + c8 * 8 + i]; cv[i] = AA[tl * 128 + c8 * 8 + i]; }
                *(u32x4*)(HL + (size_t)(tokb + t0 + tl) * D + chl) = pack8(hv); *(u32x4*)(CA + (size_t)(tokb + t0 + tl) * D + chl) = pack8(cv); }
        }
    }
}

__device__ __forceinline__ float block_excl_sum(float v, LAS float* red, int tid) {
    const int lane = tid & 63, wave = tid >> 6; float inc = v;
#pragma unroll
    for (int o = 1; o < 64; o <<= 1) { const float t = __shfl_up(inc, o); if (lane >= o) inc += t; }
    __syncthreads();
    if (lane == 63) red[wave] = inc;
    __syncthreads();
    float base = 0.f;
    for (int w = 0; w < wave; ++w) base += red[w];
    return base + inc - v;
}
__device__ __forceinline__ float block_excl_max(float v, LAS float* red, int tid) {
    const int lane = tid & 63, wave = tid >> 6; float inc = v;
#pragma unroll
    for (int o = 1; o < 64; o <<= 1) { const float t = __shfl_up(inc, o); if (lane >= o) inc = fmaxf(inc, t); }
    __syncthreads();
    if (lane == 63) red[wave] = inc;
    __syncthreads();
    float base = -INFINITY;
    for (int w = 0; w < wave; ++w) base = fmaxf(base, red[w]);
    const float prev = __shfl_up(inc, 1);
    return fmaxf(base, lane > 0 ? prev : -INFINITY);
}
__device__ __forceinline__ void gate_scan(const Args& a, LAS unsigned char* lds, int bh) {
    int tid = threadIdx.x; asm volatile("" : "+v"(tid)); float* sm = (float*)(a.ws + WS_SMALL);
    LAS float* BCl = (LAS float*)lds; LAS float* MMl = BCl + T; LAS float* red = MMl + T;
    const int b = bh >> 2, h = bh & 3;
    float lf[4], ig[4], bc[4], gv[4], pmx[4];
#pragma unroll
    for (int i = 0; i < 4; ++i) { const int row = b * T + tid * 4 + i; lf[i] = log_sigmoid_(sm[SM_GF + row * 4 + h]); ig[i] = sm[SM_GI + row * 4 + h]; }
    const float tot = (lf[0] + lf[1]) + (lf[2] + lf[3]);
    const float ex = block_excl_sum(tot, red, tid);
    float run = ex;
#pragma unroll
    for (int i = 0; i < 4; ++i) { run += lf[i]; bc[i] = run; gv[i] = ig[i] - run; }
    const float lm = fmaxf(fmaxf(gv[0], gv[1]), fmaxf(gv[2], gv[3]));
    const float exm = block_excl_max(lm, red, tid);
    float rm = exm;
#pragma unroll
    for (int i = 0; i < 4; ++i) { rm = fmaxf(rm, gv[i]); pmx[i] = rm; BCl[tid * 4 + i] = bc[i]; MMl[tid * 4 + i] = bc[i] + rm; }
    __syncthreads();
#pragma unroll
    for (int i = 0; i < 4; ++i) { const int t = tid * 4 + i, c = t >> 6;
        const float Bprev = c ? BCl[64 * c - 1] : 0.f, mprev = c ? MMl[64 * c - 1] : M_INIT, Blast = BCl[64 * c + 63], mlast = MMl[64 * c + 63];
        const float mm = bc[i] + pmx[i];
        sm[SM_BM + bh * T + t] = -pmx[i]; sm[SM_GIB + bh * T + t] = gv[i]; sm[SM_MM + bh * T + t] = mm;
        sm[SM_SC + bh * T + t] = __expf(bc[i] - Bprev + mprev - mm);
        sm[SM_WK + bh * T + t] = __expf(Blast - bc[i] + ig[i] - mlast);
        if ((t & 63) == 0) sm[SM_DEC + bh * 32 + c] = __expf(Blast - Bprev + mprev - mlast);
        if (t == T - 1) a.out[O_PM + bh] = mm; }
    __syncthreads();
}

struct P3Ops { bf16x8 vf[2][2]; bf16x8 kf[2][2]; float sc, dec; };
__device__ __forceinline__ void p3_load(P3Ops& o, const bf16_t* Q, const bf16_t* KT, const bf16_t* VT, const float* sm, int b, int h, int bh, int es, int c, int wave, int fr, int fq) {
    const int tok0 = b * T + c * 64, gb = bh * T + c * 64, mt = wave >> 1;
#pragma unroll
    for (int ks = 0; ks < 2; ++ks) {
#pragma unroll
        for (int e = 0; e < 2; ++e) o.vf[ks][e] = *(const bf16x8*)(VT + ((size_t)(bh * 32 + c) * 256 + es * 32 + e * 16 + fr) * 64 + ks * 32 + fq * 8);
#pragma unroll
        for (int d = 0; d < 2; ++d) o.kf[ks][d] = *(const bf16x8*)(KT + ((size_t)(bh * 32 + c) * 256 + 32 * wave + d * 16 + fr) * 64 + ks * 32 + fq * 8);
    }
    o.sc = sm[SM_SC + gb + mt * 16 + fr]; o.dec = sm[SM_DEC + bh * 32 + c];
}
__device__ __forceinline__ void p3_item(const Args& a, LAS unsigned char* lds, int idx) {
    int tid = threadIdx.x; asm volatile("" : "+v"(tid)); const int lane = tid & 63, wave = tid >> 6, fr = lane & 15, fq = lane >> 4;
    unsigned char* ws = a.ws + opq0(); float* sm = (float*)(ws + WS_SMALL);
    const int es = idx & 7, bh = idx >> 3, b = bh >> 2, h = bh & 3;
    const bf16_t* Q = (const bf16_t*)(ws + WS_Q); const bf16_t* KT = (const bf16_t*)(ws + WS_KT); const bf16_t* VT = (const bf16_t*)(ws + WS_VT);
    bf16_t* NUMI = (bf16_t*)(ws + WS_XC);
    const int ii = tid >> 8, q_ = tid & 255, sit = idx * 2 + ii, ssb = sit >> 2, shh = sit & 3, srow = MP + ssb, ssh = ssb * 4 + shh;
    LAS float* SQ = (LAS float*)(lds + 34816) + ii * 256; LAS float* SK = (LAS float*)(lds + 36864) + ii * 256; LAS float* SV = (LAS float*)(lds + 38912) + ii * 256;
    LAS float* SRED = (LAS float*)(lds + 40960) + ii * 1024; LAS float* SR2 = (LAS float*)(lds + 49152) + ii * 16;
    SQ[q_] = bf2f(Q[((size_t)shh * M + srow) * 256 + q_]); SK[q_] = bf2f(((const bf16_t*)(ws + WS_K))[((size_t)shh * M + srow) * 256 + q_]); SV[q_] = bf2f(((const bf16_t*)(ws + WS_VS))[(size_t)ssb * D + shh * 256 + q_]);
    const float s_lf = log_sigmoid_(sm[SM_GF + srow * 4 + shh]), s_ig = sm[SM_GI + srow * 4 + shh], s_m0 = INP(7)[ssh];
    const float s_mn = fmaxf(s_lf + s_m0, s_ig), s_dec = fexp_(s_lf + s_m0 - s_mn), s_wkk = fexp_(s_ig - s_mn);
    const int s_r = q_ >> 6, s_e4 = (q_ & 63) * 4;
    const float* sC0 = INP(5) + (size_t)ssh * 65536 + s_e4; float* sC1 = a.out + O_SC + (size_t)ssh * 65536 + s_e4;
    f32x4 sacc = (f32x4){0.f, 0.f, 0.f, 0.f};
    const int s_ch = shh * 256 + q_;
    LAS float* SXL = (LAS float*)(lds + 49280) + ii * 256;
    SXL[q_] = sm[SM_XLS + ssb * D + s_ch];
    const float* wa = INP(15) + (size_t)(s_ch >> 7) * 16384 + (s_ch & 127); const float* wx = INP(17) + (size_t)(s_ch >> 7) * 16384 + (s_ch & 127);
    float s_rp = INP(16)[s_ch], s_ip = INP(18)[s_ch];
    f32x4 acc[2][2], accn[2];
#pragma unroll
    for (int e = 0; e < 2; ++e)
#pragma unroll
        for (int d = 0; d < 2; ++d) acc[e][d] = (f32x4){0.f, 0.f, 0.f, 0.f};
    accn[0] = (f32x4){0.f, 0.f, 0.f, 0.f}; accn[1] = (f32x4){0.f, 0.f, 0.f, 0.f};
    bf16x8 ones_f; { const short o1 = fr == 0 ? (short)0x3F80 : (short)0; ones_f = (bf16x8){o1, o1, o1, o1, o1, o1, o1, o1}; }
    P3Ops cur, nxt;
    p3_load(cur, Q, KT, VT, sm, b, h, bh, es, 0, wave, fr, fq);
    bf16x8 qf[8];
#pragma unroll
    for (int ks = 0; ks < 8; ++ks) qf[ks] = *(const bf16x8*)(Q + ((size_t)h * M + b * T + 64 + (wave >> 1) * 16 + fr) * 256 + ks * 32 + fq * 8);
    __syncthreads();
    const f32x4 s_v4 = *(const LAS f32x4*)(SV + s_e4);
    for (int c = 0; c < NCH; ++c) {
        const int tok0 = b * T + c * 64;
        LAS bf16_t* CTr = (LAS bf16_t*)(lds + (c & 1) * 16896);
        LAS bf16_t* CTw = (LAS bf16_t*)(lds + ((c + 1) & 1) * 16896);
        p3_load(nxt, Q, KT, VT, sm, b, h, bh, es, c + 1 < NCH ? c + 1 : c, wave, fr, fq);
        const int sd0 = c * 8 + s_r, sd1 = sd0 + 4;
        const f32x4 sc0 = __builtin_nontemporal_load((const f32x4*)(sC0 + (size_t)sd0 * 256)), sc1 = __builtin_nontemporal_load((const f32x4*)(sC0 + (size_t)sd1 * 256));
        float wa4[4], wx4[4];
#pragma unroll
        for (int k = 0; k < 4; ++k) { wa4[k] = wa[(c * 4 + k) * 128]; wx4[k] = wx[(c * 4 + k) * 128]; }
        if (c > 0) {
            const int mt = wave >> 1, et = wave & 1;
            f32x4 ai = (f32x4){0.f, 0.f, 0.f, 0.f};
#pragma unroll
            for (int ks = 0; ks < 8; ++ks) { const bf16x8 cf = *(const LAS bf16x8*)(CTr + (et * 16 + fr) * 264 + ks * 32 + fq * 8); ai = MFMA16(cf, qf[ks], ai); }
            u32x2 w; w.x = pk2(ai[0] * cur.sc, ai[1] * cur.sc); w.y = pk2(ai[2] * cur.sc, ai[3] * cur.sc);
            *(u32x2*)(NUMI + (size_t)(tok0 + mt * 16 + fr) * D + h * 256 + es * 32 + et * 16 + fq * 4) = w;
            const int cq = c + 1 < NCH ? c + 1 : c;
#pragma unroll
            for (int ks = 0; ks < 8; ++ks) qf[ks] = *(const bf16x8*)(Q + ((size_t)h * M + b * T + cq * 64 + mt * 16 + fr) * 256 + ks * 32 + fq * 8);
        }
        if (es == 0 && fq == 0) { sm[SM_NST + (bh * 32 + c) * 256 + 32 * wave + fr] = accn[0][0]; sm[SM_NST + (bh * 32 + c) * 256 + 32 * wave + 16 + fr] = accn[1][0]; }
        const float dec = cur.dec;
#pragma unroll
        for (int e = 0; e < 2; ++e)
#pragma unroll
            for (int d = 0; d < 2; ++d) acc[e][d] = acc[e][d] * dec;
        accn[0] = accn[0] * dec; accn[1] = accn[1] * dec;
#pragma unroll
        for (int ks = 0; ks < 2; ++ks) {
#pragma unroll
            for (int e = 0; e < 2; ++e)
#pragma unroll
                for (int d = 0; d < 2; ++d) acc[e][d] = MFMA16(cur.vf[ks][e], cur.kf[ks][d], acc[e][d]);
            if (es == 0) { accn[0] = MFMA16(ones_f, cur.kf[ks][0], accn[0]); accn[1] = MFMA16(ones_f, cur.kf[ks][1], accn[1]); }
        }
#pragma unroll
        for (int e = 0; e < 2; ++e)
#pragma unroll
            for (int d = 0; d < 2; ++d)
#pragma unroll
                for (int j = 0; j < 4; ++j) CTw[(e * 16 + fq * 4 + j) * 264 + 32 * wave + d * 16 + fr] = (bf16_t)f2bf(acc[e][d][j]);
        {
            const float k0 = SK[sd0] * s_wkk, k1 = SK[sd1] * s_wkk, q0 = SQ[sd0], q1 = SQ[sd1];
            const f32x4 cn0 = sc0 * s_dec + s_v4 * k0, cn1 = sc1 * s_dec + s_v4 * k1;
            __builtin_nontemporal_store(cn0, (f32x4*)(sC1 + (size_t)sd0 * 256)); __builtin_nontemporal_store(cn1, (f32x4*)(sC1 + (size_t)sd1 * 256));
            sacc += cn0 * q0 + cn1 * q1;
#pragma unroll
            for (int k = 0; k < 4; ++k) { const float xv = SXL[(q_ >> 7) * 128 + c * 4 + k]; s_rp += xv * wa4[k]; s_ip += xv * wx4[k]; }
        }
        LBAR();
        cur = nxt;
    }
#pragma unroll
    for (int e = 0; e < 2; ++e)
#pragma unroll
        for (int d = 0; d < 2; ++d) *(f32x4*)(a.out + O_PC + ((size_t)bh * 256 + 32 * wave + d * 16 + fr) * 256 + es * 32 + e * 16 + fq * 4) = acc[e][d];
    if (es == 0 && fq == 0) { a.out[O_PN + bh * 256 + 32 * wave + fr] = accn[0][0]; a.out[O_PN + bh * 256 + 32 * wave + 16 + fr] = accn[1][0]; }
    *(LAS f32x4*)(SRED + s_r * 256 + s_e4) = sacc;
    const float nn = s_dec * INP(6)[ssh * 256 + q_] + s_wkk * SK[q_];
    a.out[O_SN + ssh * 256 + q_] = nn;
    const float dn = wave_sum(SQ[q_] * nn);
    if (lane == 0) SR2[wave & 3] = dn;
    __syncthreads();
    const float den = (SR2[0] + SR2[1]) + (SR2[2] + SR2[3]);
    const float num = (SRED[q_] + SRED[256 + q_]) + (SRED[512 + q_] + SRED[768 + q_]);
    const float hv = num / fmaxf(fabsf(den), fexp_(-s_mn));
    const float hq = wave_sum(hv * hv);
    if (lane == 0) SR2[4 + (wave & 3)] = hq;
    __syncthreads();
    {
        const float rs = 1.0f / sqrtf(((SR2[4] + SR2[5]) + (SR2[6] + SR2[7])) * (1.f / 256.f) + EPS);
        const bf16_t* Z = (const bf16_t*)(ws + WS_Z);
        const int ch = s_ch;
        const float ym = hv * rs * INP(25)[ch] * sigmoidf_(bf2f(Z[(size_t)srow * NZ + 2048 + ch]));
        const float rp = s_rp, ip = s_ip;
        const float lam = INP(19)[ch], sp = fmaxf(-lam, 0.f) + log1pf(__expf(-fabsf(lam)));
        const float r = sigmoidf_(rp), ig = sigmoidf_(ip), la = -8.0f * r * sp, av = fexp_(la);
        const float uv = __builtin_amdgcn_sqrtf(fmaxf(1.f - av * av, 0.f)) * ig * SXL[q_];
        const float hn = av * INP(3)[ssb * D + ch] + uv;
        a.out[O_SLH + ssb * D + ch] = hn;
        const float mg = sigmoidf_(bf2f(Z[(size_t)srow * NZ + 3072 + ch])) * hn + sigmoidf_(bf2f(Z[(size_t)srow * NZ + 4096 + ch])) * ym;
        ((bf16_t*)(ws + WS_XB))[(size_t)srow * D + ch] = (bf16_t)f2bf(mg);
        if (q_ == 0) a.out[O_SM + ssh] = s_mn;
    }
    __syncthreads();
}
__device__ __forceinline__ void carry_scan(const Args& a, int G) {
    int tid = threadIdx.x; asm volatile("" : "+v"(tid));
    float* sm = (float*)(a.ws + opq0() + WS_SMALL);
    const int per = (NB * D + G - 1) / G;
    if (tid < per) { const int i = blockIdx.x * per + tid;
        if (i < NB * D) { const int b = i >> 10, ch = i & 1023; float la[NCH], lh[NCH];
#pragma unroll
            for (int j = 0; j < NCH; ++j) { la[j] = sm[SM_LRA + (b * 32 + j) * D + ch]; lh[j] = sm[SM_LRH + (b * 32 + j) * D + ch]; }
            float cr = 0.f;
#pragma unroll
            for (int j = 0; j < NCH; ++j) { sm[SM_CARRY + (b * 32 + j) * D + ch] = cr; cr = la[j] * cr + lh[j]; }
            a.out[O_PLH + b * D + ch] = cr; } }
}

__device__ __forceinline__ void sample_item(const Args& a, LAS unsigned char* lds, int idx) {
    int tid = threadIdx.x; asm volatile("" : "+v"(tid)); const int lane = tid & 63, wave = tid >> 6;
    unsigned char* ws = a.ws + opq0(); float* sm = (float*)(ws + WS_SMALL);
    const int sb = idx >> 2, h = idx & 3, row = MP + sb, sh = sb * 4 + h;
    const bf16_t* Q = (const bf16_t*)(ws + WS_Q); const bf16_t* Kb = (const bf16_t*)(ws + WS_K); const bf16_t* VT = (const bf16_t*)(ws + WS_VT); const bf16_t* Z = (const bf16_t*)(ws + WS_Z);
    LAS float* qs = (LAS float*)lds; LAS float* ks = qs + 256; LAS float* vs = ks + 256; LAS float* red = vs + 256  ; LAS float* r2 = red + 2048  ;
    if (tid < 256) { qs[tid] = bf2f(Q[(size_t)row * D + h * 256 + tid]); ks[tid] = bf2f(Kb[(size_t)row * D + h * 256 + tid]); vs[tid] = bf2f(VT[(size_t)(h * 256 + tid) * M + row]); }
    const float fpre = sm[SM_GF + row * 4 + h], ipre = sm[SM_GI + row * 4 + h], lf = log_sigmoid_(fpre), m0 = INP(7)[sh];
    const float mn = fmaxf(lf + m0, ipre), dec = __expf(lf + m0 - mn), wkk = __expf(ipre - mn);
    __syncthreads();
    {
        const int e4 = (tid & 63) * 4, dr = tid >> 6;
        const f32x4 v4 = *(const LAS f32x4*)(vs + e4);
        f32x4 ac = (f32x4){0.f, 0.f, 0.f, 0.f};
        const float* C0 = INP(5) + (size_t)sh * 65536; float* C1 = a.out + O_SC + (size_t)sh * 65536;
#pragma unroll 4
        for (int d = dr; d < 256; d += 8) { const f32x4 c0 = *(const f32x4*)(C0 + (size_t)d * 256 + e4); const float kd = ks[d] * wkk;
            const f32x4 cn = c0 * dec + v4 * kd; *(f32x4*)(C1 + (size_t)d * 256 + e4) = cn; ac += cn * qs[d]; }
        *(LAS f32x4*)(red + dr * 256 + e4) = ac;
    }
    float dn = 0.f;
    if (tid < 256) { const float nn = dec * INP(6)[sh * 256 + tid] + wkk * ks[tid]; a.out[O_SN + sh * 256 + tid] = nn; dn = qs[tid] * nn; }
    dn = wave_sum(dn);
    if (lane == 0) r2[wave] = dn;
    __syncthreads();
    const float den = (r2[0] + r2[1]) + (r2[2] + r2[3]);
    float hv = 0.f;
    if (tid < 256) { float num = 0.f;
#pragma unroll
        for (int r = 0; r < 8; ++r) num += red[r * 256 + tid];
        hv = num / fmaxf(fabsf(den), __expf(-mn)); }
    const float hq = wave_sum(hv * hv);
    if (lane == 0) r2[8 + wave] = hq;
    __syncthreads();
    if (tid < 256) {
        const float rs = 1.0f / sqrtf(((r2[8] + r2[9]) + (r2[10] + r2[11])) * (1.f / 256.f) + EPS);
        const int ch = h * 256 + tid, blk = ch >> 7, dd = ch & 127;
        const float ym = hv * rs * INP(25)[ch] * sigmoidf_(bf2f(Z[(size_t)row * NZ + 2048 + ch]));
        const float* xl = sm + SM_XLS + sb * D + blk * 128; const float* wa = INP(15) + (size_t)blk * 16384 + dd; const float* wx = INP(17) + (size_t)blk * 16384 + dd;
        float rp = INP(16)[ch], ip = INP(18)[ch];
#pragma unroll 8
        for (int c = 0; c < 128; ++c) { const float xv = xl[c]; rp += xv * wa[c * 128]; ip += xv * wx[c * 128]; }
        const float lam = INP(19)[ch], sp = fmaxf(-lam, 0.f) + log1pf(__expf(-fabsf(lam)));
        const float r = sigmoidf_(rp), ig = sigmoidf_(ip), la = -8.0f * r * sp, av = __expf(la);
        const float uv = sqrtf(-expm1f(2.f * la)) * ig * sm[SM_XLS + sb * D + ch];
        const float hn = av * INP(3)[sb * D + ch] + uv;
        a.out[O_SLH + sb * D + ch] = hn;
        const float mg = sigmoidf_(bf2f(Z[(size_t)row * NZ + 3072 + ch])) * hn + sigmoidf_(bf2f(Z[(size_t)row * NZ + 4096 + ch])) * ym;
        ((bf16_t*)(ws + WS_XB))[(size_t)row * D + ch] = (bf16_t)f2bf(mg);
        if (tid == 0) a.out[O_SM + sh] = mn;
    }
    __syncthreads();
}

__device__ __forceinline__ void p4w_item(const Args& a, LAS unsigned char* lds, int it) {
    int tid = threadIdx.x; asm volatile("" : "+v"(tid)); const int lane = tid & 63, wave = tid >> 6, fr = lane & 15, fq = lane >> 4;
    unsigned char* ws = a.ws + opq0(); float* sm = (float*)(ws + WS_SMALL);
    it = __builtin_amdgcn_readfirstlane(it);
    const int tt = it < 2048 ? (it & 3) : 3 - (it & 3), bch = it >> 2,
              h = bch & 3, c = (bch >> 2) & 31, b = bch >> 7, bh = b * 4 + h, tok0 = b * T + c * 64, gb = bh * T + c * 64;
    const bf16_t* Q = (const bf16_t*)(ws + WS_Q); const bf16_t* Kb = (const bf16_t*)(ws + WS_K); const bf16_t* VT = (const bf16_t*)(ws + WS_VT); const bf16_t* Z = (const bf16_t*)(ws + WS_Z);
    const bf16_t* NUMI = (const bf16_t*)(ws + WS_XC); const bf16_t* HL = (const bf16_t*)(ws + WS_HLOC); const bf16_t* CA = (const bf16_t*)(ws + WS_CUMA);
    bf16_t* MG = (bf16_t*)(ws + WS_XB);
    LAS bf16_t* Sl = (LAS bf16_t*)(lds + wave * 2304);
    const int t = tt * 16 + fr; const size_t tok = (size_t)(tok0 + t);
    bf16x8 qf[8];
#pragma unroll
    for (int ks = 0; ks < 8; ++ks) qf[ks] = *(const bf16x8*)(Q + ((size_t)h * M + tok) * 256 + ks * 32 + fq * 8);
    float di = 0.f;
#pragma unroll
    for (int ks = 0; ks < 8; ++ks) { float qq[8]; unpack8(__builtin_bit_cast(u32x4, qf[ks]), qq);
        const f32x4 n0 = *(const f32x4*)(sm + SM_NST + (bh * 32 + c) * 256 + ks * 32 + fq * 8), n1 = *(const f32x4*)(sm + SM_NST + (bh * 32 + c) * 256 + ks * 32 + fq * 8 + 4);
        di += (qq[0] * n0[0] + qq[1] * n0[1]) + (qq[2] * n0[2] + qq[3] * n0[3]) + (qq[4] * n1[0] + qq[5] * n1[1]) + (qq[6] * n1[2] + qq[7] * n1[3]); }
    di += __shfl_xor(di, 16); di += __shfl_xor(di, 32);
    di *= sm[SM_SC + gb + t];
    const float bm = sm[SM_BM + gb + t];
    float ds = 0.f;
    bf16x8 kfc[8];
#pragma unroll
    for (int ks = 0; ks < 8; ++ks) kfc[ks] = *(const bf16x8*)(Kb + ((size_t)h * M + tok0 + fr) * 256 + ks * 32 + fq * 8);
    u32x2 niw[16];
#pragma unroll
    for (int e = 0; e < 16; ++e) niw[e] = c > 0 ? *(const u32x2*)(NUMI + tok * D + h * 256 + e * 16 + fq * 4) : (u32x2){0u, 0u};
    for (int st = 0; st <= tt; ++st) {
        bf16x8 kfn[8];
        const int stn = st < tt ? st + 1 : st;
#pragma unroll
        for (int ks = 0; ks < 8; ++ks) kfn[ks] = *(const bf16x8*)(Kb + ((size_t)h * M + tok0 + stn * 16 + fr) * 256 + ks * 32 + fq * 8);
        f32x4 sa = (f32x4){0.f, 0.f, 0.f, 0.f};
#pragma unroll
        for (int ks = 0; ks < 8; ++ks) sa = MFMA16(kfc[ks], qf[ks], sa);
        const f32x4 gib = *(const f32x4*)(sm + SM_GIB + gb + st * 16 + fq * 4);
        float vv[4];
#pragma unroll
        for (int j = 0; j < 4; ++j) { const int s_ = st * 16 + fq * 4 + j; vv[j] = (s_ <= t) ? sa[j] * fexp_(bm + gib[j]) : 0.f; ds += vv[j]; }
        u32x2 w; w.x = pk2(vv[0], vv[1]); w.y = pk2(vv[2], vv[3]);
        *(LAS u32x2*)(Sl + fr * 72 + st * 16 + fq * 4) = w;
#pragma unroll
        for (int ks = 0; ks < 8; ++ks) kfc[ks] = kfn[ks];
    }
    if ((tt & 1) == 0) { unsigned z0 = 0u; asm volatile("" : "+v"(z0)); *(LAS u32x2*)(Sl + fr * 72 + (tt + 1) * 16 + fq * 4) = (u32x2){z0, z0}; }
    ds += __shfl_xor(ds, 16); ds += __shfl_xor(ds, 32);
    const float den = ds + di;
    const float inv = 1.0f / fmaxf(fabsf(den), fexp_(-sm[SM_MM + gb + t]));
    asm volatile("s_waitcnt lgkmcnt(0)" ::: "memory");
    f32x4 acc[16];
#pragma unroll
    for (int e = 0; e < 16; ++e) acc[e] = (f32x4){0.f, 0.f, 0.f, 0.f};
    const int nks = tt < 2 ? 1 : 2;
    {
        bf16x8 vf0[16], vf1[16];
#pragma unroll
        for (int e = 0; e < 16; ++e) vf0[e] = *(const bf16x8*)(VT + ((size_t)(bh * 32 + c) * 256 + e * 16 + fr) * 64 + fq * 8);
        if (nks == 2) {
#pragma unroll
            for (int e = 0; e < 16; ++e) vf1[e] = *(const bf16x8*)(VT + ((size_t)(bh * 32 + c) * 256 + e * 16 + fr) * 64 + 32 + fq * 8);
        }
        const bf16x8 sf0 = *(const LAS bf16x8*)(Sl + fr * 72 + fq * 8);
#pragma unroll
        for (int e = 0; e < 16; ++e) acc[e] = MFMA16(vf0[e], sf0, acc[e]);
        if (nks == 2) { const bf16x8 sf1 = *(const LAS bf16x8*)(Sl + fr * 72 + 32 + fq * 8);
#pragma unroll
            for (int e = 0; e < 16; ++e) acc[e] = MFMA16(vf1[e], sf1, acc[e]); }
    }
    asm volatile("s_waitcnt lgkmcnt(0)" ::: "memory");
    float hq = 0.f;
#pragma unroll
    for (int e = 0; e < 16; ++e) { const float ni[4] = {bflo(niw[e].x), bfhi(niw[e].x), bflo(niw[e].y), bfhi(niw[e].y)};
#pragma unroll
        for (int j = 0; j < 4; ++j) { const float hv = (acc[e][j] + ni[j]) * inv; acc[e][j] = hv; hq += hv * hv; } }
    hq += __shfl_xor(hq, 16); hq += __shfl_xor(hq, 32);
    const float rs = __builtin_amdgcn_rsqf(hq * (1.f / 256.f) + EPS);
#pragma unroll
    for (int e = 0; e < 16; ++e) { const int ch = h * 256 + e * 16 + fq * 4;
        const f32x4 mg = *(const f32x4*)(INP(25) + ch); const f32x4 cr = *(const f32x4*)(sm + SM_CARRY + (b * 32 + c) * D + ch);
        const u32x2 ow = *(const u32x2*)(Z + tok * NZ + 2048 + ch), glw = *(const u32x2*)(Z + tok * NZ + 3072 + ch), gmw = *(const u32x2*)(Z + tok * NZ + 4096 + ch);
        const u32x2 hlw = *(const u32x2*)(HL + tok * D + ch), caw = *(const u32x2*)(CA + tok * D + ch);
        const float ov[4] = {bflo(ow.x), bfhi(ow.x), bflo(ow.y), bfhi(ow.y)}, gl[4] = {bflo(glw.x), bfhi(glw.x), bflo(glw.y), bfhi(glw.y)}, gm[4] = {bflo(gmw.x), bfhi(gmw.x), bflo(gmw.y), bfhi(gmw.y)};
        const float hl[4] = {bflo(hlw.x), bfhi(hlw.x), bflo(hlw.y), bfhi(hlw.y)}, ca[4] = {bflo(caw.x), bfhi(caw.x), bflo(caw.y), bfhi(caw.y)};
        float o[4];
#pragma unroll
        for (int j = 0; j < 4; ++j) { const float ym = acc[e][j] * rs * mg[j] * sigmoidf_(ov[j]); const float yl = hl[j] + ca[j] * cr[j];
            o[j] = sigmoidf_(gl[j]) * yl + sigmoidf_(gm[j]) * ym; }
        u32x2 w; w.x = pk2(o[0], o[1]); w.y = pk2(o[2], o[3]);
        *(u32x2*)(MG + tok * D + ch) = w; }
}

__device__ __forceinline__ void p9_final(const Args& a, int G) {
    int tid = threadIdx.x; asm volatile("" : "+v"(tid)); const int lane = tid & 63, wave = tid >> 6;
    const float* sm = (const float*)(a.ws + WS_SMALL); const bf16_t* X = (const bf16_t*)(a.ws + WS_X1B);
    const int gw = blockIdx.x * 8 + wave, NGW = G * 8;
    f32x4 g4[4];
#pragma unroll
    for (int j = 0; j < 4; ++j) g4[j] = *((const f32x4*)INP(34) + lane + 64 * j);
    for (int r0 = gw; r0 < MR; r0 += 4 * NGW) {
        u32x2 xw[4][4]; float ssv[4];
#pragma unroll
        for (int q = 0; q < 4; ++q) { const int row = r0 + q * NGW;
            if (row < MR) { ssv[q] = sm[SM_SS3 + row]; const u32x2* xr = (const u32x2*)(X + (size_t)row * D) + lane;
#pragma unroll
                for (int j = 0; j < 4; ++j) xw[q][j] = xr[64 * j]; } }
#pragma unroll
        for (int q = 0; q < 4; ++q) { const int row = r0 + q * NGW;
            if (row < MR) { const float rs = 1.0f / sqrtf(ssv[q] * (1.f / D) + EPS);
                f32x4* o = (f32x4*)(a.out + (row < MP ? O_YP + (size_t)row * D : O_YS + (size_t)(row - MP) * D)) + lane;
#pragma unroll
                for (int j = 0; j < 4; ++j) { const u32x2 w = xw[q][j]; const f32x4 v = (f32x4){bflo(w.x), bfhi(w.x), bflo(w.y), bfhi(w.y)}; o[64 * j] = v * rs * g4[j]; } } }
    }
}

template <int KS, int MT>
__device__ __forceinline__ void skinny_job(const Args& a, LAS unsigned char* lds, int kind, int G) {
    int tid = threadIdx.x; asm volatile("" : "+v"(tid)); const int lane = tid & 63, wave = tid >> 6, fr = lane & 15, fq = lane >> 4;
    unsigned char* ws = a.ws + opq0(); float* sm = (float*)(ws + WS_SMALL);
    const bf16_t* A; const bf16_t* Bt; int lda, ldb, K, ncol;
    switch (kind) {
    case 0: A = (const bf16_t*)(ws + WS_XB); lda = D; Bt = (const bf16_t*)(ws + WS_W1T); ldb = D; K = D; ncol = NZ / 16; break;
    case 1: A = (const bf16_t*)(ws + WS_XC); lda = D; Bt = (const bf16_t*)(ws + WS_WQKT); ldb = HD; K = HD; ncol = NH * 32; break;
    case 3: A = (const bf16_t*)(ws + WS_Z) + 1024; lda = NZ; Bt = (const bf16_t*)(ws + WS_WVT); ldb = HD; K = HD; ncol = NH * 16; break;
    case 4: A = (const bf16_t*)(ws + WS_XB); lda = D; Bt = (const bf16_t*)(ws + WS_WOT); ldb = D; K = D; ncol = D / 16; break;
    case 5: A = (const bf16_t*)(ws + WS_X1B); lda = D; Bt = (const bf16_t*)(ws + WS_WGUT); ldb = D; K = D; ncol = (DFF / 128) * 8; break;
    case 6: A = (const bf16_t*)(ws + WS_Z); lda = DFF; Bt = (const bf16_t*)(ws + WS_WDT); ldb = DFF; K = DFF; ncol = D / 16; break;
    case 7: A = (const bf16_t*)(ws + WS_PB); lda = PD; Bt = (const bf16_t*)(ws + WS_WPT); ldb = PD; K = PD; ncol = D / 16; break;
    default: A = (const bf16_t*)(ws + WS_X2B); lda = D; Bt = (const bf16_t*)(ws + WS_WPGT); ldb = D; K = D; ncol = D / 16; break;
    }
    constexpr int NG = 8 / MT;
    const int nksw = K / 256, kw = wave * (K / 8), nunits = ncol * NG;
    LAS f32x4* red0 = (LAS f32x4*)lds; LAS f32x4* red1 = (LAS f32x4*)(lds + 65536);
    for (int uu = blockIdx.x; uu < nunits; uu += G) {
        const int u = uu / NG, mbase = (uu % NG) * MT;
        int acol = 0, brow0 = u * 16, brow1 = u * 16, z = 0; size_t boff = 0;
        if (kind == 1) { z = u >> 5; acol = z * 256; brow0 = (u & 31) * 16; brow1 = brow0; boff = (size_t)z * 512 * 256; }
        if (kind == 3) { z = u >> 4; acol = z * 256; brow0 = (u & 15) * 16; brow1 = brow0; boff = (size_t)z * 65536; }
        if (kind == 5) { brow0 = (u >> 3) * 256 + (u & 7) * 16; brow1 = brow0 + 128; }
        const bf16_t* Ap = A + (size_t)(MP + mbase * 16 + fr) * lda + acol + kw + fq * 8;
        const bf16_t* B0p = Bt + boff + (size_t)(brow0 + fr) * ldb + kw + fq * 8;
        const bf16_t* B1p = Bt + boff + (size_t)(brow1 + fr) * ldb + kw + fq * 8;
        bf16x8 b0[KS], b1[KS], af[KS][MT];
#pragma unroll
        for (int i = 0; i < KS; ++i) if (i < nksw) { b0[i] = *(const bf16x8*)(B0p + i * 32); if (kind == 5) b1[i] = *(const bf16x8*)(B1p + i * 32);
#pragma unroll
            for (int m = 0; m < MT; ++m) af[i][m] = *(const bf16x8*)(Ap + (size_t)m * 16 * lda + i * 32); }
        f32x4 p0[MT], p1[MT];
#pragma unroll
        for (int m = 0; m < MT; ++m) { p0[m] = (f32x4){0.f, 0.f, 0.f, 0.f}; p1[m] = (f32x4){0.f, 0.f, 0.f, 0.f}; }
#pragma unroll
        for (int i = 0; i < KS; ++i) if (i < nksw) {
#pragma unroll
            for (int m = 0; m < MT; ++m) { p0[m] = MFMA16(b0[i], af[i][m], p0[m]); if (kind == 5) p1[m] = MFMA16(b1[i], af[i][m], p1[m]); } }
#pragma unroll
        for (int m = 0; m < MT; ++m) { red0[(wave * MT + m) * 64 + lane] = p0[m]; if (kind == 5) red1[(wave * MT + m) * 64 + lane] = p1[m]; }
        __syncthreads();
        if (wave < MT) {
        const int row = MP + (mbase + wave) * 16 + fr;
        f32x4 acc0 = (f32x4){0.f, 0.f, 0.f, 0.f}, acc1 = (f32x4){0.f, 0.f, 0.f, 0.f};
#pragma unroll
        for (int w = 0; w < 8; ++w) { acc0 += red0[(w * MT + wave) * 64 + lane]; if (kind == 5) acc1 += red1[(w * MT + wave) * 64 + lane]; }
        switch (kind) {
        case 0: { const float s = 1.f; u32x2 w; w.x = pk2(acc0[0] * s, acc0[1] * s); w.y = pk2(acc0[2] * s, acc0[3] * s);
                  *(u32x2*)((bf16_t*)(ws + WS_Z) + (size_t)row * NZ + u * 16 + fq * 4) = w; } break;
        case 1: { const int col = brow0 + fq * 4; bf16_t* dst = (col < 256 ? (bf16_t*)(ws + WS_Q) + col : (bf16_t*)(ws + WS_K) + col - 256) + ((size_t)z * M + row) * 256;
                  u32x2 w; w.x = pk2(acc0[0], acc0[1]); w.y = pk2(acc0[2], acc0[3]); *(u32x2*)dst = w; } break;
        case 3: { u32x2 w; w.x = pk2(acc0[0], acc0[1]); w.y = pk2(acc0[2], acc0[3]); *(u32x2*)((bf16_t*)(ws + WS_VS) + (size_t)(row - MP) * D + z * 256 + brow0 + fq * 4) = w; } break;
        case 4: case 6: { const int col = u * 16 + fq * 4; f32x4 b;
                  if (kind == 4) b = *(const f32x4*)(INP(1) + (size_t)(row - MP) * D + col);
                  else { const u32x2 w = *(const u32x2*)((const bf16_t*)(ws + WS_X1B) + (size_t)row * D + col); b = (f32x4){bflo(w.x), bfhi(w.x), bflo(w.y), bfhi(w.y)}; }
                  const f32x4 v = acc0 + b; u32x2 w; w.x = pk2(v[0], v[1]); w.y = pk2(v[2], v[3]);
                  *(u32x2*)((bf16_t*)(ws + (kind == 4 ? WS_X1B : WS_X2B)) + (size_t)row * D + col) = w;
                  float q = (v[0] * v[0] + v[1] * v[1]) + (v[2] * v[2] + v[3] * v[3]); q += __shfl_xor(q, 16); q += __shfl_xor(q, 32);
                  if (fq == 0) atomicAdd(sm + (kind == 4 ? SM_SS1 : SM_SS2) + row, q); } break;
        case 5: { const float s = __builtin_amdgcn_rsqf(sm[SM_SS1 + row] * (1.f / D) + EPS); float o[4];
#pragma unroll
                  for (int j = 0; j < 4; ++j) { const float gv = acc0[j] * s, uv = acc1[j] * s; o[j] = gv * sigmoidf_(gv) * uv; }
                  u32x2 w; w.x = pk2(o[0], o[1]); w.y = pk2(o[2], o[3]);
                  *(u32x2*)((bf16_t*)(ws + WS_Z) + (size_t)row * DFF + (u >> 3) * 128 + (u & 7) * 16 + fq * 4) = w; } break;
        case 7: { u32x2 w; w.x = pk2(acc0[0], acc0[1]); w.y = pk2(acc0[2], acc0[3]); *(u32x2*)((bf16_t*)(ws + WS_PE) + (size_t)row * D + u * 16 + fq * 4) = w; } break;
        default: { const int col = u * 16 + fq * 4; const float s = __builtin_amdgcn_rsqf(sm[SM_SS2 + row] * (1.f / D) + EPS);
                  const u32x2 xw = *(const u32x2*)((const bf16_t*)(ws + WS_X2B) + (size_t)row * D + col), pw = *(const u32x2*)((const bf16_t*)(ws + WS_PE) + (size_t)row * D + col);
                  const float xb[4] = {bflo(xw.x), bfhi(xw.x), bflo(xw.y), bfhi(xw.y)}, pe[4] = {bflo(pw.x), bfhi(pw.x), bflo(pw.y), bfhi(pw.y)};
                  float v[4], q = 0.f;
#pragma unroll
                  for (int j = 0; j < 4; ++j) { v[j] = xb[j] + sigmoidf_(acc0[j] * s) * pe[j]; q += v[j] * v[j]; }
                  u32x2 w; w.x = pk2(v[0], v[1]); w.y = pk2(v[2], v[3]); *(u32x2*)((bf16_t*)(ws + WS_X1B) + (size_t)row * D + col) = w;
                  q += __shfl_xor(q, 16); q += __shfl_xor(q, 32);
                  if (fq == 0) atomicAdd(sm + SM_SS3 + row, q); } break;
        }
        }
        __syncthreads();
    }
}
__device__ __forceinline__ int skinny_kind(int ph, int j) {
    if (ph == 1) return j == 0 ? 0 : -1;
    if (ph == 3) return j == 0 ? 1 : (j == 1 ? 3 : -1);
    if (ph == 6) return j == 0 ? 4 : -1;
    if (ph == 7) return j == 0 ? 5 : -1;
    if (ph == 8) return j == 0 ? 6 : -1;
    if (ph == 9) return j == 0 ? 7 : (j == 1 ? 8 : -1);
    return -1;
}

#define XB_TMO      128
#define XB_XCNT(j)  (256  + 64 * (j))
#define XB_XSUB(j)  (1280 + 64 * (j))
#define XB_XGEN(j)  (2304 + 64 * (j))
#define XB_TOP      3328
#define XB_TOPGEN   3392
#define XCD_BAR_WORDS 3456
#define XB_SPIN_CAP (1u << 18)
__device__ __forceinline__ unsigned xb_ld(unsigned* p)              { return __hip_atomic_load(p, __ATOMIC_RELAXED, __HIP_MEMORY_SCOPE_AGENT); }
__device__ __forceinline__ unsigned xb_add(unsigned* p, unsigned v) { return __hip_atomic_fetch_add(p, v, __ATOMIC_RELAXED, __HIP_MEMORY_SCOPE_AGENT); }
__device__ __forceinline__ unsigned xb_xcc_id() { return (unsigned)__builtin_amdgcn_s_getreg((3 << 11) | 20) & 0xFu; }
#define XB_SPIN(cond, bar) do { unsigned _sp = 0; while (cond) { __builtin_amdgcn_s_sleep(1); \
    if ((++_sp & 255u) == 0u) { if (xb_ld(&(bar)[XB_TMO])) break; if (_sp > XB_SPIN_CAP) { atomicAdd(&(bar)[XB_TMO], 1u); break; } } } } while (0)
struct XcdBarrier { unsigned* bar; unsigned x; volatile LAS unsigned* st; };
__device__ __forceinline__ XcdBarrier xcd_barrier_post(unsigned* bar, volatile LAS unsigned* st) {
    XcdBarrier b; b.bar = bar; b.x = xb_xcc_id(); b.st = st;
    if (threadIdx.x == 0) (void)xb_add(&bar[XB_XCNT(b.x)], 1u);
    return b;
}
__device__ __forceinline__ void xcd_barrier_complete(unsigned* bar, unsigned x, unsigned& nloc, unsigned& nx) {
    const unsigned G = gridDim.x * gridDim.y * gridDim.z;
    unsigned sum, cnt, mine, sp = 0u;
    for (;;) {
        sum = 0u; cnt = 0u; mine = 0u;
#pragma unroll
        for (unsigned j = 0; j < 16; ++j) { const unsigned c = xb_ld(&bar[XB_XCNT(j)]); sum += c; cnt += (c > 0u) ? 1u : 0u; mine = (j == x) ? c : mine; }
        if (sum == G) break;
        __builtin_amdgcn_s_sleep(1);
        if ((++sp & 255u) == 0u) { if (xb_ld(&bar[XB_TMO])) break; if (sp > XB_SPIN_CAP) { atomicAdd(&bar[XB_TMO], 1u); break; } }
    }
    nloc = mine > 0u ? mine : 1u; nx = cnt > 0u ? cnt : 1u;
}
__device__ __forceinline__ void xcd_barrier(const XcdBarrier& b) {
    asm volatile("s_waitcnt vmcnt(0)" ::: "memory");
    __syncthreads();
    if (threadIdx.x == 0) {
        unsigned* bar = b.bar;
        __builtin_amdgcn_s_waitcnt(0);
        unsigned nloc = b.st[0], nx = b.st[1];
        if (nloc == 0u) { xcd_barrier_complete(bar, b.x, nloc, nx); b.st[0] = nloc; b.st[1] = nx; }
        const unsigned old = xb_add(&bar[XB_XSUB(b.x)], 1u);
        const unsigned gen = old / nloc;
        if (old + 1u == (gen + 1u) * nloc) {
            __builtin_amdgcn_fence(__ATOMIC_RELEASE, "agent");
            asm volatile("s_waitcnt vmcnt(0)" ::: "memory");
            const unsigned og = xb_add(&bar[XB_TOP], 1u);
            const unsigned tg = og / nx;
            if (og + 1u == (tg + 1u) * nx) xb_add(&bar[XB_TOPGEN], 1u);
            else XB_SPIN(xb_ld(&bar[XB_TOPGEN]) == tg, bar);
            __builtin_amdgcn_fence(__ATOMIC_ACQUIRE, "agent");
            xb_add(&bar[XB_XGEN(b.x)], 1u);
            asm volatile("s_waitcnt vmcnt(0)" ::: "memory");
        } else {
            XB_SPIN(xb_ld(&bar[XB_XGEN(b.x)]) == gen, bar);
            __builtin_amdgcn_fence(__ATOMIC_ACQUIRE, "agent");
            asm volatile("s_waitcnt vmcnt(0)" ::: "memory");
        }
    }
    __syncthreads();
}

namespace pg8 {
struct EpiAny {
    int kind; unsigned char* ws; const float* xp; const float* xs;
    __device__ __forceinline__ void operator()(const f32x4 (&acc)[2][2][4][2], const Unit& u, int wr, int wc, int fr, int fq) const {
        float* sm = (float*)(ws + WS_SMALL);
        switch (kind) {
        case 0: { EpiZ E{(bf16_t*)(ws + WS_Z), sm + SM_RSTD0}; E(acc, u, wr, wc, fr, fq); } break;
        case 1: { EpiQK E{(bf16_t*)(ws + WS_Q), (bf16_t*)(ws + WS_K)}; E(acc, u, wr, wc, fr, fq); } break;
        case 2: { EpiT E{(bf16_t*)(ws + WS_KT), sm + SM_WK}; E(acc, u, wr, wc, fr, fq); } break;
        case 3: { EpiT E{(bf16_t*)(ws + WS_VT), nullptr}; E(acc, u, wr, wc, fr, fq); } break;
        case 4: { EpiRes<0> E{xp, xs, nullptr, (bf16_t*)(ws + WS_X1B), sm + SM_SS1}; E(acc, u, wr, wc, fr, fq); } break;
        case 5: { EpiGU E{(bf16_t*)(ws + WS_Z), sm + SM_SS1}; E(acc, u, wr, wc, fr, fq); } break;
        case 6: { EpiRes<1> E{nullptr, nullptr, (const bf16_t*)(ws + WS_X1B), (bf16_t*)(ws + WS_X2B), sm + SM_SS2}; E(acc, u, wr, wc, fr, fq); } break;
        case 7: { EpiPlain E{(bf16_t*)(ws + WS_PE), D}; E(acc, u, wr, wc, fr, fq); } break;
        default: { EpiPle E{(const bf16_t*)(ws + WS_X2B), (bf16_t*)(ws + WS_X1B), (const bf16_t*)(ws + WS_PE), sm + SM_SS2, sm + SM_SS3}; E(acc, u, wr, wc, fr, fq); } break;
        }
    }
};
}

__device__ __forceinline__ bool gemm_job(unsigned char* ws, int ph, int j, pg8::Gemm& g, int& nM, int& nN, int& nZ, int& kind) {
    using namespace pg8;
    const bf16_t* w = (const bf16_t*)ws;
#define WSB(off) ((const bf16_t*)(ws + (off)))
    if (ph == 1 && j == 0) { g = Gemm{WSB(WS_XB), WSB(WS_W1T), D, D, D, 0, 0}; nM = MP / 256; nN = NZ / 256; nZ = 1; kind = 0; return true; }
    if (ph == 3 && j == 0) { g = Gemm{WSB(WS_XC), WSB(WS_WQKT), D, HD, HD, 512, (size_t)512 * 256 * 2}; nM = MP / 256; nN = 2; nZ = NH; kind = 1; return true; }
    if (ph == 3 && j == 1) { g = Gemm{WSB(WS_WQKT) + 65536, WSB(WS_XC), HD, D, HD, (size_t)512 * 256 * 2, 512}; nM = 1; nN = MP / 256; nZ = NH; kind = 2; return true; }
    if (ph == 3 && j == 2) { g = Gemm{WSB(WS_WVT), WSB(WS_Z) + 1024, HD, NZ, HD, (size_t)65536 * 2, 512}; nM = 1; nN = MP / 256; nZ = NH; kind = 3; return true; }
    if (ph == 6 && j == 0) { g = Gemm{WSB(WS_XB), WSB(WS_WOT), D, D, D, 0, 0}; nM = MP / 256; nN = D / 256; nZ = 1; kind = 4; return true; }
    if (ph == 7 && j == 0) { g = Gemm{WSB(WS_X1B), WSB(WS_WGUT), D, D, D, 0, 0}; nM = MP / 256; nN = NGU / 256; nZ = 1; kind = 5; return true; }
    if (ph == 8 && j == 0) { g = Gemm{WSB(WS_Z), WSB(WS_WDT), DFF, DFF, DFF, 0, 0}; nM = MP / 256; nN = D / 256; nZ = 1; kind = 6; return true; }
    if (ph == 7 && j == 1) { g = Gemm{WSB(WS_PB), WSB(WS_WPT), PD, PD, PD, 0, 0}; nM = MP / 256; nN = D / 256; nZ = 1; kind = 7; return true; }
    if (ph == 9 && j == 0) { g = Gemm{WSB(WS_X2B), WSB(WS_WPGT), D, D, D, 0, 0}; nM = MP / 256; nN = D / 256; nZ = 1; kind = 8; return true; }
#undef WSB
    (void)w; return false;
}

#ifndef REPMASK
#define REPMASK 0
#endif
constexpr int NPHASE = 11;
__global__ void __launch_bounds__(NT, 2) hawk_fwd(Args a) {
    extern __shared__ __attribute__((aligned(16))) unsigned char lds_raw[];
    LAS unsigned char* lds = (LAS unsigned char*)lds_raw;
    cg::grid_group grid = cg::this_grid();
    const int G = gridDim.x, bx = blockIdx.x;
    volatile LAS unsigned* bst = (volatile LAS unsigned*)(lds + LDS_BYTES - 64);
    if (threadIdx.x == 0) { bst[0] = 0u; bst[1] = 0u; }
    __syncthreads();
    const XcdBarrier xbar = xcd_barrier_post((unsigned*)(a.ws + WS_BAR), bst);
    if (a.ph_hi < 0) grid.sync();
    for (int ph = a.ph_lo; ph < a.ph_hi; ++ph) {
        for (int rep = 0; rep < 1 + ((REPMASK >> ph) & 1); ++rep) {
            if (rep) xcd_barrier(xbar);
            switch (ph) {
            case 0: p0_prologue(a, lds, G); break;
            case 2: p2_phase(a, lds, G); __syncthreads();
                    for (int it = 2048 + (bx + G - G / 2) % G; it < 2048 + MS; it += G) p2a_item(a, lds, it);
                    __syncthreads();
                    for (int bh = G - 1 - bx; bh < 32; bh += G) gate_scan(a, lds, bh); break;
            case 4: carry_scan(a, G);
                    for (int it = bx; it < 256; it += G) p3_item(a, lds, ((it & 7) << 5) | (it >> 3)); break;
            case 5: { int tw = threadIdx.x; asm volatile("" : "+v"(tw)); for (int it = bx * 8 + (tw >> 6); it < 4096; it += G * 8) p4w_item(a, lds, it); } break;
            case 10: p9_final(a, G); break;
            default: break;
            }
            for (int sj = 0; sj < 2; ++sj) { const int sk = skinny_kind(ph, sj); if (sk < 0) break; if (sk == 6) skinny_job<11, 2>(a, lds, sk, G); else skinny_job<4, 4>(a, lds, sk, G); __syncthreads(); }
            __syncthreads();
            for (int j = 0; j < 3; ++j) {
                pg8::Gemm g; int nM, nN, nZ, kind;
                if (!gemm_job(a.ws, ph, j, g, nM, nN, nZ, kind)) break;
                pg8::Order S; S.init(nM, nN, nZ, G, bx);
                if (kind == 7) { if (G != 256) S.init(nM, nN, nZ, G, bx); else if (bx < 128) continue; else S.init(nM, nN, nZ, 128, bx - 128); }
                pg8::EpiAny E{kind, a.ws, a.in[0], a.in[1]};
                pg8::gemm_phase(lds, g, S, E);
            }
        }
        if (ph + 1 < a.ph_hi) xcd_barrier(xbar);
    }
}

#ifndef N_LAUNCH_SPLIT
#define N_LAUNCH_SPLIT 0
#endif
extern "C" void kernel_launch(void* const* d_in, const int* in_sizes, int n_in, void* d_out, int out_size, void* d_ws, size_t ws_size, hipStream_t stream) {
    static int grid = 0;
    if (grid == 0) {
        int dev = 0, cus = 0, per_cu = 0;
        hipGetDevice(&dev);
        hipDeviceGetAttribute(&cus, hipDeviceAttributeMultiprocessorCount, dev);
        hipFuncSetAttribute((const void*)hawk_fwd, hipFuncAttributeMaxDynamicSharedMemorySize, LDS_BYTES);
        hipOccupancyMaxActiveBlocksPerMultiprocessor(&per_cu, (const void*)hawk_fwd, NT, LDS_BYTES);
        if (per_cu < 1) { fprintf(stderr, "kernel_launch: occupancy query says %d blocks per CU\n", per_cu); per_cu = 1; }
        grid = cus * per_cu;
        if (n_in != 35 || ws_size < WS_END || (size_t)out_size != O_END) fprintf(stderr, "kernel_launch: unexpected sizes n_in %d ws %zu out %d\n", n_in, ws_size, out_size);
    }
    Args a{};
    for (int i = 0; i < 35; ++i) a.in[i] = (const float*)d_in[i];
    a.out = (float*)d_out; a.ws = (unsigned char*)d_ws;
#if N_LAUNCH_SPLIT
    for (int p = 0; p < NPHASE; ++p) { a.ph_lo = p; a.ph_hi = p + 1; hipLaunchKernelGGL(hawk_fwd, dim3(grid), dim3(NT), LDS_BYTES, stream, a); }
#else
    a.ph_lo = 0; a.ph_hi = NPHASE;
    hipMemsetAsync((char*)d_ws + WS_BAR, 0, 16384, stream);
    void* args[] = {&a};
    hipError_t e = hipLaunchCooperativeKernel((const void*)hawk_fwd, dim3(grid), dim3(NT), args, LDS_BYTES, stream);
    if (e != hipSuccess) fprintf(stderr, "cooperative launch failed: %s (grid %d)\n", hipGetErrorString(e), grid);
#endif
}
```
